# Optimizing an MI355X kernel written in HIP

```python
import math
import jax, jax.numpy as jnp
from jax import lax
import numpy as np

D_MODEL = 1024
BATCH = 8
SEQ = 4096
DEPTH = 2

N_A = max(DEPTH // 2, 1)
N_B = DEPTH - N_A
N_DENSE = (DEPTH + 1) // 2
N_MOE = DEPTH // 2

POOL_WINDOWS = (2, 4, 8, 16)
N_POOL_GROUPS = len(POOL_WINDOWS)
POOL_GROUP_DIM = D_MODEL // N_POOL_GROUPS
POOL_MAX = max(POOL_WINDOWS)

HEAD_DIM = 128
N_HEADS = D_MODEL // HEAD_DIM
BLOCK = 256
TOP_BLOCKS = 3
Q_CHUNK = 16
ROT_DIM = HEAD_DIM // 4
ROPE_THETA = 500000.0

D_FF = 2816
N_EXPERTS = 8
TOP_K = 2
D_FF_EXPERT = 3584

EPS = 1e-6

kernel_name = "yoco_pool_moba_moe_hybrid"


def rms_norm(x, g):
    xf = x.astype(jnp.float32)
    var = jnp.mean(xf * xf, axis=-1, keepdims=True)
    return (xf * lax.rsqrt(var + EPS) * g.astype(jnp.float32)).astype(x.dtype)


def rope_partial(x, pos):
    half = ROT_DIM // 2
    inv = ROPE_THETA ** (-jnp.arange(half, dtype=jnp.float32) * 2.0 / ROT_DIM)
    ang = pos.astype(jnp.float32)[:, None] * inv[None, :]
    cos, sin = jnp.cos(ang), jnp.sin(ang)
    xf = x.astype(jnp.float32)
    x1 = xf[..., :half]
    x2 = xf[..., half:ROT_DIM]
    out = jnp.concatenate([x1 * cos - x2 * sin, x2 * cos + x1 * sin, xf[..., ROT_DIM:]], axis=-1)
    return out.astype(x.dtype)


def pool_mixer(x, w_pool, scale):
    B, S, D = x.shape
    xf = x.astype(jnp.float32)
    csp = jnp.pad(jnp.cumsum(xf, axis=1), ((0, 0), (POOL_MAX, 0), (0, 0)))
    t = jnp.arange(S)
    groups = []
    for g, w in enumerate(POOL_WINDOWS):
        sl = slice(g * POOL_GROUP_DIM, (g + 1) * POOL_GROUP_DIM)
        win_sum = csp[:, POOL_MAX:POOL_MAX + S, sl] - csp[:, POOL_MAX - w:POOL_MAX - w + S, sl]
        count = jnp.minimum(t + 1, w).astype(jnp.float32)[None, :, None]
        groups.append(win_sum / count - xf[:, :, sl])
    pooled = jnp.stack(groups, axis=2)
    y = jnp.einsum('bsgc,gcd->bsgd', pooled, w_pool.astype(jnp.float32))
    y = y.reshape(B, S, D) * scale.astype(jnp.float32)
    return y.astype(x.dtype)


def swiglu(x, wg, wu, wd):
    return (jax.nn.silu(x @ wg) * (x @ wu)) @ wd


def moe_swiglu(x, w_router, wg, wu, wd):
    B, S, D = x.shape
    t = x.reshape(B * S, D)
    logits = (t @ w_router).astype(jnp.float32)
    top_v, top_i = lax.top_k(logits, TOP_K)
    top_w = jax.nn.softmax(top_v, axis=-1)
    gates = jnp.sum(jax.nn.one_hot(top_i, N_EXPERTS, dtype=jnp.float32) * top_w[..., None], axis=1)
    y = jnp.zeros((B * S, D), jnp.float32)
    for e in range(N_EXPERTS):
        ye = swiglu(t, wg[e], wu[e], wd[e]).astype(jnp.float32)
        y = y + gates[:, e:e + 1] * ye
    return y.astype(x.dtype).reshape(B, S, D)


def shared_kv(h, kv_norm, wk, wv, pos):
    B, S, D = h.shape
    hn = rms_norm(h, kv_norm)
    k = (hn @ wk).reshape(B, S, N_HEADS, HEAD_DIM).transpose(0, 2, 1, 3)
    v = (hn @ wv).reshape(B, S, N_HEADS, HEAD_DIM).transpose(0, 2, 1, 3)
    k = rope_partial(k, pos)
    n_blocks = -(-S // BLOCK)
    pad = n_blocks * BLOCK - S
    k = jnp.pad(k, ((0, 0), (0, 0), (0, pad), (0, 0)))
    v = jnp.pad(v, ((0, 0), (0, 0), (0, pad), (0, 0)))
    kb = k.reshape(B, N_HEADS, n_blocks, BLOCK, HEAD_DIM)
    vb = v.reshape(B, N_HEADS, n_blocks, BLOCK, HEAD_DIM)
    k_mean = jnp.mean(kb.astype(jnp.float32), axis=3)
    return kb, vb, k_mean


def moba_attention(q, kb, vb, k_mean):
    B, H, S, hd = q.shape
    n_blocks = kb.shape[2]
    ks = min(TOP_BLOCKS, n_blocks)
    scale = hd ** -0.5
    q_blk = jnp.arange(S) // BLOCK
    gate = jnp.einsum('bhsd,bhnd->bhsn', q.astype(jnp.float32), k_mean)
    fully_past = jnp.arange(n_blocks)[None, :] < q_blk[:, None]
    gate = jnp.where(fully_past[None, None], gate, -jnp.inf)
    _, sel = lax.top_k(gate, ks)
    slot_valid = jnp.arange(ks)[None, :] < q_blk[:, None]
    bi = jnp.arange(B)[:, None, None, None]
    hi = jnp.arange(H)[None, :, None, None]

    def chunk(c):
        start = c * Q_CHUNK
        qc = lax.dynamic_slice_in_dim(q, start, Q_CHUNK, axis=2)
        selc = lax.dynamic_slice_in_dim(sel, start, Q_CHUNK, axis=2)
        validc = lax.dynamic_slice_in_dim(slot_valid, start, Q_CHUNK, axis=0)
        kg = kb[bi, hi, selc]
        vg = vb[bi, hi, selc]
        s_sel = jnp.einsum('bhqd,bhqnkd->bhqnk', qc, kg).astype(jnp.float32) * scale
        s_sel = jnp.where(validc[None, None, :, :, None], s_sel, -jnp.inf)
        ob = start // BLOCK
        ko = lax.dynamic_index_in_dim(kb, ob, axis=2, keepdims=False)
        vo = lax.dynamic_index_in_dim(vb, ob, axis=2, keepdims=False)
        s_own = jnp.einsum('bhqd,bhkd->bhqk', qc, ko).astype(jnp.float32) * scale
        kpos = ob * BLOCK + jnp.arange(BLOCK)
        qpos = start + jnp.arange(Q_CHUNK)
        s_own = jnp.where((kpos[None, :] <= qpos[:, None])[None, None], s_own, -jnp.inf)
        logits = jnp.concatenate([s_sel.reshape(B, H, Q_CHUNK, ks * BLOCK), s_own], axis=-1)
        p = jax.nn.softmax(logits, axis=-1).astype(vb.dtype)
        p_sel = p[..., :ks * BLOCK].reshape(B, H, Q_CHUNK, ks, BLOCK)
        p_own = p[..., ks * BLOCK:]
        return (jnp.einsum('bhqnk,bhqnkd->bhqd', p_sel, vg)
                + jnp.einsum('bhqk,bhkd->bhqd', p_own, vo))

    outs = lax.map(chunk, jnp.arange(S // Q_CHUNK))
    return outs.transpose(1, 2, 0, 3, 4).reshape(B, H, S, hd)


def setup_inputs(seed: int = 0) -> dict:
    key = jax.random.key(seed)
    ks = jax.random.split(key, 20)
    D = D_MODEL
    f32 = jnp.float32
    nrm = lambda k, shape, fan: jax.random.normal(k, shape, f32) * (fan ** -0.5)
    return {
        "x": jax.random.normal(ks[0], (BATCH, SEQ, D), f32),
        "attn_norm": 1.0 + 0.02 * jax.random.normal(ks[1], (DEPTH, D), f32),
        "ffn_norm": 1.0 + 0.02 * jax.random.normal(ks[2], (DEPTH, D), f32),
        "pool_w": nrm(ks[3], (N_A, N_POOL_GROUPS, POOL_GROUP_DIM, POOL_GROUP_DIM), POOL_GROUP_DIM),
        "pool_scale": 1.0 + 0.02 * jax.random.normal(ks[4], (N_A, D), f32),
        "wq": nrm(ks[5], (N_B, D, D), D),
        "wo": nrm(ks[6], (N_B, D, D), D),
        "kv_norm": 1.0 + 0.02 * jax.random.normal(ks[7], (D,), f32),
        "wk": nrm(ks[8], (D, D), D),
        "wv": nrm(ks[9], (D, D), D),
        "ffn_w_gate": nrm(ks[10], (N_DENSE, D, D_FF), D),
        "ffn_w_up": nrm(ks[11], (N_DENSE, D, D_FF), D),
        "ffn_w_down": nrm(ks[12], (N_DENSE, D_FF, D), D_FF),
        "router_w": nrm(ks[13], (N_MOE, D, N_EXPERTS), D),
        "moe_w_gate": nrm(ks[14], (N_MOE, N_EXPERTS, D, D_FF_EXPERT), D),
        "moe_w_up": nrm(ks[15], (N_MOE, N_EXPERTS, D, D_FF_EXPERT), D),
        "moe_w_down": nrm(ks[16], (N_MOE, N_EXPERTS, D_FF_EXPERT, D), D_FF_EXPERT),
        "final_norm": 1.0 + 0.02 * jax.random.normal(ks[17], (D,), f32),
    }


def reference(x, attn_norm, ffn_norm, pool_w, pool_scale, wq, wo, kv_norm, wk, wv,
              ffn_w_gate, ffn_w_up, ffn_w_down, router_w, moe_w_gate, moe_w_up, moe_w_down,
              final_norm):
    B, S, D = x.shape
    pos = jnp.arange(S)
    h = x
    kb = vb = k_mean = None
    for l in range(DEPTH):
        hn = rms_norm(h, attn_norm[l])
        if l < N_A:
            h = h + pool_mixer(hn, pool_w[l], pool_scale[l])
        else:
            j = l - N_A
            q = (hn @ wq[j]).reshape(B, S, N_HEADS, HEAD_DIM).transpose(0, 2, 1, 3)
            q = rope_partial(q, pos)
            o = moba_attention(q, kb, vb, k_mean)
            o = o.transpose(0, 2, 1, 3).reshape(B, S, D)
            h = h + o @ wo[j]
        hn = rms_norm(h, ffn_norm[l])
        if l % 2 == 0:
            i = l // 2
            h = h + swiglu(hn, ffn_w_gate[i], ffn_w_up[i], ffn_w_down[i])
        else:
            i = l // 2
            h = h + moe_swiglu(hn, router_w[i], moe_w_gate[i], moe_w_up[i], moe_w_down[i])
        if l == N_A - 1:
            kb, vb, k_mean = shared_kv(h, kv_norm, wk, wv, pos)
    return rms_norm(h, final_norm)
```

```cpp
#include <hip/hip_runtime.h>
#include <cstdio>
#include <cstdint>

#define LAS __attribute__((address_space(3)))
#define GAS __attribute__((address_space(1)))
typedef unsigned short bf16;
typedef short bf16x8 __attribute__((ext_vector_type(8)));
typedef short s16x4 __attribute__((ext_vector_type(4)));
typedef float f32x4 __attribute__((ext_vector_type(4)));
typedef float f32x16 __attribute__((ext_vector_type(16)));
typedef unsigned u32x4 __attribute__((ext_vector_type(4)));
typedef unsigned u32x2 __attribute__((ext_vector_type(2)));
typedef float f32x2 __attribute__((ext_vector_type(2)));
typedef long l64x2 __attribute__((ext_vector_type(2)));
typedef int i32x4 __attribute__((ext_vector_type(4)));
typedef int i32x8 __attribute__((ext_vector_type(8)));

constexpr int T = 32768, D = 1024, SEQ = 4096, NBATCH = 8, NH = 8, HD = 128, FF = 2816, FE = 3584, NE = 8, NBLK = 16;
constexpr float EPS = 1e-6f;
constexpr int NWAVES = 8;
constexpr int MOE_ROWS_MAX = 2 * T + NE * 256;
constexpr int MOE_TILES_MAX = MOE_ROWS_MAX / 256;
constexpr int CHUNK_TILES = 64;
constexpr int CONV_WGS = 64;
constexpr int MOE_STEPS = 5;

constexpr size_t MiB = 1u << 20, KiB = 1u << 10;
constexpr size_t WS_CTL = 0, CTL_ZERO_BYTES = 64 * KiB;
constexpr size_t WS_ROPE_C = 1 * MiB, WS_ROPE_S = 1 * MiB + 256 * KiB;
constexpr size_t WS_KMEAN = 1 * MiB + 512 * KiB;
constexpr size_t WS_SS1 = 2 * MiB, WS_SS2 = 4 * MiB, WS_SS3 = 6 * MiB;
constexpr size_t WS_RSTD3 = 8 * MiB;
constexpr size_t WS_GATEW = 8 * MiB + 128 * KiB;
constexpr size_t WS_ENT = 8 * MiB + 384 * KiB;
constexpr size_t WS_BCNT = 8 * MiB + 640 * KiB;
constexpr size_t WS_SOFF = 9 * MiB, WS_SRSTD = 9 * MiB + 512 * KiB, WS_SDST = 10 * MiB, WS_SGW = 10 * MiB + 512 * KiB;
constexpr size_t WS_TEXP = 11 * MiB;
constexpr size_t WS_W_POOL = 12 * MiB;
constexpr size_t WS_W_QKV = WS_W_POOL + 512 * KiB;
constexpr size_t WS_W_WO = WS_W_QKV + 6 * MiB;
constexpr size_t WS_W_FGU = WS_W_WO + 2 * MiB;
constexpr size_t WS_W_FD = WS_W_FGU + 11 * MiB;
constexpr size_t WS_PART = WS_W_FD + 5 * MiB + 512 * KiB;
constexpr size_t WS_W_MGU = WS_PART + 84 * MiB;
constexpr size_t WS_W_MD = WS_W_MGU + 56 * MiB;
constexpr size_t WS_H = WS_W_MD + 28 * MiB;
constexpr size_t WS_R = WS_H + 64 * MiB;
constexpr size_t WS_POOLED = WS_R;
constexpr size_t WS_FACT = WS_R;
constexpr size_t WS_Q = WS_R, WS_K = WS_R + 64 * MiB, WS_V = WS_R + 128 * MiB;
constexpr size_t WS_MLP = WS_R + 192 * MiB;
constexpr size_t WS_MLOWN = WS_R + 198 * MiB;
constexpr size_t WS_SEL = WS_SS1;
constexpr size_t WS_ACT0 = WS_R, WS_ACT1 = WS_R + 56 * MiB;
constexpr size_t WS_ACT2 = WS_R + 112 * MiB;
constexpr size_t WS_H8 = WS_R + 120 * MiB;
constexpr size_t WS_Y8 = WS_R + 152 * MiB;
constexpr size_t WS_END = WS_R + 239 * MiB;
constexpr float W8S_GU = 32.f, W8S_DN = 64.f, ACT8S = 4.f;
static_assert(WS_H == 205 * MiB && WS_END == 508 * MiB && WS_PART + (size_t)64 * 10752 * 128 == WS_W_MGU, "ws map");
constexpr int CW_TMO = 0, CW_CODE = 1, CW_BAR = 4096, CW_NTILES = 8192, CW_CONVQ = 8256, CW_KVQ = 8448;

constexpr int RING_OFF = 0, RING_BYTES = 131072;
constexpr int LDSCTL_OFF = RING_BYTES, MISC_OFF = LDSCTL_OFF + 320, XTRA_OFF = LDSCTL_OFF + 1024;
constexpr int LDS_BYTES = 155648;

#define RLX_AGENT __ATOMIC_RELAXED, __HIP_MEMORY_SCOPE_AGENT
#define LDS_WAIT() asm volatile("s_waitcnt lgkmcnt(0)" ::: "memory")
#define VM_WAIT() asm volatile("s_waitcnt vmcnt(0)" ::: "memory")
__device__ __forceinline__ unsigned f2bf(float f) { unsigned u = __builtin_bit_cast(unsigned, f); return (u + 0x7fffu + ((u >> 16) & 1u)) >> 16; }
__device__ __forceinline__ unsigned pk2(float lo, float hi) { return f2bf(lo) | (f2bf(hi) << 16); }
__device__ __forceinline__ unsigned cvt_pk_bf16(float lo, float hi) { unsigned r; asm volatile("v_cvt_pk_bf16_f32 %0, %1, %2" : "=v"(r) : "v"(lo), "v"(hi)); return r; }
typedef float f32x2v __attribute__((ext_vector_type(2)));
__device__ __forceinline__ void up4_fp8(unsigned w, float (&f)[4]) { const f32x2v lo = __builtin_amdgcn_cvt_pk_f32_fp8((int)w, false), hi = __builtin_amdgcn_cvt_pk_f32_fp8((int)w, true); f[0] = lo[0]; f[1] = lo[1]; f[2] = hi[0]; f[3] = hi[1]; }
__device__ __forceinline__ unsigned pk4_fp8(float a, float b, float c, float d) { int w = 0; w = __builtin_amdgcn_cvt_pk_fp8_f32(a, b, w, false); w = __builtin_amdgcn_cvt_pk_fp8_f32(c, d, w, true); return (unsigned)w; }
__device__ __forceinline__ float bflo(unsigned w) { return __builtin_bit_cast(float, w << 16); }
__device__ __forceinline__ float bfhi(unsigned w) { return __builtin_bit_cast(float, w & 0xffff0000u); }
__device__ __forceinline__ float wave_sum(float v) {
#pragma unroll
    for (int o = 1; o < 64; o <<= 1) v += __shfl_xor(v, o);
    return v;
}

namespace pg8 {
constexpr int BM = 256, BK = 64, HALF = 128, HTB = HALF * BK * 2, STAGE_BYTES = 8 * HTB, NXCD = 8, WGM = 8;
constexpr int GSLOT_OFF = 132096, RSLOT_OFF = 132096 + 8192;
__host__ __device__ __forceinline__ int lds_byte(int r, int c) { return (r >> 3) * 1024 + (r & 7) * 128 + ((((c >> 3) ^ (r >> 1)) & 7) << 4) + (c & 7) * 2; }
__host__ __device__ __forceinline__ void stage_rc(int b, int& R, int& C) { const int q = b / 1024, p = b % 1024, rr = p / 128, cq = (p % 128) / 16; R = q * 8 + rr; C = ((cq ^ (R >> 1)) & 7) * 8; }
__host__ __device__ __forceinline__ int perm32(int rho) { const int n = rho >> 4, i = rho & 15; return 8 * (i >> 2) + 4 * n + (i & 3); }
struct Unit { int pm, pn; };
struct StaticOrder {
    int nM, nN, nwg, G, c;
    __device__ void init(int nM_, int nN_, int G_, int c_) { nM = nM_; nN = nN_; nwg = nM * nN; G = G_; c = c_; }
    __device__ bool next(int i, Unit& u) const {
        const long L = (long)i * G + c; if (L >= nwg) return false;
        int wgid = (int)L; { const int q = nwg / NXCD, r = nwg % NXCD, xcd = wgid % NXCD, off = wgid / NXCD; wgid = (xcd < r ? xcd * (q + 1) : r * (q + 1) + (xcd - r) * q) + off; }
        const int nig = WGM * nN, gid = wgid / nig, fm = gid * WGM, gsz = (nM - fm) < WGM ? (nM - fm) : WGM;
        u.pm = fm + ((wgid % nig) % gsz); u.pn = (wgid % nig) / gsz; return true;
    }
};
template <class P, class Epi, class Sched>
__device__ __forceinline__ void gemm_phase(LAS unsigned char* lds, const P& pr, const Sched& S, const Epi& E) {
    int tid_ = threadIdx.x; asm volatile("" : "+v"(tid_));
    const int tid = tid_, wid = __builtin_amdgcn_readfirstlane(tid >> 6), lane = tid & 63, wr = wid >> 2, wc = wid & 3, fr = lane & 15, fq = lane >> 4;
    const int K = pr.K, nt = K / BK;
    unsigned voffB[2], vcA[2][2]; int Rr[2]; unsigned Cc[2];
#pragma unroll
    for (int i = 0; i < 2; ++i) { int R, C; stage_rc(tid * 16 + i * 8192, R, C); const int Rb = (R & ~31) + perm32(R & 31);
        voffB[i] = (unsigned)(Rb * K + C) * 2u; Rr[i] = R; Cc[i] = (unsigned)C * 2u; }
    const size_t kstep = (size_t)(BK * 2);
    const size_t hstepB = (size_t)HALF * K * 2;
    const unsigned ldsw = (unsigned)wid * 1024u;
    const int aoff0 = lds_byte(wr * 64 + fr, fq * 8), boff0 = lds_byte(wc * 32 + fr, fq * 8);
#define PG8_SA(b, h) (((b) * 2 + (h)) * HTB)
#define PG8_SB(b, h) ((4 + (b) * 2 + (h)) * HTB)
#define PG8_STAGE(bufoff, gbase, voff) do { _Pragma("unroll") for (int _i = 0; _i < 2; ++_i) { unsigned vo_ = (voff)[_i]; asm volatile("" : "+v"(vo_));     \
        __builtin_amdgcn_global_load_lds((const unsigned*)((const char*)(gbase) + vo_), (LAS unsigned*)(lds + (bufoff) + ldsw + _i * 8192), 16, 0, 0); } } while (0)
#define PG8_X64(o1, o0) int o1; asm volatile("v_xor_b32 %0, 64, %1" : "=v"(o1) : "v"(o0))
#define PG8_LDA(dst, b, h) do { PG8_X64(aoff1, aoff0); _Pragma("unroll") for (int m = 0; m < 4; ++m) { dst[m][0] = *(const LAS bf16x8*)(lds + PG8_SA(b, h) + aoff0 + m * 2048); dst[m][1] = *(const LAS bf16x8*)(lds + PG8_SA(b, h) + aoff1 + m * 2048); } } while (0)
#define PG8_LDB(dst, b, h) do { PG8_X64(boff1, boff0); _Pragma("unroll") for (int n = 0; n < 2; ++n) { dst[n][0] = *(const LAS bf16x8*)(lds + PG8_SB(b, h) + boff0 + n * 2048); dst[n][1] = *(const LAS bf16x8*)(lds + PG8_SB(b, h) + boff1 + n * 2048); } } while (0)
#define PG8_MMA(ai, bj, At, Bt) do { __builtin_amdgcn_s_setprio(1); \
        if constexpr (P::FP8) { _Pragma("unroll") for (int m = 0; m < 4; ++m) _Pragma("unroll") for (int n = 0; n < 2; ++n) { \
            const i32x8 a8_ = __builtin_shufflevector(__builtin_bit_cast(i32x4, At[m][0]), __builtin_bit_cast(i32x4, At[m][1]), 0, 1, 2, 3, 4, 5, 6, 7); \
            const i32x8 b8_ = __builtin_shufflevector(__builtin_bit_cast(i32x4, Bt[n][0]), __builtin_bit_cast(i32x4, Bt[n][1]), 0, 1, 2, 3, 4, 5, 6, 7); \
            asm volatile("v_mfma_scale_f32_16x16x128_f8f6f4 %0, %1, %2, %0, %3, %3 op_sel_hi:[0,0,0]" : "+v"(acc[ai][bj][m][n]) : "v"(b8_), "v"(a8_), "v"(sc1_)); } }     \
        else { _Pragma("unroll") for (int m = 0; m < 4; ++m) _Pragma("unroll") for (int n = 0; n < 2; ++n) _Pragma("unroll") for (int k = 0; k < 2; ++k) \
            acc[ai][bj][m][n] = __builtin_amdgcn_mfma_f32_16x16x32_bf16(Bt[n][k], At[m][k], acc[ai][bj][m][n], 0, 0, 0); } \
        __builtin_amdgcn_s_setprio(0); } while (0)
#define PG8_MMA0(ai, bj, At, Bt) do { __builtin_amdgcn_s_setprio(1);        \
        if constexpr (P::FP8) { _Pragma("unroll") for (int m = 0; m < 4; ++m) _Pragma("unroll") for (int n = 0; n < 2; ++n) { \
            const i32x8 a8_ = __builtin_shufflevector(__builtin_bit_cast(i32x4, At[m][0]), __builtin_bit_cast(i32x4, At[m][1]), 0, 1, 2, 3, 4, 5, 6, 7); \
            const i32x8 b8_ = __builtin_shufflevector(__builtin_bit_cast(i32x4, Bt[n][0]), __builtin_bit_cast(i32x4, Bt[n][1]), 0, 1, 2, 3, 4, 5, 6, 7); \
            asm volatile("v_mfma_scale_f32_16x16x128_f8f6f4 %0, %1, %2, 0, %3, %3 op_sel_hi:[0,0,0]" : "=v"(acc[ai][bj][m][n]) : "v"(b8_), "v"(a8_), "v"(sc1_)); } } \
        else { _Pragma("unroll") for (int m = 0; m < 4; ++m) _Pragma("unroll") for (int n = 0; n < 2; ++n) { \
            acc[ai][bj][m][n] = __builtin_amdgcn_mfma_f32_16x16x32_bf16(Bt[n][0], At[m][0], (f32x4){0.f, 0.f, 0.f, 0.f}, 0, 0, 0); \
            acc[ai][bj][m][n] = __builtin_amdgcn_mfma_f32_16x16x32_bf16(Bt[n][1], At[m][1], acc[ai][bj][m][n], 0, 0, 0); } } \
        __builtin_amdgcn_s_setprio(0); } while (0)
#define PG8_WAIT_V(n) asm volatile("s_waitcnt vmcnt(" #n ")" ::: "memory")
#define PG8_WAIT_L(n) asm volatile("s_waitcnt lgkmcnt(" #n ")" ::: "memory")
#define PG8_BAR __builtin_amdgcn_s_barrier()
#define PG8_SCHED __builtin_amdgcn_sched_barrier(0)
    Unit cur, nxt; int ui = 0;
    if (!S.next(0, cur)) return;
    int sc1_ = 0x7f7f7f7f; asm volatile("" : "+v"(sc1_));
    f32x4 acc[2][2][4][2];
    bf16x8 At[4][2], B0[2][2], B1[2][2];
    const char* cA = pr.a_base(cur); const char* cB = pr.b_base(cur);
    if constexpr (Epi::PREFETCH) E.prefetch(lds, cur, ldsw, lane);
    if constexpr (P::GATHER) {
        const unsigned* rl = pr.rows(cur);
#pragma unroll
        for (int h = 0; h < 2; ++h)
#pragma unroll
            for (int i = 0; i < 2; ++i) vcA[h][i] = rl[h * HALF + Rr[i]] + Cc[i];
    } else {
#pragma unroll
        for (int h = 0; h < 2; ++h)
#pragma unroll
            for (int i = 0; i < 2; ++i) vcA[h][i] = (unsigned)((h * HALF + Rr[i]) * pr.lda) * 2u + Cc[i];
    }
    PG8_STAGE(PG8_SB(0, 0), cB, voffB); PG8_STAGE(PG8_SB(0, 1), cB + hstepB, voffB); PG8_STAGE(PG8_SA(0, 0), cA, vcA[0]); PG8_STAGE(PG8_SA(0, 1), cA, vcA[1]);
    if (wr == 1) PG8_BAR;
    PG8_WAIT_V(2); PG8_BAR;
    PG8_STAGE(PG8_SB(1, 0), cB + kstep, voffB); PG8_STAGE(PG8_SA(1, 0), cA + kstep, vcA[0]); PG8_STAGE(PG8_SB(1, 1), cB + hstepB + kstep, voffB);
    PG8_WAIT_V(6); PG8_BAR;
    for (;;) {
        const bool has_next = S.next(ui + 1, nxt);
        const char* nA = has_next ? pr.a_base(nxt) : cA; const char* nB = has_next ? pr.b_base(nxt) : cB;
        if constexpr (P::GATHER) {
            if (has_next) { const unsigned* rn = pr.rows(nxt);
#pragma unroll
                for (int h = 0; h < 2; ++h)
#pragma unroll
                    for (int i = 0; i < 2; ++i) { int t2 = threadIdx.x; asm volatile("" : "+v"(t2)); int R2, C2; stage_rc(t2 * 16 + i * 8192, R2, C2);
                        __builtin_amdgcn_global_load_lds(rn + h * HALF + R2, (LAS unsigned*)(lds + GSLOT_OFF + ldsw + (h * 2 + i) * 256), 4, 0, 0); } }
        }
        for (int t = 0; t < nt; t += 2) {
            const bool last = (t == nt - 2);
            const char* a1 = cA + (size_t)(t + 1) * kstep;
            const char* a2 = last ? nA : cA + (size_t)(t + 2) * kstep; const char* b2 = last ? nB : cB + (size_t)(t + 2) * kstep;
            const char* a3 = a2 + kstep; const char* b3 = b2 + kstep;
            PG8_LDB(B0, 0, 0); PG8_LDB(B1, 0, 1); PG8_SCHED; PG8_LDA(At, 0, 0); PG8_STAGE(PG8_SA(1, 1), a1, vcA[1]);
            if constexpr (P::GATHER) { if (last && has_next) {
#pragma unroll
                for (int h = 0; h < 2; ++h)
#pragma unroll
                    for (int i = 0; i < 2; ++i) { int t3 = threadIdx.x; asm volatile("" : "+v"(t3)); int R3, C3; stage_rc(t3 * 16 + i * 8192, R3, C3);
                        vcA[h][i] = *(const LAS unsigned*)(lds + GSLOT_OFF + ldsw + (h * 2 + i) * 256 + (t3 & 63) * 4) + (unsigned)C3 * 2u; } } }
            PG8_WAIT_V(8); PG8_WAIT_L(0); PG8_BAR; if (t == 0) { PG8_MMA0(0, 0, At, B0); PG8_MMA0(0, 1, At, B1); } else { PG8_MMA(0, 0, At, B0); PG8_MMA(0, 1, At, B1); } PG8_BAR; PG8_SCHED;
            PG8_LDA(At, 0, 1); PG8_STAGE(PG8_SB(0, 0), b2, voffB); PG8_STAGE(PG8_SB(0, 1), b2 + hstepB, voffB); PG8_STAGE(PG8_SA(0, 0), a2, vcA[0]);
            PG8_WAIT_V(8); PG8_WAIT_L(0); PG8_BAR; if (t == 0) { PG8_MMA0(1, 0, At, B0); PG8_MMA0(1, 1, At, B1); } else { PG8_MMA(1, 0, At, B0); PG8_MMA(1, 1, At, B1); } PG8_BAR; PG8_SCHED;
            PG8_LDB(B0, 1, 0); PG8_LDB(B1, 1, 1); PG8_SCHED; PG8_LDA(At, 1, 0); PG8_STAGE(PG8_SA(0, 1), a2, vcA[1]);
            PG8_WAIT_V(8); PG8_WAIT_L(0); PG8_BAR; PG8_MMA(0, 0, At, B0); PG8_MMA(0, 1, At, B1); PG8_BAR; PG8_SCHED;
            PG8_LDA(At, 1, 1); PG8_STAGE(PG8_SB(1, 0), b3, voffB); PG8_STAGE(PG8_SB(1, 1), b3 + hstepB, voffB); PG8_STAGE(PG8_SA(1, 0), a3, vcA[0]);
            PG8_WAIT_V(8); PG8_WAIT_L(0); PG8_BAR; PG8_MMA(1, 0, At, B0); PG8_MMA(1, 1, At, B1); PG8_BAR; PG8_SCHED;
        }
        if (wr == 0) PG8_BAR;
        if constexpr (P::FP8) asm volatile("s_nop 15\n\ts_nop 15" ::: "memory");
        { int te_ = threadIdx.x; asm volatile("" : "+v"(te_)); const int fr_e = te_ & 15, fq_e = (te_ >> 4) & 3;
          if constexpr (Epi::PREFETCH) E.run(acc, cur, wr, wc, fr_e, fq_e, lds, ldsw); else E(acc, cur, wr, wc, fr_e, fq_e); }
        if (!has_next) break;
        cur = nxt; cA = nA; cB = nB; ++ui;
        if constexpr (Epi::PREFETCH) { int tp_ = threadIdx.x; asm volatile("" : "+v"(tp_)); E.prefetch(lds, cur, ldsw, tp_ & 63); }
        if (wr == 1) PG8_BAR;
    }
    PG8_WAIT_V(0);
    PG8_BAR;
#undef PG8_SA
#undef PG8_SB
#undef PG8_STAGE
#undef PG8_LDA
#undef PG8_X64
#undef PG8_LDB
#undef PG8_MMA
#undef PG8_MMA0
#undef PG8_WAIT_V
#undef PG8_WAIT_L
#undef PG8_BAR
#undef PG8_SCHED
}
}

#ifndef FFN1_FP8
#define FFN1_FP8 0
#endif
#ifndef FFN2_FP8
#define FFN2_FP8 1
#endif
#ifndef WO_FP8
#define WO_FP8 1
#endif
constexpr float O8S = 16.f;
constexpr float P8S = 16.f, Y8S = 16.f;
#ifndef QKV_FP8
#define QKV_FP8 1
#endif
template <bool F8> struct ProbDenseT {
    static constexpr bool GATHER = false, FP8 = F8;
    const char* A; const char* B; int K, lda; int a_pn_step;
    __device__ __forceinline__ const char* a_base(const pg8::Unit& u) const { return A + (size_t)u.pm * 256 * lda * 2 + (size_t)u.pn * a_pn_step; }
    __device__ __forceinline__ const char* b_base(const pg8::Unit& u) const { return B + (size_t)u.pn * 256 * K * 2; }
    __device__ __forceinline__ const unsigned* rows(const pg8::Unit&) const { return nullptr; }
};
typedef ProbDenseT<false> ProbDense;
__device__ __forceinline__ int moe_tile(int pm, int mt0, int nmain) { return pm < nmain ? mt0 + pm : 256 + pm - nmain; }
struct ProbMoeG1 {
    static constexpr bool GATHER = true, FP8 = true;
    const char* A; const char* B; int K, lda; const unsigned* soff; const LAS int* texp; int mt0, nmain;
    __device__ __forceinline__ const char* a_base(const pg8::Unit&) const { return A; }
    __device__ __forceinline__ const char* b_base(const pg8::Unit& u) const { const int e = texp[moe_tile(u.pm, mt0, nmain)]; return B + ((size_t)e * (2 * FE) + (size_t)u.pn * 256) * D; }
    __device__ __forceinline__ const unsigned* rows(const pg8::Unit& u) const { return soff + (size_t)moe_tile(u.pm, mt0, nmain) * 256; }
};
struct ProbMoeG2 {
    static constexpr bool GATHER = false, FP8 = true;
    const char* A; const char* A2; const char* B; int K, lda; const LAS int* texp; int mt0, nmain;
    __device__ __forceinline__ const char* a_base(const pg8::Unit& u) const { return u.pm < nmain ? A + (size_t)u.pm * 256 * FE : A2 + (size_t)(u.pm - nmain) * 256 * FE; }
    __device__ __forceinline__ const char* b_base(const pg8::Unit& u) const { const int e = texp[moe_tile(u.pm, mt0, nmain)]; return B + ((size_t)e * D + (size_t)u.pn * 256) * FE; }
    __device__ __forceinline__ const unsigned* rows(const pg8::Unit&) const { return nullptr; }
};
struct SkewOrder : pg8::StaticOrder {
    int e;
    __device__ bool next(int i, pg8::Unit& u) const {
        long L;
        if (c < e) { if (i >= 3) return false; L = (long)i * G + c; }
        else if (i < 7) L = (long)i * G + c;
        else { const int rho = c - e; if (i > 7 || rho >= 4 * e) return false; L = (long)(3 + rho / e) * G + (rho % e); }
        if (L >= nwg) return false;
        int wgid = (int)L; { const int q = nwg / pg8::NXCD, r = nwg % pg8::NXCD, xcd = wgid % pg8::NXCD, off = wgid / pg8::NXCD; wgid = (xcd < r ? xcd * (q + 1) : r * (q + 1) + (xcd - r) * q) + off; }
        const int nig = pg8::WGM * nN, gid = wgid / nig, fm = gid * pg8::WGM, gsz = (nM - fm) < pg8::WGM ? (nM - fm) : pg8::WGM;
        u.pm = fm + ((wgid % nig) % gsz); u.pn = (wgid % nig) / gsz; return true;
    }
};

__device__ __forceinline__ void rstd_rows(const float* ss, int row0  , int fq, float (&rs)[2][4]) {
#pragma unroll
    for (int ai = 0; ai < 2; ++ai)
#pragma unroll
        for (int m = 0; m < 4; ++m) {
            const f32x4 p = *(const f32x4*)(ss + (size_t)(row0 + ai * 128 + m * 16) * 16 + 4 * fq);
            float s = (p[0] + p[1]) + (p[2] + p[3]);
            s += __shfl_xor(s, 16); s += __shfl_xor(s, 32);
            rs[ai][m] = __builtin_amdgcn_rsqf(s * (1.0f / D) + EPS);
        }
}
struct RstdTable {
    const float* ss; mutable int prev_pm; mutable int par;
    __device__ __forceinline__ void update(LAS unsigned char* lds, const pg8::Unit& u) const {
        if (u.pm != prev_pm) { prev_pm = u.pm; par ^= 1;
            int t_ = threadIdx.x; asm volatile("" : "+v"(t_)); const int t = t_, row = t >> 1, hf = t & 1;
            const float* p = ss + ((size_t)u.pm * 256 + row) * 16 + hf * 8;
            const f32x4 a = *(const f32x4*)p, b = *(const f32x4*)(p + 4);
            float s = ((a[0] + a[1]) + (a[2] + a[3])) + ((b[0] + b[1]) + (b[2] + b[3]));
            s += __shfl_xor(s, 1);
            if (hf == 0) *(LAS float*)(lds + pg8::RSLOT_OFF + par * 1024 + row * 4) = __builtin_amdgcn_rsqf(s * (1.0f / D) + EPS); }
    }
    __device__ __forceinline__ void rows(LAS unsigned char* lds, int wr, int fr, float (&rs)[2][4]) const {
#pragma unroll
        for (int ai = 0; ai < 2; ++ai)
#pragma unroll
            for (int m = 0; m < 4; ++m) rs[ai][m] = *(const LAS float*)(lds + pg8::RSLOT_OFF + par * 1024 + (ai * 128 + wr * 64 + m * 16 + fr) * 4);
    }
};
__device__ __forceinline__ float silu_mul(float g, float u) { return g * u * __builtin_amdgcn_rcpf(1.0f + __builtin_amdgcn_exp2f(-1.4426950408889634f * g)); }
__device__ __forceinline__ f32x4 silu4(f32x4 gp, f32x4 up) {
    f32x4 e; e[0] = __builtin_amdgcn_exp2f(gp[0]); e[1] = __builtin_amdgcn_exp2f(gp[1]); e[2] = __builtin_amdgcn_exp2f(gp[2]); e[3] = __builtin_amdgcn_exp2f(gp[3]);
    const f32x4 d = e + 1.0f; f32x4 q; q[0] = __builtin_amdgcn_rcpf(d[0]); q[1] = __builtin_amdgcn_rcpf(d[1]); q[2] = __builtin_amdgcn_rcpf(d[2]); q[3] = __builtin_amdgcn_rcpf(d[3]);
    return (gp * up) * q;
}

template <bool BASE_F32> struct EpiRes {
    static constexpr bool PREFETCH = false;
    const float* x; bf16* h; float* ss; unsigned char* h8; float sc;
    __device__ __forceinline__ void operator()(const f32x4 (&acc)[2][2][4][2], const pg8::Unit& u, int wr, int wc, int fr, int fq) const {
        const int row0 = u.pm * 256 + wr * 64 + fr, col0 = u.pn * 256 + wc * 32 + 8 * fq;
#pragma unroll
        for (int ai = 0; ai < 2; ++ai)
#pragma unroll
            for (int m = 0; m < 4; ++m) {
                const int row = row0 + ai * 128 + m * 16; float q = 0.f;
#pragma unroll
                for (int bj = 0; bj < 2; ++bj) {
                    f32x4 v0, v1; const size_t off = (size_t)row * D + col0 + bj * 128;
                    if constexpr (BASE_F32) { v0 = *(const f32x4*)(x + off); v1 = *(const f32x4*)(x + off + 4); }
                    else { const u32x4 w = *(const u32x4*)(h + off); v0 = (f32x4){bflo(w.x), bfhi(w.x), bflo(w.y), bfhi(w.y)}; v1 = (f32x4){bflo(w.z), bfhi(w.z), bflo(w.w), bfhi(w.w)}; }
                    v0 += acc[ai][bj][m][0] * sc; v1 += acc[ai][bj][m][1] * sc;
                    q += (v0[0] * v0[0] + v0[1] * v0[1]) + (v0[2] * v0[2] + v0[3] * v0[3]) + (v1[0] * v1[0] + v1[1] * v1[1]) + (v1[2] * v1[2] + v1[3] * v1[3]);
                    u32x4 o; o.x = cvt_pk_bf16(v0[0], v0[1]); o.y = cvt_pk_bf16(v0[2], v0[3]); o.z = cvt_pk_bf16(v1[0], v1[1]); o.w = cvt_pk_bf16(v1[2], v1[3]);
                    *(u32x4*)(h + off) = o;
                    if (h8) { u32x2 o8; o8.x = pk4_fp8(v0[0], v0[1], v0[2], v0[3]); o8.y = pk4_fp8(v1[0], v1[1], v1[2], v1[3]); *(u32x2*)(h8 + off) = o8; }
                }
                q += __shfl_xor(q, 16); q += __shfl_xor(q, 32);
                if (fq == 0) ss[(size_t)row * 16 + u.pn * 4 + wc] = q;
            }
    }
};
template <bool MOE, int LDO, bool O8 = MOE, bool W8 = MOE> struct EpiSwiGLU {
    static constexpr bool PREFETCH = true;
    bf16* act; RstdTable tab; const float* srstd; int mt0; int nmain; bf16* act2;
    __device__ __forceinline__ void prefetch(LAS unsigned char* lds, const pg8::Unit& u, unsigned ldsw, int lane) const {
        if constexpr (!MOE) { tab.update(lds, u); return; }
        const float* sp = srstd + (size_t)moe_tile(u.pm, mt0, nmain) * 256 + lane;
#pragma unroll
        for (int k = 0; k < 4; ++k) __builtin_amdgcn_global_load_lds((const unsigned*)(sp + k * 64), (LAS unsigned*)(lds + pg8::RSLOT_OFF + ldsw + k * 256), 4, 0, 0);
    }
    __device__ __forceinline__ void run(const f32x4 (&acc)[2][2][4][2], const pg8::Unit& u, int wr, int wc, int fr, int fq, LAS unsigned char* lds, unsigned ldsw) const {
        float rs[2][4];
        if constexpr (MOE) {
#pragma unroll
            for (int ai = 0; ai < 2; ++ai)
#pragma unroll
                for (int m = 0; m < 4; ++m) rs[ai][m] = *(const LAS float*)(lds + pg8::RSLOT_OFF + ldsw + (ai * 128 + wr * 64 + m * 16 + fr) * 4);
        } else tab.rows(lds, wr, fr, rs);
        body(acc, u, wr, wc, fr, fq, rs);
    }
    __device__ __forceinline__ void body(const f32x4 (&acc)[2][2][4][2], const pg8::Unit& u, int wr, int wc, int fr, int fq, const float (&rs)[2][4]) const {
        constexpr int ES = O8 ? 1 : 2;
        char* ob = (MOE && u.pm >= nmain) ? (char*)act2 + ((size_t)(u.pm - nmain) * 256 * LDO + (size_t)u.pn * 128) * ES : (char*)act + ((size_t)u.pm * 256 * LDO + (size_t)u.pn * 128) * ES;
        const unsigned vo = (unsigned)((wr * 64 + fr) * LDO + wc * 32 + 8 * fq) * (unsigned)ES;
#pragma unroll
        for (int ai = 0; ai < 2; ++ai)
#pragma unroll
            for (int m = 0; m < 4; ++m) {
                const float r = W8 ? rs[ai][m] * (1.0f / W8S_GU) : rs[ai][m];
                const float rg = r * -1.4426950408889634f, ru = r * (O8 ? -0.6931471805599453f * ACT8S : -0.6931471805599453f);
                const f32x4 s0 = silu4(acc[ai][0][m][0] * rg, acc[ai][1][m][0] * ru), s1 = silu4(acc[ai][0][m][1] * rg, acc[ai][1][m][1] * ru);
                if constexpr (O8) { u32x2 o; o.x = pk4_fp8(s0[0], s0[1], s0[2], s0[3]); o.y = pk4_fp8(s1[0], s1[1], s1[2], s1[3]);
                    *(u32x2*)(ob + (size_t)((ai * 128 + m * 16) * LDO) + vo) = o; }
                else {
                u32x4 o; o.x = cvt_pk_bf16(s0[0], s0[1]); o.y = cvt_pk_bf16(s0[2], s0[3]); o.z = cvt_pk_bf16(s1[0], s1[1]); o.w = cvt_pk_bf16(s1[2], s1[3]);
                *(u32x4*)(ob + (size_t)((ai * 128 + m * 16) * LDO * 2) + vo) = o; }
            }
    }
};
struct EpiQKV {
    static constexpr bool PREFETCH = true;
    bf16* Q; RstdTable tab; const float* rc; const float* rsn; float* kmean;
    __device__ __forceinline__ void prefetch(LAS unsigned char* lds, const pg8::Unit& u, unsigned ldsw, int lane) const { tab.update(lds, u); }
    __device__ __forceinline__ void run(const f32x4 (&acc)[2][2][4][2], const pg8::Unit& u, int wr, int wc, int fr, int fq, LAS unsigned char* lds, unsigned ldsw) const {
        const int row0 = u.pm * 256 + wr * 64 + fr; const int which = u.pn >> 2;
        bf16* O = Q + (size_t)which * ((WS_K - WS_Q) / 2);
        const int col0 = (u.pn & 3) * 256 + wc * 32 + 8 * fq;
        float rs[2][4]; tab.rows(lds, wr, fr, rs);
        f32x4 ks[2][2];
#pragma unroll
        for (int bj = 0; bj < 2; ++bj) { ks[bj][0] = (f32x4){0.f, 0.f, 0.f, 0.f}; ks[bj][1] = (f32x4){0.f, 0.f, 0.f, 0.f}; }
#pragma unroll
        for (int ai = 0; ai < 2; ++ai)
#pragma unroll
            for (int m = 0; m < 4; ++m) {
                const int row = row0 + ai * 128 + m * 16; const float r = QKV_FP8 ? rs[ai][m] * (1.0f / W8S_GU) : rs[ai][m];
                f32x4 cs = (f32x4){1.f, 1.f, 1.f, 1.f}, sn = (f32x4){0.f, 0.f, 0.f, 0.f};
                if (which < 2 && wc == 0) { const int pos = row & (SEQ - 1); cs = *(const f32x4*)(rc + pos * 16 + 4 * fq); sn = *(const f32x4*)(rsn + pos * 16 + 4 * fq); }
#pragma unroll
                for (int bj = 0; bj < 2; ++bj) {
                    f32x4 v0 = acc[ai][bj][m][0] * r, v1 = acc[ai][bj][m][1] * r;
                    if (which < 2 && wc == 0) { const f32x4 a = v0 * cs - v1 * sn, b = v1 * cs + v0 * sn; v0 = a; v1 = b; }
                    if (which == 1) { ks[bj][0] += v0; ks[bj][1] += v1; }
                    u32x4 o; o.x = cvt_pk_bf16(v0[0], v0[1]); o.y = cvt_pk_bf16(v0[2], v0[3]); o.z = cvt_pk_bf16(v1[0], v1[1]); o.w = cvt_pk_bf16(v1[2], v1[3]);
                    *(u32x4*)(O + (size_t)row * D + col0 + bj * 128) = o;
                }
            }
        if (which == 1) {
            const int b = u.pm >> 4, blk = u.pm & 15;
#pragma unroll
            for (int bj = 0; bj < 2; ++bj)
#pragma unroll
                for (int n = 0; n < 2; ++n) { f32x4 s = ks[bj][n];
#pragma unroll
                    for (int o = 1; o < 16; o <<= 1) { s[0] += __shfl_xor(s[0], o); s[1] += __shfl_xor(s[1], o); s[2] += __shfl_xor(s[2], o); s[3] += __shfl_xor(s[3], o); }
                    if (fr == 0) { const int head = (u.pn & 3) * 2 + bj; float* kp = kmean + ((size_t)(b * NH + head) * NBLK + blk) * HD + wc * 32 + 8 * fq + 4 * n;
                        atomicAdd(kp + 0, s[0]); atomicAdd(kp + 1, s[1]); atomicAdd(kp + 2, s[2]); atomicAdd(kp + 3, s[3]); } }
        }
    }
};
struct EpiMoeOut {
    static constexpr bool PREFETCH = false;
    unsigned char* Y; const int* sdst; const float* sgw; int mt0, nmain;
    __device__ __forceinline__ void operator()(const f32x4 (&acc)[2][2][4][2], const pg8::Unit& u, int wr, int wc, int fr, int fq) const {
        const int row0 = moe_tile(u.pm, mt0, nmain) * 256 + wr * 64 + fr, col0 = u.pn * 256 + wc * 32 + 8 * fq;
#pragma unroll
        for (int ai = 0; ai < 2; ++ai)
#pragma unroll
            for (int m = 0; m < 4; ++m) {
                const int sr = row0 + ai * 128 + m * 16; const int dst = sdst[sr]; const float g = sgw[sr] * (Y8S / (W8S_DN * ACT8S));
                if (dst >= 0) {
#pragma unroll
                    for (int bj = 0; bj < 2; ++bj) { const f32x4 v0 = acc[ai][bj][m][0] * g, v1 = acc[ai][bj][m][1] * g;
                        u32x2 o; o.x = pk4_fp8(v0[0], v0[1], v0[2], v0[3]); o.y = pk4_fp8(v1[0], v1[1], v1[2], v1[3]);
                        *(u32x2*)(Y + (size_t)dst * D + col0 + bj * 128) = o; }
                }
            }
    }
};

namespace att {
constexpr int KVBLK = 64, LDX = D;
constexpr float SCALE = 0.088388347648318440f, THR = 8.f;
constexpr size_t SHM_V = KVBLK * HD * 2, SHM_K = KVBLK * HD * 2, SHM_ATTN = 2 * SHM_V + 2 * SHM_K + NWAVES * 64 * 4;
#define KSWZ(row, colB) ((row) * 256 + ((colB) ^ (((row) & 7) << 4)))
#define SBAR() __builtin_amdgcn_sched_barrier(0)
__device__ __forceinline__ int crow(int r, int hi) { return (r & 3) + 8 * (r >> 2) + 4 * hi; }
__device__ __forceinline__ void partialSM(f32x16& p0, f32x16& p1, float& m_reg, float& mn, float& alpha) {
    constexpr float C = SCALE * 1.4426950408889634f;
    float pmax = p0[0];
#pragma unroll
    for (int r = 1; r < 16; ++r) pmax = fmaxf(pmax, p0[r]);
#pragma unroll
    for (int r = 0; r < 16; ++r) pmax = fmaxf(pmax, p1[r]);
    { auto rr = __builtin_amdgcn_permlane32_swap(__float_as_uint(pmax), __float_as_uint(pmax), false, false);
      pmax = fmaxf(__uint_as_float(rr[0]), __uint_as_float(rr[1])); }
    if (__builtin_expect(__all(pmax - m_reg <= THR / SCALE), 1)) { mn = m_reg; alpha = 1.f; }
    else { mn = fmaxf(m_reg, pmax); alpha = __builtin_amdgcn_exp2f((m_reg - mn) * C); m_reg = mn; }
    const float mnC = -mn * C;
#pragma unroll
    for (int r = 0; r < 16; ++r) p0[r] = fmaf(p0[r], C, mnC);
#pragma unroll
    for (int r = 0; r < 16; ++r) p1[r] = fmaf(p1[r], C, mnC);
#pragma unroll
    for (int r = 0; r < 16; ++r) p0[r] = __builtin_amdgcn_exp2f(p0[r]);
}
__device__ __forceinline__ void finishSM(f32x16& p0, f32x16& p1, float alpha, float& l_reg, bf16x8& pa0, bf16x8& pa1, bf16x8& pa2, bf16x8& pa3) {
#pragma unroll
    for (int r = 0; r < 16; ++r) p1[r] = __builtin_amdgcn_exp2f(p1[r]);
    float ps = 0;
#pragma unroll
    for (int r = 0; r < 16; ++r) ps += p0[r];
#pragma unroll
    for (int r = 0; r < 16; ++r) ps += p1[r];
    { auto rr = __builtin_amdgcn_permlane32_swap(__float_as_uint(ps), __float_as_uint(ps), false, false);
      ps = __uint_as_float(rr[0]) + __uint_as_float(rr[1]); }
    l_reg = l_reg * alpha + ps;
#define PK4(P, BASE, OUT) do { unsigned a0 = cvt_pk_bf16(P[BASE + 0], P[BASE + 1]), a1 = cvt_pk_bf16(P[BASE + 2], P[BASE + 3]);   \
    unsigned b0 = cvt_pk_bf16(P[BASE + 4], P[BASE + 5]), b1 = cvt_pk_bf16(P[BASE + 6], P[BASE + 7]);                              \
    auto r0 = __builtin_amdgcn_permlane32_swap(a0, b0, false, false); auto r1 = __builtin_amdgcn_permlane32_swap(a1, b1, false, false); \
    u32x4 w = {r0[0], r1[0], r0[1], r1[1]}; OUT = *reinterpret_cast<bf16x8*>(&w); } while (0)
    PK4(p0, 0, pa0); PK4(p0, 8, pa1); PK4(p1, 0, pa2); PK4(p1, 8, pa3);
#undef PK4
}
__device__ __forceinline__ void qkt(f32x16& p0, f32x16& p1, const char* Ks, const bf16x8* qr, int r32, int hi) {
    p0 = f32x16{}; p1 = f32x16{};
#pragma unroll
    for (int d0 = 0; d0 < 8; ++d0) { const int cb = (d0 * 16 + hi * 8) * 2;
        const bf16x8 b0 = *reinterpret_cast<const bf16x8*>(Ks + KSWZ(r32, cb));
        const bf16x8 b1 = *reinterpret_cast<const bf16x8*>(Ks + KSWZ(32 + r32, cb));
        p0 = __builtin_amdgcn_mfma_f32_32x32x16_bf16(b0, qr[d0], p0, 0, 0, 0);
        p1 = __builtin_amdgcn_mfma_f32_32x32x16_bf16(b1, qr[d0], p1, 0, 0, 0); }
}
__device__ __forceinline__ int v_st(int k, int c) { const int kk = (k & ~0xC) | ((k & 4) << 1) | ((k & 8) >> 1); return ((kk >> 3) * 4 + (c >> 5)) * 512 + ((kk & 7) * 32 + (c & 31)) * 2; }
__device__ __forceinline__ int v_rd_base(int lane) { return ((lane & 3) << 3) | (((lane >> 2) & 3) << 6) | (((lane >> 4) & 1) << 5) | (((lane >> 5) & 1) << 8); }
constexpr int v_rd_off(int d0, int ks, int half) { return d0 * 512 + ks * 4096 + half * 2048; }
template <int OFF> __device__ __forceinline__ s16x4 tr_read(int vb) {
    s16x4 r; asm volatile("ds_read_b64_tr_b16 %0, %1 offset:%2" : "=&v"(r) : "v"(vb), "i"(OFF) : "memory"); return r;
}
template <int D0, bool FIRST = false> __device__ __forceinline__ void pv_one(f32x16& od, int vb, bf16x8 pa0, bf16x8 pa1, bf16x8 pa2, bf16x8 pa3) {
    const s16x4 l0 = tr_read<v_rd_off(D0, 0, 0)>(vb), h0 = tr_read<v_rd_off(D0, 0, 1)>(vb), l1 = tr_read<v_rd_off(D0, 1, 0)>(vb), h1 = tr_read<v_rd_off(D0, 1, 1)>(vb);
    const s16x4 l2 = tr_read<v_rd_off(D0, 2, 0)>(vb), h2 = tr_read<v_rd_off(D0, 2, 1)>(vb), l3 = tr_read<v_rd_off(D0, 3, 0)>(vb), h3 = tr_read<v_rd_off(D0, 3, 1)>(vb);
    asm volatile("s_waitcnt lgkmcnt(0)" ::: "memory"); SBAR();
#define PK(L, H) (bf16x8){L[0], L[1], L[2], L[3], H[0], H[1], H[2], H[3]}
    if constexpr (FIRST) od = __builtin_amdgcn_mfma_f32_32x32x16_bf16(PK(l0, h0), pa0, f32x16{}, 0, 0, 0);
    else od = __builtin_amdgcn_mfma_f32_32x32x16_bf16(PK(l0, h0), pa0, od, 0, 0, 0);
    od = __builtin_amdgcn_mfma_f32_32x32x16_bf16(PK(l1, h1), pa1, od, 0, 0, 0);
    od = __builtin_amdgcn_mfma_f32_32x32x16_bf16(PK(l2, h2), pa2, od, 0, 0, 0);
    od = __builtin_amdgcn_mfma_f32_32x32x16_bf16(PK(l3, h3), pa3, od, 0, 0, 0);
#undef PK
}
template <bool FIRST = false> __device__ __forceinline__ void pv_d0(f32x16* o, int vb, bf16x8 pa0, bf16x8 pa1, bf16x8 pa2, bf16x8 pa3) {
    pv_one<0, FIRST>(o[0], vb, pa0, pa1, pa2, pa3); pv_one<1, FIRST>(o[1], vb, pa0, pa1, pa2, pa3); pv_one<2, FIRST>(o[2], vb, pa0, pa1, pa2, pa3); pv_one<3, FIRST>(o[3], vb, pa0, pa1, pa2, pa3);
}
constexpr int PROWS = 10752;
__device__ __forceinline__ int nsl_of(int i) { return i < 3 ? i : 3; }
__device__ __forceinline__ int rowoff_of(int i) { return 256 * (i <= 1 ? 0 : (i == 2 ? 1 : 3 * i - 6)); }

__device__ __forceinline__ void sel_load(const bf16* Qb, bf16x8 (&qr)[8]) {
    const int tid = threadIdx.x, wid = __builtin_amdgcn_readfirstlane(tid >> 6), lane = tid & 63, r32 = lane & 31, hi = lane >> 5;
    const char* Qc = (const char*)Qb; const unsigned qoff = (unsigned)((wid * 32 + r32) * LDX + hi * 8) * 2u;
#pragma unroll
    for (int d0 = 0; d0 < 8; ++d0) qr[d0] = *reinterpret_cast<const bf16x8*>(Qc + qoff + d0 * 32);
}
__device__ __forceinline__ void sel_unit(const bf16x8 (&qr)[8], const float* kmL  , unsigned short* selo  , int iblk) {
    const int tid = threadIdx.x, wid = __builtin_amdgcn_readfirstlane(tid >> 6), lane = tid & 63, r32 = lane & 31, hi = lane >> 5;
    unsigned sel = 0;
    float v1 = -__builtin_inff(), v2 = v1, v3 = v1; int i1 = -1, i2 = -1, i3 = -1;
#pragma unroll 1
    for (int n = 0; n < iblk; ++n) {
        float s = 0.f; const float* kp = kmL + n * 128 + hi * 8;
#pragma unroll
        for (int d0 = 0; d0 < 8; ++d0) { const f32x4 k0 = *(const f32x4*)(kp + d0 * 16), k1 = *(const f32x4*)(kp + d0 * 16 + 4); const bf16x8 q = qr[d0];
#pragma unroll
            for (int e = 0; e < 4; ++e) { s += __builtin_bit_cast(float, ((unsigned)(unsigned short)q[e]) << 16) * k0[e]; s += __builtin_bit_cast(float, ((unsigned)(unsigned short)q[4 + e]) << 16) * k1[e]; } }
        s += __shfl_xor(s, 32);
        if (s > v1) { v3 = v2; i3 = i2; v2 = v1; i2 = i1; v1 = s; i1 = n; }
        else if (s > v2) { v3 = v2; i3 = i2; v2 = s; i2 = n; }
        else if (s > v3) { v3 = s; i3 = n; }
    }
    if (i1 >= 0) sel |= 1u << i1; if (i2 >= 0) sel |= 1u << i2; if (i3 >= 0) sel |= 1u << i3;
    if (hi == 0) selo[wid * 32 + r32] = (unsigned short)sel;
}

__device__ __forceinline__ void tile_step(f32x16 (&o)[4], float& m_reg, float& l_reg, const char* Kt, int vb, bf16x8 (&qr)[8], int r32, int hi, float* al_l, bool do_mask, int thr, bool hasn, const char* Qbase, unsigned enext) {
    f32x16 p0, p1; qkt(p0, p1, Kt, qr, r32, hi); SBAR();
    if (do_mask && hasn) { const char* qnext = Qbase + (unsigned)((int)(enext & 4095u) * LDX + hi * 8) * 2u;
#pragma unroll
        for (int d0 = 0; d0 < 8; ++d0) qr[d0] = *reinterpret_cast<const bf16x8*>(qnext + d0 * 32); }
    if (do_mask) { const float ninf = -__builtin_inff(); asm volatile("" : "+v"(thr));
#pragma unroll
        for (int r = 0; r < 16; ++r) { const int c = (r & 3) + 8 * (r >> 2); p0[r] = (c <= thr) ? p0[r] : ninf; p1[r] = (c + 32 <= thr) ? p1[r] : ninf; } }
    float mn, alpha; partialSM(p0, p1, m_reg, mn, alpha);
    if (__any(alpha < 1.f)) {
#pragma unroll
        for (int d = 0; d < 4; ++d)
#pragma unroll
            for (int r = 0; r < 16; ++r) o[d][r] *= alpha; }
    bf16x8 pa0, pa1, pa2, pa3; finishSM(p0, p1, alpha, l_reg, pa0, pa1, pa2, pa3); SBAR();
    pv_d0(o, vb, pa0, pa1, pa2, pa3);
}

__device__ __forceinline__ void flash4(f32x16 (&o)[4], float& m_reg, float& l_reg, const char* K_lds, int vbase, bf16x8 (&qr)[8], int r32, int hi, bool hasn, const char* Qbase, unsigned enext) {
    f32x16 pA0, pA1, pB0, pB1; float mnA, mnB, alA, alB; bf16x8 pa0, pa1, pa2, pa3;
#define RESC1(a) do { if (__any((a) < 1.f)) { _Pragma("unroll") for (int d = 0; d < 4; ++d) _Pragma("unroll") for (int r = 0; r < 16; ++r) o[d][r] *= (a); } } while (0)
    qkt(pA0, pA1, K_lds, qr, r32, hi); partialSM(pA0, pA1, m_reg, mnA, alA);
    SBAR(); qkt(pB0, pB1, K_lds + 16384, qr, r32, hi); finishSM(pA0, pA1, alA, l_reg, pa0, pa1, pa2, pa3); SBAR();
    pv_d0<true>(o, vbase, pa0, pa1, pa2, pa3); partialSM(pB0, pB1, m_reg, mnB, alB); RESC1(alB);
    SBAR(); qkt(pA0, pA1, K_lds + 2 * 16384, qr, r32, hi); finishSM(pB0, pB1, alB, l_reg, pa0, pa1, pa2, pa3); SBAR();
    pv_d0(o, vbase + 16384, pa0, pa1, pa2, pa3); partialSM(pA0, pA1, m_reg, mnA, alA); RESC1(alA);
    SBAR(); qkt(pB0, pB1, K_lds + 3 * 16384, qr, r32, hi); SBAR();
    if (hasn) { const char* qnext = Qbase + (unsigned)((int)(enext & 4095u) * LDX + hi * 8) * 2u;
#pragma unroll
        for (int d0 = 0; d0 < 8; ++d0) qr[d0] = *reinterpret_cast<const bf16x8*>(qnext + d0 * 32); }
    finishSM(pA0, pA1, alA, l_reg, pa0, pa1, pa2, pa3); SBAR();
    pv_d0(o, vbase + 2 * 16384, pa0, pa1, pa2, pa3); partialSM(pB0, pB1, m_reg, mnB, alB); RESC1(alB);
    finishSM(pB0, pB1, alB, l_reg, pa0, pa1, pa2, pa3); SBAR();
    pv_d0(o, vbase + 3 * 16384, pa0, pa1, pa2, pa3);
#undef RESC1
}

__device__ __forceinline__ void kv_unit(const bf16* Qh, const bf16* Kh, const bf16* Vh, const unsigned short* selb, unsigned char* Oown, float* mlown, unsigned char* P, float* mlp, int j, char* lds, LAS unsigned char* ldsq) {
    const int tid = threadIdx.x, wid = __builtin_amdgcn_readfirstlane(tid >> 6), lane = tid & 63, r32 = lane & 31, hi = lane >> 5;
    char* K_lds = lds; char* V_lds = lds + 65536; char* xt = lds + XTRA_OFF;
    float* wsf = (float*)xt + wid * 64; float* li_l = wsf; float* al_l = wsf + 32;
    int* drow = (int*)(xt + 2048) + wid * 32;
    LAS int* cnt = (LAS int*)(ldsq + XTRA_OFF + 3072);
    LAS unsigned short* list = (LAS unsigned short*)(ldsq + XTRA_OFF + 3200);
    if (tid == 0) { int z_ = 0; asm volatile("" : "+v"(z_)); cnt[0] = z_; cnt[1] = z_; }
    int tid_s = threadIdx.x; asm volatile("" : "+v"(tid_s));
    const int sr = tid_s >> 4, sc = (tid_s & 15) * 8, vst0 = v_st(sr, sc), vst1 = v_st(32 + sr, sc);
    const unsigned ldoff0 = (unsigned)(sr * LDX + sc) * 2u, ldoff1 = ldoff0 + 32u * LDX * 2u;
    const char* kb = (const char*)Kh + (size_t)(j * 256) * (LDX * 2); const char* vbp = (const char*)Vh + (size_t)(j * 256) * (LDX * 2);
    bf16x8 kk[4][2], vv[4][2];
#pragma unroll
    for (int t = 0; t < 4; ++t) { const size_t to = (size_t)(t * 64) * (LDX * 2);
        kk[t][0] = *reinterpret_cast<const bf16x8*>(kb + to + ldoff0); kk[t][1] = *reinterpret_cast<const bf16x8*>(kb + to + ldoff1);
        vv[t][0] = *reinterpret_cast<const bf16x8*>(vbp + to + ldoff0); vv[t][1] = *reinterpret_cast<const bf16x8*>(vbp + to + ldoff1); }
    __syncthreads();
    {   unsigned sv[8];
#pragma unroll
        for (int k = 0; k < 8; ++k) { const int s = 256 * (j + 1) + k * 512 + tid_s; sv[k] = (s < SEQ) ? (unsigned)selb[s] : 0u; }
#pragma unroll
        for (int k = 0; k < 8; ++k) { const int s0 = 256 * (j + 1) + wid * 64 + k * 512;
            if (s0 < SEQ) { const int s = 256 * (j + 1) + k * 512 + tid_s; const unsigned v = sv[k];
                const bool hit = (v >> j) & 1u; const unsigned long long mk = __ballot(hit); const int nw = __builtin_popcountll(mk);
                int base = 0; if (lane == 0 && nw) base = __hip_atomic_fetch_add(&cnt[0], nw, __ATOMIC_RELAXED, __HIP_MEMORY_SCOPE_WORKGROUP);
                base = __builtin_amdgcn_readfirstlane(base);
                if (hit) list[base + __builtin_popcountll(mk & ((1ull << lane) - 1ull))] = (unsigned short)(s | (__builtin_popcount(v & ((1u << j) - 1u)) << 12)); } } }
#pragma unroll
    for (int t = 0; t < 4; ++t) { const int kc = sc * 2;
        *(bf16x8*)(K_lds + t * 16384 + KSWZ(sr, kc)) = kk[t][0]; *(bf16x8*)(K_lds + t * 16384 + KSWZ(32 + sr, kc)) = kk[t][1];
        *(bf16x8*)(V_lds + t * 16384 + vst0) = vv[t][0]; *(bf16x8*)(V_lds + t * 16384 + vst1) = vv[t][1]; }
    __syncthreads();
    const int n = cnt[0]; const int ngath = (n + 31) >> 5; const int ng = ngath + 8;
    const int vbase = (int)(uintptr_t)V_lds + v_rd_base(lane);
#define KV_TICKET(gv) do { int t_ = 0; if (lane == 0) t_ = __hip_atomic_fetch_add(&cnt[1], 1, __ATOMIC_RELAXED, __HIP_MEMORY_SCOPE_WORKGROUP); gv = __builtin_amdgcn_readfirstlane(t_); } while (0)
#define KV_META(gv, own_, wq_, e_, ntl_) do { own_ = (gv) >= ngath; wq_ = 7 - ((gv) - ngath);     \
        if (own_) { e_ = (unsigned)(256 * j + 32 * wq_ + r32) | 0x8000u; ntl_ = (wq_ >> 1) + 1; }          \
        else { const int idx_ = (gv) * 32 + r32; const bool v_ = idx_ < n; e_ = (unsigned)list[v_ ? idx_ : n - 1] | (v_ ? 0x8000u : 0u); ntl_ = 4; } } while (0)
#define KV_QOFF(e_) ((unsigned)((int)((e_) & 4095u) * LDX + hi * 8) * 2u)
#define KV_LOADQ(e_, q_) do { const char* Qc_ = (const char*)Qh; const unsigned qoff_ = KV_QOFF(e_); \
        _Pragma("unroll") for (int d0 = 0; d0 < 8; ++d0) q_[d0] = *reinterpret_cast<const bf16x8*>(Qc_ + qoff_ + d0 * 32); } while (0)
    int g; KV_TICKET(g);
    bool own = false; int wq = 0, ntl = 0; unsigned ecur = 0; bf16x8 qr[8];
    if (g < ng) { KV_META(g, own, wq, ecur, ntl); KV_LOADQ(ecur, qr); }
    while (g < ng) {
        int gn; KV_TICKET(gn);
        bool ownn = false; int wqn = 0, ntln = 0; unsigned enext = 0;
        const bool hasn = gn < ng;
        if (hasn) { KV_META(gn, ownn, wqn, enext, ntln); }
        float m_reg = -1e30f, l_reg = 0; f32x16 o[4];
        if (!own) flash4(o, m_reg, l_reg, K_lds, vbase, qr, r32, hi, hasn, (const char*)Qh, enext);
        else {
#pragma unroll
            for (int d = 0; d < 4; ++d) o[d] = f32x16{};
#pragma unroll 1
            for (int t = 0; t < ntl - 1; ++t)
                tile_step(o, m_reg, l_reg, K_lds + t * 16384, vbase + t * 16384, qr, r32, hi, al_l, false, 0, false, nullptr, 0u);
            { const int t = ntl - 1;
              tile_step(o, m_reg, l_reg, K_lds + t * 16384, vbase + t * 16384, qr, r32, hi, al_l, true, 32 * wq + r32 - 64 * t - 4 * hi, hasn, (const char*)Qh, enext); }
        }
        const float rl = __builtin_amdgcn_rcpf(l_reg);
        const int qs = (int)(ecur & 4095u), slot = (int)((ecur >> 12) & 3u); const bool valid = (ecur & 0x8000u) != 0u;
        char* rowp;
        if (own) { rowp = (char*)Oown + (size_t)qs * LDX; if (hi == 0) { float* mp = mlown + (size_t)qs * 2; mp[0] = m_reg; mp[1] = l_reg; } }
        else { const int i = qs >> 8; const int ns = nsl_of(i); const int prow = rowoff_of(i) + (qs & 255) * ns + slot; rowp = (char*)P + (size_t)prow * HD;
               if (hi == 0 && valid) { float* mp = mlp + (size_t)prow * 2; mp[0] = m_reg; mp[1] = l_reg; } }
        if (valid) { const float rs = rl * P8S;
#pragma unroll
            for (int d0 = 0; d0 < 4; ++d0)
#pragma unroll
                for (int kp = 0; kp < 2; ++kp) {
                    const unsigned a = pk4_fp8(o[d0][8 * kp + 0] * rs, o[d0][8 * kp + 1] * rs, o[d0][8 * kp + 2] * rs, o[d0][8 * kp + 3] * rs);
                    const unsigned b = pk4_fp8(o[d0][8 * kp + 4] * rs, o[d0][8 * kp + 5] * rs, o[d0][8 * kp + 6] * rs, o[d0][8 * kp + 7] * rs);
                    auto r = __builtin_amdgcn_permlane32_swap(a, b, false, false);
                    const u32x2 w = {r[0], r[1]};
                    *(u32x2*)(rowp + d0 * 32 + kp * 16 + hi * 8) = w; }
        }
        g = gn; own = ownn; wq = wqn; ecur = enext; ntl = ntln;
    }
#undef KV_TICKET
#undef KV_META
#undef KV_QOFF
#undef KV_LOADQ
    __syncthreads();
}
}

#define XB_TMO      128
#define XB_XCNT(j)  (256  + 64 * (j))
#define XB_XSUB(j)  (1280 + 64 * (j))
#define XB_XGEN(j)  (2304 + 64 * (j))
#define XB_TOP      3328
#define XB_TOPGEN   3392
#define XCD_BAR_WORDS 3456
#define XB_SPIN_CAP (1u << 18)
__device__ __forceinline__ unsigned xb_ld(unsigned* p)              { return __hip_atomic_load(p, __ATOMIC_RELAXED, __HIP_MEMORY_SCOPE_AGENT); }
__device__ __forceinline__ unsigned xb_add(unsigned* p, unsigned v) { return __hip_atomic_fetch_add(p, v, __ATOMIC_RELAXED, __HIP_MEMORY_SCOPE_AGENT); }
__device__ __forceinline__ unsigned xb_xcc_id() { return (unsigned)__builtin_amdgcn_s_getreg((3 << 11) | 20) & 0xFu; }
#define XB_SPIN(cond, bar) do { unsigned _sp = 0; while (cond) { __builtin_amdgcn_s_sleep(1); \
    if ((++_sp & 255u) == 0u) { if (xb_ld(&(bar)[XB_TMO])) break; if (_sp > XB_SPIN_CAP) { atomicAdd(&(bar)[XB_TMO], 1u); break; } } } } while (0)
struct XcdBarrier { unsigned* bar; unsigned x; volatile LAS unsigned* st; };
__device__ __forceinline__ XcdBarrier xcd_barrier_post(unsigned* bar, volatile LAS unsigned* st) {
    XcdBarrier b; b.bar = bar; b.x = xb_xcc_id(); b.st = st;
    if (threadIdx.x == 0) (void)xb_add(&bar[XB_XCNT(b.x)], 1u);
    return b;
}
__device__ __forceinline__ void xcd_barrier_complete(unsigned* bar, unsigned x, unsigned& nloc, unsigned& nx) {
    const unsigned G = gridDim.x * gridDim.y * gridDim.z;
    unsigned sum, cnt, mine, sp = 0u;
    for (;;) {
        sum = 0u; cnt = 0u; mine = 0u;
#pragma unroll
        for (unsigned j = 0; j < 16; ++j) { const unsigned c = xb_ld(&bar[XB_XCNT(j)]); sum += c; cnt += (c > 0u) ? 1u : 0u; mine = (j == x) ? c : mine; }
        if (sum == G) break;
        __builtin_amdgcn_s_sleep(1);
        if ((++sp & 255u) == 0u) { if (xb_ld(&bar[XB_TMO])) break; if (sp > XB_SPIN_CAP) { atomicAdd(&bar[XB_TMO], 1u); break; } }
    }
    nloc = mine > 0u ? mine : 1u; nx = cnt > 0u ? cnt : 1u;
}
__device__ __forceinline__ void xcd_barrier(const XcdBarrier& b) {
    asm volatile("s_waitcnt vmcnt(0)" ::: "memory");
    __syncthreads();
    if (threadIdx.x == 0) {
        unsigned* bar = b.bar;
        __builtin_amdgcn_s_waitcnt(0);
        unsigned nloc = b.st[0], nx = b.st[1];
        if (nloc == 0u) { xcd_barrier_complete(bar, b.x, nloc, nx); b.st[0] = nloc; b.st[1] = nx; }
        const unsigned old = xb_add(&bar[XB_XSUB(b.x)], 1u);
        const unsigned gen = old / nloc;
        if (old + 1u == (gen + 1u) * nloc) {
            __builtin_amdgcn_fence(__ATOMIC_RELEASE, "agent");
            asm volatile("s_waitcnt vmcnt(0)" ::: "memory");
            const unsigned og = xb_add(&bar[XB_TOP], 1u);
            const unsigned tg = og / nx;
            if (og + 1u == (tg + 1u) * nx) xb_add(&bar[XB_TOPGEN], 1u);
            else XB_SPIN(xb_ld(&bar[XB_TOPGEN]) == tg, bar);
            __builtin_amdgcn_fence(__ATOMIC_ACQUIRE, "agent");
            xb_add(&bar[XB_XGEN(b.x)], 1u);
            asm volatile("s_waitcnt vmcnt(0)" ::: "memory");
        } else {
            XB_SPIN(xb_ld(&bar[XB_XGEN(b.x)]) == gen, bar);
            __builtin_amdgcn_fence(__ATOMIC_ACQUIRE, "agent");
            asm volatile("s_waitcnt vmcnt(0)" ::: "memory");
        }
    }
    __syncthreads();
}

__constant__ double ROPE_C1[16] = {
    0.5403023058681398, 0.9045954518793624, 0.9812558362840286, 0.996355883049411, 0.9992929765482185, 0.9998628790459692, 0.9999734086383661, 0.9999948433117433,
    0.9999990000001666, 0.9999998060772615, 0.9999999623939693, 0.9999999927073353, 0.9999999985857865, 0.9999999997257518, 0.999999999946817, 0.9999999999896866};
__constant__ double ROPE_S1[16] = {
    0.8414709848078965, 0.4262711208130009, 0.19270958398204202, 0.08529334272279625, 0.0375971677311151, 0.01655968314629382, 0.007292600096474083, 0.0032114404746087437,
    0.0014142130909686214, 0.0006227723816580176, 0.00027424817223841217, 0.00012076973711788731, 5.31829589443792e-05, 2.3419998959268378e-05, 1.0313385377029628e-05, 4.541670480592256e-06};

__device__ __forceinline__ int sig32(int p) { return (p & 4) ? 16 + 4 * (p >> 3) + (p & 3) : 4 * (p >> 3) + (p & 3); }
__device__ __forceinline__ void tr_item(const float* src, int ldw, int k0, bf16* out, int K, const float* gk, const float* gn, bool sigma, LAS float* scr, int lane) {
    const int lr = lane >> 3, lc = (lane & 7) * 4;
#pragma unroll
    for (int i = 0; i < 8; ++i) { const int kk = 8 * i + lr; f32x4 v = *(const f32x4*)(src + (size_t)(k0 + kk) * ldw + lc); if (gk) v *= gk[k0 + kk];
        LAS float* d = scr + kk * 33 + lc; d[0] = v[0]; d[1] = v[1]; d[2] = v[2]; d[3] = v[3]; }
    LDS_WAIT(); asm volatile("" ::: "memory");
    const int c = lane & 7;
#pragma unroll
    for (int j = 0; j < 4; ++j) { const int n = (lane >> 3) + 8 * j; const int ns = sigma ? sig32(n) : n; const LAS float* s = scr + (8 * c) * 33 + ns; const float sc = gn ? gn[n] : 1.0f;
        u32x4 o; o.x = pk2(s[0 * 33] * sc, s[1 * 33] * sc); o.y = pk2(s[2 * 33] * sc, s[3 * 33] * sc); o.z = pk2(s[4 * 33] * sc, s[5 * 33] * sc); o.w = pk2(s[6 * 33] * sc, s[7 * 33] * sc);
        *(GAS u32x4*)(out + (size_t)n * K + k0 + 8 * c) = o; }
    LDS_WAIT(); asm volatile("" ::: "memory");
}

__device__ __forceinline__ void tr_load(const float* src, int ldw, int k0, int lane, f32x4 (&v)[8]) {
    const int lr = lane >> 3, lc = (lane & 7) * 4;
#pragma unroll
    for (int i = 0; i < 8; ++i) v[i] = __builtin_nontemporal_load((const GAS f32x4*)(src + (size_t)(k0 + 8 * i + lr) * ldw + lc));
}
__device__ __forceinline__ void tr_finish(const f32x4 (&v)[8], int k0, bf16* out, int K, const LAS float* gk, LAS float* scr, int lane) {
    const int lr = lane >> 3, lc = (lane & 7) * 4;
#pragma unroll
    for (int i = 0; i < 8; ++i) { LAS float* d = scr + (8 * i + lr) * 33 + lc; d[0] = v[i][0]; d[1] = v[i][1]; d[2] = v[i][2]; d[3] = v[i][3]; }
    LDS_WAIT(); asm volatile("" ::: "memory");
    const int c = lane & 7;
    f32x4 g0 = (f32x4){1.f, 1.f, 1.f, 1.f}, g1 = g0;
    if (gk) { g0 = *(const LAS f32x4*)(gk + k0 + 8 * c); g1 = *(const LAS f32x4*)(gk + k0 + 8 * c + 4); }
    float tv[4][8];
#pragma unroll
    for (int j = 0; j < 4; ++j) { const LAS float* s = scr + (8 * c) * 33 + (lane >> 3) + 8 * j;
#pragma unroll
        for (int e = 0; e < 8; ++e) tv[j][e] = s[e * 33]; }
    LDS_WAIT(); asm volatile("" ::: "memory");
#pragma unroll
    for (int j = 0; j < 4; ++j) { const int n = (lane >> 3) + 8 * j;
        u32x4 o; o.x = cvt_pk_bf16(tv[j][0] * g0[0], tv[j][1] * g0[1]); o.y = cvt_pk_bf16(tv[j][2] * g0[2], tv[j][3] * g0[3]); o.z = cvt_pk_bf16(tv[j][4] * g1[0], tv[j][5] * g1[1]); o.w = cvt_pk_bf16(tv[j][6] * g1[2], tv[j][7] * g1[3]);
        *(GAS u32x4*)(out + (size_t)n * K + k0 + 8 * c) = o; }
}

__device__ __forceinline__ void tr_finish8(const f32x4 (&v)[8], int k0, unsigned char* out, int Kb, const LAS float* gk, float sc, LAS float* scr, int lane, bool sigma = false) {
    const int lr = lane >> 3, lc = (lane & 7) * 4;
#pragma unroll
    for (int i = 0; i < 8; ++i) { LAS float* d = scr + (8 * i + lr) * 33 + lc; d[0] = v[i][0]; d[1] = v[i][1]; d[2] = v[i][2]; d[3] = v[i][3]; }
    LDS_WAIT(); asm volatile("" ::: "memory");
    const int c = lane & 7;
    f32x4 g0 = (f32x4){1.f, 1.f, 1.f, 1.f}, g1 = g0;
    if (gk) { g0 = *(const LAS f32x4*)(gk + k0 + 8 * c); g1 = *(const LAS f32x4*)(gk + k0 + 8 * c + 4); }
    g0 *= sc; g1 *= sc;
    float tv[4][8];
#pragma unroll
    for (int j = 0; j < 4; ++j) { const int n_ = (lane >> 3) + 8 * j; const LAS float* s = scr + (8 * c) * 33 + (sigma ? sig32(n_) : n_);
#pragma unroll
        for (int e = 0; e < 8; ++e) tv[j][e] = s[e * 33]; }
    LDS_WAIT(); asm volatile("" ::: "memory");
#pragma unroll
    for (int j = 0; j < 4; ++j) { const int n = (lane >> 3) + 8 * j;
        u32x2 o; o.x = pk4_fp8(tv[j][0] * g0[0], tv[j][1] * g0[1], tv[j][2] * g0[2], tv[j][3] * g0[3]); o.y = pk4_fp8(tv[j][4] * g1[0], tv[j][5] * g1[1], tv[j][6] * g1[2], tv[j][7] * g1[3]);
        *(GAS u32x2*)(out + (size_t)n * Kb + k0 + 8 * c) = o; }
}

#define rope_c ((float*)(unsigned char*)(wsp + WS_ROPE_C))
#define rope_s ((float*)(unsigned char*)(wsp + WS_ROPE_S))
#define kmean ((float*)(unsigned char*)(wsp + WS_KMEAN))
#define ss1 ((float*)(unsigned char*)(wsp + WS_SS1))
#define ss2 ((float*)(unsigned char*)(wsp + WS_SS2))
#define ss3 ((float*)(unsigned char*)(wsp + WS_SS3))
#define rstd3 ((float*)(unsigned char*)(wsp + WS_RSTD3))
#define gatew ((float*)(unsigned char*)(wsp + WS_GATEW))
#define ent ((unsigned*)(unsigned char*)(wsp + WS_ENT))
#define bcnt ((int*)(unsigned char*)(wsp + WS_BCNT))
#define soff ((unsigned*)(unsigned char*)(wsp + WS_SOFF))
#define srstd ((float*)(unsigned char*)(wsp + WS_SRSTD))
#define sdst ((int*)(unsigned char*)(wsp + WS_SDST))
#define sgw ((float*)(unsigned char*)(wsp + WS_SGW))
#define texp ((int*)(unsigned char*)(wsp + WS_TEXP))
#define w_pool ((bf16*)(unsigned char*)(wsp + WS_W_POOL))
#define w_qkv ((bf16*)(unsigned char*)(wsp + WS_W_QKV))
#define w_wo ((bf16*)(unsigned char*)(wsp + WS_W_WO))
#define w_fgu ((bf16*)(unsigned char*)(wsp + WS_W_FGU))
#define w_fd ((bf16*)(unsigned char*)(wsp + WS_W_FD))
#define w_mgu ((bf16*)(unsigned char*)(wsp + WS_W_MGU))
#define w_md ((bf16*)(unsigned char*)(wsp + WS_W_MD))
#define w_mgu8 ((unsigned char*)(wsp + WS_W_MGU))
#define w_md8 ((unsigned char*)(wsp + WS_W_MD))
#define h8buf ((unsigned char*)(wsp + WS_H8))
#define o8buf ((unsigned char*)(wsp + WS_Q))
#define h8abuf ((unsigned char*)(wsp + WS_PART))
#define hbuf ((bf16*)(unsigned char*)(wsp + WS_H))
#define pooled ((bf16*)(unsigned char*)(wsp + WS_POOLED))
#define fact ((bf16*)(unsigned char*)(wsp + WS_FACT))
#define qbuf ((bf16*)(unsigned char*)(wsp + WS_Q))
#define kbuf ((bf16*)(unsigned char*)(wsp + WS_K))
#define vbuf ((bf16*)(unsigned char*)(wsp + WS_V))
struct Args { const float* in[18]; float* out; unsigned char* ws; int ph_lo, ph_hi; };
constexpr int PH_P0 = 0, PH_POOL = 1, PH_FFN1 = 2, PH_FFN2 = 3, PH_QKV = 4, PH_SEL = 5, PH_KV = 6, PH_COMB = 7, PH_WO = 8, PH_ROUTE = 9, PH_LIST = 10, PH_MOE0 = 11, PH_FINAL = PH_MOE0 + MOE_STEPS, PH_COUNT = PH_FINAL + 1;

__global__ void __launch_bounds__(NWAVES * 64, 2) yoco_fwd(Args args) {
    extern __shared__ __attribute__((aligned(16))) unsigned char lds_raw[];
    LAS unsigned char* lds = (LAS unsigned char*)lds_raw;
    volatile LAS unsigned* MISC = (volatile LAS unsigned*)(lds + MISC_OFF);
    const int tid = threadIdx.x, lane = tid & 63, wave = __builtin_amdgcn_readfirstlane(tid >> 6);
    const int G = gridDim.x; const int bx = blockIdx.x; const int vcu = (G % 8 == 0) ? (bx % 8) * (G / 8) + bx / 8 : bx;
    unsigned char* ws = args.ws;
    unsigned* ctl = (unsigned*)(ws + WS_CTL);
    typedef const __attribute__((address_space(4))) Args* KArgs;
    KArgs kap = (KArgs)__builtin_amdgcn_kernarg_segment_ptr();
#define PIN_ARGS() asm volatile("" : "+s"(kap))
    GAS unsigned char* wsp = (GAS unsigned char*)ws;
#define obuf ((unsigned char*)kap->out)
#define y8buf ((unsigned char*)(wsp + WS_Y8))
    for (int u = tid; u < (LDS_BYTES - LDSCTL_OFF) / 4; u += NWAVES * 64) ((LAS unsigned*)(lds + LDSCTL_OFF))[u] = 0u;
    __syncthreads();
    const bool one_launch = (args.ph_hi - args.ph_lo) > 1;
    XcdBarrier bar; bar.bar = ctl + CW_BAR; bar.x = 0; bar.st = nullptr;
    if (one_launch) bar = xcd_barrier_post(ctl + CW_BAR, MISC + 8);
    const int lo = args.ph_lo, hi = args.ph_hi;
#ifndef PHMASK
#define PHMASK 0xffffffffu
#endif
#define IN(k) (((PHMASK >> ((k) < 31 ? (k) : 31)) & 1u) && lo <= (k) && (k) < hi)
#define SEAM(k) do { if (IN(k) && IN((k) + 1)) xcd_barrier(bar); } while (0)
    const int gw = vcu * NWAVES + wave, NGW = G * NWAVES;

#ifndef REP_P0
#define REP_P0 1
#endif
    for (int rep = 0; rep < REP_P0; ++rep) { if (rep) xcd_barrier(bar);
    if (IN(PH_P0)) {
        wsp = (GAS unsigned char*)ws; asm volatile("" : "+s"(wsp)); PIN_ARGS(); const float* x = kap->in[0]; const float* attn_norm = kap->in[1]; const float* ffn_norm = kap->in[2]; const float* pool_w = kap->in[3]; const float* pool_scale = kap->in[4]; const float* wq = kap->in[5]; const float* wo = kap->in[6]; const float* kv_norm = kap->in[7]; const float* wk = kap->in[8]; const float* wv = kap->in[9]; const float* fwg = kap->in[10]; const float* fwu = kap->in[11]; const float* fwd = kap->in[12];
        for (int i = bx * 512 + tid; i < SEQ * 16; i += G * 512) { const int s = i >> 4, d = i & 15; double c = 1.0, sn = 0.0, bc = ROPE_C1[d], bs = ROPE_S1[d];
            for (int b = 0; b < 12; ++b) { if ((s >> b) & 1) { const double nc = c * bc - sn * bs, ns = sn * bc + c * bs; c = nc; sn = ns; } const double nbc = bc * bc - bs * bs, nbs = 2.0 * bc * bs; bc = nbc; bs = nbs; }
            rope_c[i] = (float)c; rope_s[i] = (float)sn; }
        for (int i = bx * 512 + tid; i < NBATCH * NH * NBLK * HD; i += G * 512) kmean[i] = 0.f;
        {
            LAS float* rsl = (LAS float*)(lds + XTRA_OFF);
            for (int chunk = vcu; chunk < T / 128; chunk += G) {
                const int t0 = chunk * 128, p0 = t0 & (SEQ - 1);
                for (int r0 = wave; r0 < 143; r0 += 6 * NWAVES) {
                    float s6[6];
#pragma unroll
                    for (int q = 0; q < 6; ++q) { const int rr = r0 + q * NWAVES; const int t = t0 - 15 + rr; float s = 0.f;
                        if (rr < 143 && p0 + rr - 15 >= 0) { const GAS f32x4* xr = (const GAS f32x4*)(x + (size_t)t * D) + lane;
#pragma unroll
                            for (int j = 0; j < 4; ++j) { const f32x4 v = xr[64 * j]; s += (v[0] * v[0] + v[1] * v[1]) + (v[2] * v[2] + v[3] * v[3]); } }
                        s6[q] = s; }
#pragma unroll
                    for (int q = 0; q < 6; ++q) { const int rr = r0 + q * NWAVES; const float s = wave_sum(s6[q]); if (lane == 0 && rr < 143) rsl[rr] = 1.0f / sqrtf(s * (1.0f / D) + EPS); }
                }
                __syncthreads();
                const int tb = t0 + wave * 16;
                const int pb = tb & (SEQ - 1);
#pragma unroll
                for (int jh = 0; jh < 8; ++jh) {
                    const int j = jh >> 1, hh = jh & 1; const int w = 2 << j; const int tq = tb + 8 * hh, pq = pb + 8 * hh;
                    const f32x4 g = *(const f32x4*)(attn_norm + 256 * j + 4 * lane);
                    f32x4 v[23];
                    const char* xb = (const char*)x + ((size_t)(tq - 15) * D + 256 * j) * 4; const unsigned lo = (unsigned)lane * 16u;
#pragma unroll
                    for (int r = 0; r < 23; ++r) { const bool need = (r >= 16 - w) && (pq - 15 + r >= 0);
                        if (need) { const float rs = __builtin_bit_cast(float, __builtin_amdgcn_readfirstlane(__builtin_bit_cast(int, rsl[wave * 16 + 8 * hh + r]))); v[r] = *(const f32x4*)(xb + (size_t)r * (D * 4) + lo) * (rs * g); }
                        else v[r] = (f32x4){0.f, 0.f, 0.f, 0.f}; }
#pragma unroll
                    for (int i = 0; i < 8; ++i) { const int pos = pq + i; f32x4 S = v[15 + i];
#pragma unroll
                        for (int d = 1; d < w; ++d) S += v[15 + i - d];
                        const float inv = 1.0f / (float)(pos + 1 < w ? pos + 1 : w); const f32x4 o = S * inv - v[15 + i];
                        u32x2 pk; pk.x = pk2(o[0], o[1]); pk.y = pk2(o[2], o[3]); *(u32x2*)(pooled + (size_t)(tq + i) * D + 256 * j + 4 * lane) = pk; }
                    asm volatile("" ::: "memory");
                }
                __syncthreads();
            }
        }
        {
            LAS float* scr = (LAS float*)(lds + RING_OFF + wave * 16384);
            for (int it = gw; it < 128; it += NGW) { const int g = it >> 5, r = it & 31, kb = r >> 3, nb = r & 7;
                tr_item(pool_w + (size_t)g * 65536 + nb * 32, 256, kb * 64, w_pool + (size_t)(g * 256 + nb * 32) * 256, 256, nullptr, pool_scale + g * 256 + nb * 32, false, scr, lane); }
#if QKV_FP8
            LAS float* gq = (LAS float*)(lds + XTRA_OFF + 12288); LAS float* gkv = gq + D;
            for (int i = tid; i < D; i += NWAVES * 64) { gq[i] = attn_norm[D + i]; gkv[i] = kv_norm[i]; }
            __syncthreads();
#endif
            for (int it = gw; it < 1536; it += NGW) { const int which = it >> 9, r = it & 511, kb = r >> 5, nb = r & 31;
                const float* W = which == 0 ? wq : (which == 1 ? wk : wv);
#if QKV_FP8
                f32x4 b8[8]; tr_load(W + nb * 32, D, kb * 64, lane, b8); tr_finish8(b8, kb * 64, (unsigned char*)w_qkv + (size_t)(which * 1024 + nb * 32) * D, D, which == 0 ? gq : gkv, W8S_GU, scr, lane, which < 2 && (nb & 3) == 0); LDS_WAIT();
#else
                const float* gk = which == 0 ? attn_norm + D : kv_norm;
                tr_item(W + nb * 32, D, kb * 64, w_qkv + (size_t)(which * 1024 + nb * 32) * D, D, gk, nullptr, which < 2 && (nb & 3) == 0, scr, lane);
#endif
            }
            for (int it = gw; it < 512; it += NGW) { const int kb = it >> 5, nb = it & 31;
#if WO_FP8
                f32x4 b8[8]; tr_load(wo + nb * 32, D, kb * 64, lane, b8); tr_finish8(b8, kb * 64, (unsigned char*)w_wo + (size_t)(nb * 32) * D, D, nullptr, W8S_GU, scr, lane); LDS_WAIT();
#else
                tr_item(wo + nb * 32, D, kb * 64, w_wo + (size_t)(nb * 32) * D, D, nullptr, nullptr, false, scr, lane);
#endif
            }
#if FFN1_FP8
            LAS float* gk0 = (LAS float*)(lds + XTRA_OFF + 8192);
            for (int i = tid; i < D; i += NWAVES * 64) gk0[i] = ffn_norm[i];
            __syncthreads();
#endif
            for (int it = gw; it < 16 * 176; it += NGW) { const int kb = it / 176, nb = it % 176, n0 = nb * 32, pn = n0 >> 8, r = n0 & 255;
                const float* W = (r < 128 ? fwg : fwu) + pn * 128 + (r & 127);
#if FFN1_FP8
                f32x4 b8[8]; tr_load(W, FF, kb * 64, lane, b8); tr_finish8(b8, kb * 64, (unsigned char*)w_fgu + (size_t)n0 * D, D, gk0, W8S_GU, scr, lane); LDS_WAIT();
#else
                tr_item(W, FF, kb * 64, w_fgu + (size_t)n0 * D, D, ffn_norm, nullptr, false, scr, lane);
#endif
            }
            for (int it = gw; it < 44 * 32; it += NGW) { const int kb = it >> 5, nb = it & 31;
#if FFN2_FP8
                f32x4 b8[8]; tr_load(fwd + nb * 32, D, kb * 64, lane, b8); tr_finish8(b8, kb * 64, (unsigned char*)w_fd + (size_t)(nb * 32) * FF, FF, nullptr, W8S_DN, scr, lane); LDS_WAIT();
#else
                tr_item(fwd + nb * 32, D, kb * 64, w_fd + (size_t)(nb * 32) * FF, FF, nullptr, nullptr, false, scr, lane);
#endif
            }
        }
    }
    }
    SEAM(PH_P0);

    if (IN(PH_POOL)) {
        wsp = (GAS unsigned char*)ws; asm volatile("" : "+s"(wsp)); PIN_ARGS(); const float* x = kap->in[0];
        ProbDense pr{(const char*)pooled, (const char*)w_pool, 256, D, 512};
        pg8::StaticOrder S; S.init(T / 256, 4, G, bx);
        EpiRes<true> E{x, hbuf, ss1, FFN1_FP8 ? h8abuf : nullptr, 1.0f};
        pg8::gemm_phase(lds + RING_OFF, pr, S, E);
    }
    SEAM(PH_POOL);

#ifndef REP_FFN1
#define REP_FFN1 1
#endif
    for (int rep = 0; rep < REP_FFN1; ++rep) { if (rep) xcd_barrier(bar);
    if (IN(PH_FFN1)) {
        wsp = (GAS unsigned char*)ws; asm volatile("" : "+s"(wsp)); PIN_ARGS();
        ProbDenseT<FFN1_FP8 != 0> pr{FFN1_FP8 ? (const char*)h8abuf : (const char*)hbuf, (const char*)w_fgu, FFN1_FP8 ? D / 2 : D, FFN1_FP8 ? D / 2 : D, 0};
        pg8::StaticOrder S; S.init(T / 256, 2 * FF / 256, G, bx);
        EpiSwiGLU<false, FF, FFN2_FP8 != 0, FFN1_FP8 != 0> E{fact, RstdTable{ss1, -1, 0}, nullptr, 0, 1 << 30, nullptr};
        pg8::gemm_phase(lds + RING_OFF, pr, S, E);
    }
    }
    SEAM(PH_FFN1);

    if (IN(PH_FFN2)) {
        wsp = (GAS unsigned char*)ws; asm volatile("" : "+s"(wsp)); PIN_ARGS();
        ProbDenseT<FFN2_FP8 != 0> pr{(const char*)fact, (const char*)w_fd, FFN2_FP8 ? FF / 2 : FF, FFN2_FP8 ? FF / 2 : FF, 0};
        pg8::StaticOrder S; S.init(T / 256, 4, G, bx);
        EpiRes<false> E{nullptr, hbuf, ss2, QKV_FP8 ? h8abuf : nullptr, FFN2_FP8 ? 1.0f / (W8S_DN * ACT8S) : 1.0f};
        pg8::gemm_phase(lds + RING_OFF, pr, S, E);
    }
    SEAM(PH_FFN2);

    if (IN(PH_QKV)) {
        wsp = (GAS unsigned char*)ws; asm volatile("" : "+s"(wsp)); PIN_ARGS();
        ProbDenseT<QKV_FP8 != 0> pr{QKV_FP8 ? (const char*)h8abuf : (const char*)hbuf, (const char*)w_qkv, QKV_FP8 ? D / 2 : D, QKV_FP8 ? D / 2 : D, 0};
        pg8::StaticOrder S; S.init(T / 256, 12, G, bx);
        EpiQKV E{qbuf, RstdTable{ss2, -1, 0}, rope_c, rope_s, kmean};
        pg8::gemm_phase(lds + RING_OFF, pr, S, E);
    }
    SEAM(PH_QKV);

#ifndef REP_SEL
#define REP_SEL 1
#endif
    for (int rep = 0; rep < REP_SEL; ++rep) { if (rep) xcd_barrier(bar);
    if (IN(PH_SEL)) {
        wsp = (GAS unsigned char*)ws; asm volatile("" : "+s"(wsp)); PIN_ARGS();
        unsigned short* selbuf = (unsigned short*)((unsigned char*)(wsp + WS_SEL));
        float* kmL = (float*)((char*)lds_raw + XTRA_OFF + 4096);
        for (int v2 = vcu; v2 < 256; v2 += G) {
            const int bh = v2 >> 2, s4 = v2 & 3, b = bh >> 3, h = bh & 7;
            bf16x8 q4[4][8];
#pragma unroll
            for (int k = 0; k < 4; ++k) att::sel_load(qbuf + ((size_t)(b * SEQ + (4 * s4 + k) * 256)) * D + h * HD, q4[k]);
            *(f32x4*)(kmL + tid * 4) = *(const f32x4*)((const char*)(kmean + (size_t)bh * NBLK * HD) + (unsigned)tid * 16u);
            __syncthreads();
#pragma unroll
            for (int k = 0; k < 4; ++k) att::sel_unit(q4[k], kmL, selbuf + (size_t)bh * SEQ + (4 * s4 + k) * 256, 4 * s4 + k);
            __syncthreads();
        }
    }
    }
    SEAM(PH_SEL);

#ifndef REP_KV
#define REP_KV 1
#endif
    for (int rep = 0; rep < REP_KV; ++rep) { if (rep) xcd_barrier(bar);
    if (IN(PH_KV)) {
        wsp = (GAS unsigned char*)ws; asm volatile("" : "+s"(wsp)); PIN_ARGS();
        const bool convfirst = (G == 256) && bx >= G - CONV_WGS;
        auto conv_pass = [&]() {
            wsp = (GAS unsigned char*)ws; asm volatile("" : "+s"(wsp)); PIN_ARGS();
            int tid_c = threadIdx.x; asm volatile("" : "+v"(tid_c)); const int tid = tid_c;
            const float* ffn_norm = kap->in[2]; const float* mwg = kap->in[14]; const float* mwu = kap->in[15]; const float* mwd = kap->in[16];
            constexpr int N_GU = NE * 16 * 224, N_DN = NE * 56 * 32;
            LAS float* scr = (LAS float*)(lds + RING_OFF + wave * 16384); int lane_c = threadIdx.x; asm volatile("" : "+v"(lane_c)); lane_c &= 63;
            LAS float* gkL = (LAS float*)(lds + XTRA_OFF + 16384);
            for (int i = tid; i < D; i += NWAVES * 64) gkL[i] = ffn_norm[D + i];
#define MOE_ITEM(it_, S_, L_, K0_, O_, KK_, G_) do { if ((it_) < N_GU) { const int e_ = (it_) / (16 * 224), r2_ = (it_) % (16 * 224), kb_ = r2_ / 224, nb_ = r2_ % 224, n0_ = nb_ * 32, pn_ = n0_ >> 8, r_ = n0_ & 255; \
        S_ = (r_ < 128 ? mwg : mwu) + (size_t)e_ * D * FE + pn_ * 128 + (r_ & 127); L_ = FE; K0_ = kb_ * 64; O_ = w_mgu8 + ((size_t)e_ * 2 * FE + n0_) * D; KK_ = D; G_ = gkL; } \
    else { const int i2_ = (it_) - N_GU; const int e_ = i2_ / (56 * 32), r2_ = i2_ % (56 * 32), kb_ = r2_ >> 5, nb_ = r2_ & 31; \
        S_ = mwd + (size_t)e_ * FE * D + nb_ * 32; L_ = D; K0_ = kb_ * 64; O_ = w_md8 + ((size_t)e_ * D + nb_ * 32) * FE; KK_ = FE; G_ = nullptr; } } while (0)
            __syncthreads();
            constexpr int NTK = (N_GU + N_DN) / 8;
#define WAVE_TICKET(v_) do { v_ = 0; if (lane_c == 0) v_ = (int)__hip_atomic_fetch_add(ctl + CW_CONVQ, 1u, RLX_AGENT); } while (0)
#define LOADB(X_, it_) do { MOE_ITEM(it_, s##X_, l##X_, k##X_, o##X_, K##X_, g##X_); c##X_ = ((it_) < N_GU) ? W8S_GU : W8S_DN; tr_load(s##X_, l##X_, k##X_, lane_c, b##X_); } while (0)
#define FINB(X_) tr_finish8(b##X_, k##X_, o##X_, K##X_, g##X_, c##X_, scr, lane_c)
            f32x4 bA[8], bB[8], bC[8], bD[8]; const float* sA; const float* sB; const float* sC; const float* sD; int lA, lB, lC, lD, kA, kB, kC, kD, KA, KB, KC, KD;
            unsigned char* oA; unsigned char* oB; unsigned char* oC; unsigned char* oD; const LAS float* gA; const LAS float* gB; const LAS float* gC; const LAS float* gD; float cA, cB, cC, cD;
            int tv; WAVE_TICKET(tv); int tk = __builtin_amdgcn_readfirstlane(tv);
            if (tk < NTK) { const int i0 = tk * 8; LOADB(A, i0); LOADB(B, i0 + 1); LOADB(C, i0 + 2); LOADB(D, i0 + 3); }
#pragma unroll 1
            while (tk < NTK) {
                const int i0 = tk * 8;
                int tnv; WAVE_TICKET(tnv);
                FINB(A); LOADB(A, i0 + 4); FINB(B); LOADB(B, i0 + 5); FINB(C); LOADB(C, i0 + 6); FINB(D); LOADB(D, i0 + 7);
                const int tkn = __builtin_amdgcn_readfirstlane(tnv);
                const int j0 = (tkn < NTK ? tkn : NTK - 1) * 8;
                FINB(A); LOADB(A, j0); FINB(B); LOADB(B, j0 + 1); FINB(C); LOADB(C, j0 + 2); FINB(D); LOADB(D, j0 + 3);
                tk = tkn;
            }
#undef WAVE_TICKET
#undef LOADB
#undef FINB
#undef MOE_ITEM
            __syncthreads();
        };
        if (convfirst) conv_pass();
        {
            wsp = (GAS unsigned char*)ws; asm volatile("" : "+s"(wsp)); PIN_ARGS();
            const unsigned short* selbuf = (const unsigned short*)((unsigned char*)(wsp + WS_SEL));
            unsigned char* part = (unsigned char*)(wsp + WS_PART); float* mlp = (float*)((unsigned char*)(wsp + WS_MLP)); float* mlown = (float*)((unsigned char*)(wsp + WS_MLOWN));
            const int xq = bx & 7; unsigned* kvq = ctl + CW_KVQ + (rep * 8 + xq) * 64;
            LAS int* tkq = (LAS int*)(lds + XTRA_OFF + 3088);
            for (;;) {
                if (tid == 0) tkq[0] = (int)__hip_atomic_fetch_add(kvq, 1u, RLX_AGENT);
                __syncthreads();
                const int tk = tkq[0];
                if (tk >= 128) break;
                const int jb = tk >> 3, bh = 8 * xq + (tk & 7), b = bh >> 3, h = bh & 7;
                const size_t hb = (size_t)b * SEQ * D + h * HD;
                att::kv_unit(qbuf + hb, kbuf + hb, vbuf + hb, selbuf + (size_t)bh * SEQ, obuf + hb, mlown + (size_t)bh * SEQ * 2, part + (size_t)bh * att::PROWS * HD, mlp + (size_t)bh * att::PROWS * 2, jb,
                             (char*)lds_raw + RING_OFF, lds + RING_OFF);
            }
            __syncthreads();
        }
        if (!convfirst) conv_pass();
    }
    }
    SEAM(PH_KV);

    if (IN(PH_COMB)) {
        wsp = (GAS unsigned char*)ws; asm volatile("" : "+s"(wsp)); PIN_ARGS();
        const unsigned char* part = (const unsigned char*)(wsp + WS_PART); const float* mlp = (const float*)((unsigned char*)(wsp + WS_MLP)); const float* mlown = (const float*)((unsigned char*)(wsp + WS_MLOWN));
        constexpr float C = att::SCALE * 1.4426950408889634f;
        constexpr int NIT = T * NH * 16;
        const int stride = G * 512;
#pragma unroll 1
        for (int base = vcu * 512 + tid; base < NIT; base += 4 * stride) {
            u32x2 ow[4]; u32x2 pw[4][3]; float m0[4], l0[4], mk[4][3], lk[4][3]; int nsv[4]; size_t opv[4];
#pragma unroll
            for (int u = 0; u < 4; ++u) {
                const int idx = base + u * stride; const int c8 = idx & 15; const int qh = idx >> 4; const int h = qh & 7, tq = qh >> 3, b = tq >> 12, s = tq & (SEQ - 1), i = s >> 8, ns = att::nsl_of(i), bh = b * NH + h;
                opv[u] = (size_t)tq * D + h * HD + c8 * 8; nsv[u] = ns;
                ow[u] = *(const u32x2*)(obuf + opv[u]);
                const f32x2 ml0 = *(const f32x2*)(mlown + ((size_t)bh * SEQ + s) * 2); m0[u] = ml0[0]; l0[u] = ml0[1];
                const size_t prow = (size_t)bh * att::PROWS + att::rowoff_of(i) + (s & 255) * ns;
#pragma unroll
                for (int k = 0; k < 3; ++k) { const size_t pr = prow + (k < ns ? k : 0);
                    const f32x2 mlk = *(const f32x2*)(mlp + pr * 2); mk[u][k] = mlk[0]; lk[u][k] = mlk[1]; pw[u][k] = *(const u32x2*)(part + pr * HD + c8 * 8); }
            }
#pragma unroll
            for (int u = 0; u < 4; ++u) {
                float M = m0[u];
#pragma unroll
                for (int k = 0; k < 3; ++k) if (k < nsv[u]) M = fmaxf(M, mk[u][k]);
                const float w0 = l0[u] * __builtin_amdgcn_exp2f((m0[u] - M) * C); float W = w0;
                float acc[8]; { float f0[4], f1[4]; up4_fp8(ow[u].x, f0); up4_fp8(ow[u].y, f1); const float ws0 = w0 * (1.0f / P8S);
                    acc[0] = f0[0] * ws0; acc[1] = f0[1] * ws0; acc[2] = f0[2] * ws0; acc[3] = f0[3] * ws0; acc[4] = f1[0] * ws0; acc[5] = f1[1] * ws0; acc[6] = f1[2] * ws0; acc[7] = f1[3] * ws0; }
#pragma unroll
                for (int k = 0; k < 3; ++k) { const float wk = (k < nsv[u]) ? lk[u][k] * __builtin_amdgcn_exp2f((mk[u][k] - M) * C) : 0.f; W += wk; const u32x2 p = pw[u][k];
                    float f0[4], f1[4]; up4_fp8(p.x, f0); up4_fp8(p.y, f1); const float ws = wk * (1.0f / P8S);
                    acc[0] += f0[0] * ws; acc[1] += f0[1] * ws; acc[2] += f0[2] * ws; acc[3] += f0[3] * ws; acc[4] += f1[0] * ws; acc[5] += f1[1] * ws; acc[6] += f1[2] * ws; acc[7] += f1[3] * ws; }
                const float iw = (WO_FP8 ? O8S : 1.0f) / W;
                u32x4 o; o.x = cvt_pk_bf16(acc[0] * iw, acc[1] * iw); o.y = cvt_pk_bf16(acc[2] * iw, acc[3] * iw); o.z = cvt_pk_bf16(acc[4] * iw, acc[5] * iw); o.w = cvt_pk_bf16(acc[6] * iw, acc[7] * iw);
#if WO_FP8
                { u32x2 o8; o8.x = pk4_fp8(acc[0] * iw, acc[1] * iw, acc[2] * iw, acc[3] * iw); o8.y = pk4_fp8(acc[4] * iw, acc[5] * iw, acc[6] * iw, acc[7] * iw); *(u32x2*)(o8buf + opv[u]) = o8; }
#else
                *(u32x4*)opv[u] = o;
#endif
            }
        }
    }
    SEAM(PH_COMB);

    if (IN(PH_WO)) {
        wsp = (GAS unsigned char*)ws; asm volatile("" : "+s"(wsp)); PIN_ARGS();
        ProbDenseT<WO_FP8 != 0> pr{WO_FP8 ? (const char*)o8buf : (const char*)obuf, (const char*)w_wo, WO_FP8 ? D / 2 : D, WO_FP8 ? D / 2 : D, 0};
        pg8::StaticOrder S; S.init(T / 256, 4, G, bx);
        EpiRes<false> E{nullptr, hbuf, ss3, h8buf, WO_FP8 ? 1.0f / (W8S_GU * O8S) : 1.0f};
        pg8::gemm_phase(lds + RING_OFF, pr, S, E);
    }
    SEAM(PH_WO);

    if (IN(PH_ROUTE)) {
        wsp = (GAS unsigned char*)ws; asm volatile("" : "+s"(wsp)); PIN_ARGS(); const float* ffn_norm = kap->in[2]; const float* router_w = kap->in[13];
        LAS unsigned* entL = (LAS unsigned*)(lds + XTRA_OFF);
        LAS unsigned* rankL = entL + 256;
        int lane_r = threadIdx.x; asm volatile("" : "+v"(lane_r) :: "memory"); lane_r &= 63;
        float wr_[16][8];
#pragma unroll
        for (int j = 0; j < 16; ++j) { const int k = (j < 8) ? 8 * lane_r + j : 512 + 8 * lane_r + (j - 8); const float gk = ffn_norm[D + k];
            const f32x4 a = *(const f32x4*)(router_w + (size_t)k * 8), b2 = *(const f32x4*)(router_w + (size_t)k * 8 + 4);
            wr_[j][0] = a[0] * gk; wr_[j][1] = a[1] * gk; wr_[j][2] = a[2] * gk; wr_[j][3] = a[3] * gk; wr_[j][4] = b2[0] * gk; wr_[j][5] = b2[1] * gk; wr_[j][6] = b2[2] * gk; wr_[j][7] = b2[3] * gk; }
        for (int chunk = vcu; chunk < T / 128; chunk += G) {
            const int t0 = chunk * 128;
            for (int i0 = 0; i0 < 16; i0 += 4) {
                float lg[4][8], sq4[4];
#pragma unroll
                for (int q = 0; q < 4; ++q) { const int t = t0 + wave * 16 + i0 + q;
                    const u32x4 h0 = *(const u32x4*)(hbuf + (size_t)t * D + 8 * lane_r), h1 = *(const u32x4*)(hbuf + (size_t)t * D + 512 + 8 * lane_r);
                    const float hv[16] = {bflo(h0.x), bfhi(h0.x), bflo(h0.y), bfhi(h0.y), bflo(h0.z), bfhi(h0.z), bflo(h0.w), bfhi(h0.w), bflo(h1.x), bfhi(h1.x), bflo(h1.y), bfhi(h1.y), bflo(h1.z), bfhi(h1.z), bflo(h1.w), bfhi(h1.w)};
#pragma unroll
                    for (int e = 0; e < 8; ++e) { float s = 0.f;
#pragma unroll
                        for (int j = 0; j < 16; ++j) s += hv[j] * wr_[j][e];
                        lg[q][e] = s; }
                    sq4[q] = (lane_r < 16) ? ss3[(size_t)t * 16 + lane_r] : 0.f; }
#pragma unroll
                for (int q = 0; q < 4; ++q) {
#pragma unroll
                    for (int e = 0; e < 8; ++e) lg[q][e] = wave_sum(lg[q][e]);
                    sq4[q] = wave_sum(sq4[q]); }
#pragma unroll
                for (int q = 0; q < 4; ++q) { const int tl = wave * 16 + i0 + q, t = t0 + tl;
                    const float rstd = 1.0f / sqrtf(sq4[q] * (1.0f / D) + EPS);
                    int i1 = 0; float v1 = lg[q][0];
#pragma unroll
                    for (int e = 1; e < 8; ++e) if (lg[q][e] > v1) { v1 = lg[q][e]; i1 = e; }
                    int i2 = -1; float v2 = -__builtin_inff();
#pragma unroll
                    for (int e = 0; e < 8; ++e) if (e != i1 && lg[q][e] > v2) { v2 = lg[q][e]; i2 = e; }
                    const float w1 = 1.0f / (1.0f + __expf((v2 - v1) * rstd));
                    if (lane_r == 0) { entL[tl * 2] = (unsigned)i1; entL[tl * 2 + 1] = (unsigned)i2; gatew[(size_t)t * 2] = w1; gatew[(size_t)t * 2 + 1] = 1.0f - w1; rstd3[t] = rstd; } }
            }
            __syncthreads();
            if (tid < 8) { unsigned c = 0; for (int j = 0; j < 256; ++j) if (entL[j] == (unsigned)tid) { rankL[j] = c; ++c; } bcnt[chunk * 8 + tid] = (int)c; }
            __syncthreads();
            if (tid < 256) ent[(size_t)t0 * 2 + tid] = entL[tid] | (rankL[tid] << 8);
            __syncthreads();
        }
    }
    SEAM(PH_ROUTE);

    if (IN(PH_LIST)) {
        wsp = (GAS unsigned char*)ws; asm volatile("" : "+s"(wsp)); PIN_ARGS();
        LAS int* cntL = (LAS int*)(lds + XTRA_OFF);
        LAS int* baseL = cntL + 2048;
        for (int chunk = vcu; chunk < T / 128; chunk += G) {
            for (int i = tid; i < 2048; i += 512) cntL[i] = bcnt[i];
            __syncthreads();
            if (tid < 8) { int tot = 0, pre = 0; for (int v2 = 0; v2 < 256; ++v2) { if (v2 == chunk) pre = tot; tot += cntL[v2 * 8 + tid]; } baseL[tid] = pre; baseL[16 + tid] = tot; }
            __syncthreads();
            if (tid == 0) { int seg = 0; for (int e = 0; e < 8; ++e) { baseL[8 + e] = seg; seg += (baseL[16 + e] + 255) & ~255; } baseL[24] = seg; }
            __syncthreads();
            if (tid < 256) { const unsigned en = ent[(size_t)chunk * 256 + tid]; const int e = en & 255, rk = en >> 8; const int t = chunk * 128 + (tid >> 1);
                const int pos = baseL[8 + e] + baseL[e] + rk;
                soff[pos] = (unsigned)t * D; srstd[pos] = rstd3[t]; sdst[pos] = t * 2 + (tid & 1); sgw[pos] = gatew[(size_t)t * 2 + (tid & 1)]; }
            if (chunk < 8) { const int e = chunk; const int tot = baseL[16 + e], seg = baseL[8 + e]; for (int p = tot + tid; p < ((tot + 255) & ~255); p += 512) { soff[seg + p] = 0u; srstd[seg + p] = 0.f; sdst[seg + p] = -1; sgw[seg + p] = 0.f; } }
            if (chunk == 0) { const int ntl = baseL[24] >> 8; for (int mt = tid; mt < ntl; mt += 512) { int e = 0; for (int q = 1; q < 8; ++q) if (mt * 256 >= baseL[8 + q]) e = q; texp[mt] = e; } if (tid == 0) ctl[CW_NTILES] = (unsigned)ntl; }
            __syncthreads();
        }
    }
    SEAM(PH_LIST);

#ifndef REP_G1
#define REP_G1 1
#endif
#ifndef REP_G2
#define REP_G2 1
#endif
#ifndef REP_MOE
#define REP_MOE 1
#endif
    for (int rep = 0; rep < REP_MOE; ++rep) { if (rep) xcd_barrier(bar);
#pragma unroll 1
    for (int st = 0; st < MOE_STEPS; ++st) {
        if (IN(PH_MOE0 + st)) {
            wsp = (GAS unsigned char*)ws; asm volatile("" : "+s"(wsp)); PIN_ARGS(); const float* mwd = kap->in[16];
            const int ntiles = (int)__hip_atomic_load(ctl + CW_NTILES, RLX_AGENT);
            const int nrem = ntiles > 256 ? ntiles - 256 : 0;
            bf16* act2 = (bf16*)(unsigned char*)(wsp + WS_ACT2);
            LAS int* texpL = (LAS int*)(lds + XTRA_OFF + 16384);
            { int tm_ = threadIdx.x; asm volatile("" : "+v"(tm_)); for (int i = tm_; i < MOE_TILES_MAX; i += NWAVES * 64) texpL[i] = texp[i]; }
            __syncthreads();
#ifndef MOE_NO_G2
            if (st >= 1) { const int c = st - 1; const int nM = CHUNK_TILES + (c == 0 ? nrem : 0);
                ProbMoeG2 pr{(const char*)(unsigned char*)(wsp + ((c & 1) ? WS_ACT1 : WS_ACT0)), (const char*)act2, (const char*)w_md8, FE / 2, FE / 2, texpL, c * CHUNK_TILES, CHUNK_TILES};
                pg8::StaticOrder S; S.init(nM, 4, G, bx);
                EpiMoeOut E{y8buf, sdst, sgw, c * CHUNK_TILES, CHUNK_TILES};
                for (int r2 = 0; r2 < REP_G2; ++r2) pg8::gemm_phase(lds + RING_OFF, pr, S, E); }
#endif
#ifndef MOE_NO_G1
            if (st < MOE_STEPS - 1) { const int c = st; const int nM = CHUNK_TILES + (c == 0 ? nrem : 0);
                ProbMoeG1 pr{(const char*)h8buf, (const char*)w_mgu8, D / 2, D / 2, soff, texpL, c * CHUNK_TILES, CHUNK_TILES};
                EpiSwiGLU<true, FE> E{(bf16*)(unsigned char*)(wsp + ((c & 1) ? WS_ACT1 : WS_ACT0)), RstdTable{nullptr, -1, 0}, srstd, c * CHUNK_TILES, CHUNK_TILES, act2};
                if (st == 1 && nrem > 0 && G == 256) { SkewOrder S; S.init(nM, 2 * FE / 256, G, bx); S.e = 4 * nrem; pg8::gemm_phase(lds + RING_OFF, pr, S, E); }
                else { pg8::StaticOrder S; S.init(nM, 2 * FE / 256, G, bx); for (int r1 = 0; r1 < REP_G1; ++r1) pg8::gemm_phase(lds + RING_OFF, pr, S, E); } }
#endif
        }
        SEAM(PH_MOE0 + st);
    }
    }

    if (IN(PH_FINAL)) {
        wsp = (GAS unsigned char*)ws; asm volatile("" : "+s"(wsp)); PIN_ARGS(); const float* final_norm = kap->in[17]; float* out_f = kap->out;
        int tf_ = threadIdx.x; asm volatile("" : "+v"(tf_)); const int lane_f = tf_ & 63;
        const unsigned tmo = __hip_atomic_load(ctl + CW_BAR + XB_TMO, RLX_AGENT);
        f32x4 gn[4];
#pragma unroll
        for (int j = 0; j < 4; ++j) gn[j] = *(const f32x4*)(final_norm + 16 * lane_f + 4 * j);
        for (int t0 = gw; t0 < T; t0 += 2 * NGW) {
            f32x4 v[2][4]; float s2[2];
#pragma unroll
            for (int q = 0; q < 2; ++q) { const int t = t0 + q * NGW;
                const u32x4 a0 = *(const u32x4*)(hbuf + (size_t)t * D + 16 * lane_f), a1 = *(const u32x4*)(hbuf + (size_t)t * D + 16 * lane_f + 8);
                const u32x4 y = *(const u32x4*)(y8buf + (size_t)t * 2 * D + 16 * lane_f), z = *(const u32x4*)(y8buf + (size_t)t * 2 * D + D + 16 * lane_f);
                float yf[4][4], zf[4][4]; up4_fp8(y.x, yf[0]); up4_fp8(y.y, yf[1]); up4_fp8(y.z, yf[2]); up4_fp8(y.w, yf[3]); up4_fp8(z.x, zf[0]); up4_fp8(z.y, zf[1]); up4_fp8(z.z, zf[2]); up4_fp8(z.w, zf[3]);
                constexpr float YI = 1.0f / Y8S;
                v[q][0] = (f32x4){bflo(a0.x) + (yf[0][0] + zf[0][0]) * YI, bfhi(a0.x) + (yf[0][1] + zf[0][1]) * YI, bflo(a0.y) + (yf[0][2] + zf[0][2]) * YI, bfhi(a0.y) + (yf[0][3] + zf[0][3]) * YI};
                v[q][1] = (f32x4){bflo(a0.z) + (yf[1][0] + zf[1][0]) * YI, bfhi(a0.z) + (yf[1][1] + zf[1][1]) * YI, bflo(a0.w) + (yf[1][2] + zf[1][2]) * YI, bfhi(a0.w) + (yf[1][3] + zf[1][3]) * YI};
                v[q][2] = (f32x4){bflo(a1.x) + (yf[2][0] + zf[2][0]) * YI, bfhi(a1.x) + (yf[2][1] + zf[2][1]) * YI, bflo(a1.y) + (yf[2][2] + zf[2][2]) * YI, bfhi(a1.y) + (yf[2][3] + zf[2][3]) * YI};
                v[q][3] = (f32x4){bflo(a1.z) + (yf[3][0] + zf[3][0]) * YI, bfhi(a1.z) + (yf[3][1] + zf[3][1]) * YI, bflo(a1.w) + (yf[3][2] + zf[3][2]) * YI, bfhi(a1.w) + (yf[3][3] + zf[3][3]) * YI};
                float s = 0.f;
#pragma unroll
                for (int j = 0; j < 4; ++j) s += (v[q][j][0] * v[q][j][0] + v[q][j][1] * v[q][j][1]) + (v[q][j][2] * v[q][j][2] + v[q][j][3] * v[q][j][3]);
                s2[q] = s; }
            s2[0] = wave_sum(s2[0]); s2[1] = wave_sum(s2[1]);
            asm volatile("s_waitcnt vmcnt(0)" ::: "memory");
#pragma unroll
            for (int q = 0; q < 2; ++q) { const int t = t0 + q * NGW;
                float rstd = 1.0f / sqrtf(s2[q] * (1.0f / D) + EPS);
                if (tmo) rstd = __builtin_nanf("");
#pragma unroll
                for (int j = 0; j < 4; ++j) *(f32x4*)(out_f + (size_t)t * D + 16 * lane_f + 4 * j) = v[q][j] * rstd * gn[j]; }
        }
    }
#undef IN
#undef SEAM
}

#ifndef MK_ONE_LAUNCH
#define MK_ONE_LAUNCH 1
#endif
extern "C" void kernel_launch(void* const* d_in, const int* in_sizes, int n_in, void* d_out, int out_size, void* d_ws, size_t ws_size, hipStream_t stream) {
    static int grid = 0;
    if (grid == 0) {
        if (n_in != 18 || in_sizes[0] != T * D || out_size != T * D || ws_size < WS_END) { fprintf(stderr, "kernel_launch: shape mismatch n_in %d in0 %d out %d ws %zu (need %zu)\n", n_in, n_in > 0 ? in_sizes[0] : -1, out_size, ws_size, (size_t)WS_END); grid = -1; return; }
        int dev = 0, cus = 0, per_cu = 0;
        if (hipGetDevice(&dev) != hipSuccess || hipDeviceGetAttribute(&cus, hipDeviceAttributeMultiprocessorCount, dev) != hipSuccess) { grid = -1; return; }
        if (hipFuncSetAttribute((const void*)yoco_fwd, hipFuncAttributeMaxDynamicSharedMemorySize, LDS_BYTES) != hipSuccess) { fprintf(stderr, "kernel_launch: hipFuncSetAttribute failed\n"); grid = -1; return; }
        if (hipOccupancyMaxActiveBlocksPerMultiprocessor(&per_cu, (const void*)yoco_fwd, NWAVES * 64, LDS_BYTES) != hipSuccess || per_cu < 1) fprintf(stderr, "kernel_launch: occupancy query says %d\n", per_cu);
        (void)hipGetLastError();
        grid = cus;
    }
    if (grid < 0) return;
    (void)hipMemsetAsync((char*)d_ws + WS_CTL, 0, CTL_ZERO_BYTES, stream);
    Args a{};
    for (int i = 0; i < 18; ++i) a.in[i] = (const float*)d_in[i];
    a.out = (float*)d_out; a.ws = (unsigned char*)d_ws;
#if MK_ONE_LAUNCH
    a.ph_lo = 0; a.ph_hi = PH_COUNT;
    hipLaunchKernelGGL(yoco_fwd, dim3(grid), dim3(NWAVES * 64), LDS_BYTES, stream, a);
#else
    for (int p = 0; p < PH_COUNT; ++p) { a.ph_lo = p; a.ph_hi = p + 1; hipLaunchKernelGGL(yoco_fwd, dim3(grid), dim3(NWAVES * 64), LDS_BYTES, stream, a); }
#endif
}
```

```cpp
#include <hip/hip_runtime.h>
#include <cstdio>
#include <cstdint>

#define LAS __attribute__((address_space(3)))
#define GAS __attribute__((address_space(1)))
typedef unsigned short bf16;
typedef short bf16x8 __attribute__((ext_vector_type(8)));
typedef short s16x4 __attribute__((ext_vector_type(4)));
typedef float f32x4 __attribute__((ext_vector_type(4)));
typedef float f32x16 __attribute__((ext_vector_type(16)));
typedef unsigned u32x4 __attribute__((ext_vector_type(4)));
typedef unsigned u32x2 __attribute__((ext_vector_type(2)));
typedef float f32x2 __attribute__((ext_vector_type(2)));
typedef long l64x2 __attribute__((ext_vector_type(2)));
typedef int i32x4 __attribute__((ext_vector_type(4)));
typedef int i32x8 __attribute__((ext_vector_type(8)));

constexpr int T = 32768, D = 1024, SEQ = 4096, NBATCH = 8, NH = 8, HD = 128, FF = 2816, FE = 3584, NE = 8, NBLK = 16;
constexpr float EPS = 1e-6f;
constexpr int NWAVES = 8;
constexpr int MOE_ROWS_MAX = 2 * T + NE * 256;
constexpr int MOE_TILES_MAX = MOE_ROWS_MAX / 256;
constexpr int CHUNK_TILES = 64;
constexpr int CONV_WGS = 64;
constexpr int MOE_STEPS = 5;

constexpr size_t MiB = 1u << 20, KiB = 1u << 10;
constexpr size_t WS_CTL = 0, CTL_ZERO_BYTES = 64 * KiB;
constexpr size_t WS_ROPE_C = 1 * MiB, WS_ROPE_S = 1 * MiB + 256 * KiB;
constexpr size_t WS_KMEAN = 1 * MiB + 512 * KiB;
constexpr size_t WS_SS1 = 2 * MiB, WS_SS2 = 4 * MiB, WS_SS3 = 6 * MiB;
constexpr size_t WS_RSTD3 = 8 * MiB;
constexpr size_t WS_GATEW = 8 * MiB + 128 * KiB;
constexpr size_t WS_ENT = 8 * MiB + 384 * KiB;
constexpr size_t WS_BCNT = 8 * MiB + 640 * KiB;
constexpr size_t WS_SOFF = 9 * MiB, WS_SRSTD = 9 * MiB + 512 * KiB, WS_SDST = 10 * MiB, WS_SGW = 10 * MiB + 512 * KiB;
constexpr size_t WS_TEXP = 11 * MiB;
constexpr size_t WS_W_POOL = 12 * MiB;
constexpr size_t WS_W_QKV = WS_W_POOL + 512 * KiB;
constexpr size_t WS_W_WO = WS_W_QKV + 6 * MiB;
constexpr size_t WS_W_FGU = WS_W_WO + 2 * MiB;
constexpr size_t WS_W_FD = WS_W_FGU + 11 * MiB;
constexpr size_t WS_PART = WS_W_FD + 5 * MiB + 512 * KiB;
constexpr size_t WS_W_MGU = WS_PART + 84 * MiB;
constexpr size_t WS_W_MD = WS_W_MGU + 56 * MiB;
constexpr size_t WS_H = WS_W_MD + 28 * MiB;
constexpr size_t WS_R = WS_H + 64 * MiB;
constexpr size_t WS_POOLED = WS_R;
constexpr size_t WS_FACT = WS_R;
constexpr size_t WS_Q = WS_R, WS_K = WS_R + 64 * MiB, WS_V = WS_R + 128 * MiB;
constexpr size_t WS_MLP = WS_R + 192 * MiB;
constexpr size_t WS_MLOWN = WS_R + 198 * MiB;
constexpr size_t WS_SEL = WS_SS1;
constexpr size_t WS_ACT0 = WS_R, WS_ACT1 = WS_R + 56 * MiB;
constexpr size_t WS_ACT2 = WS_R + 112 * MiB;
constexpr size_t WS_H8 = WS_R + 120 * MiB;
constexpr size_t WS_Y8 = WS_R + 152 * MiB;
constexpr size_t WS_END = WS_R + 239 * MiB;
constexpr float W8S_GU = 32.f, W8S_DN = 64.f, ACT8S = 4.f;
static_assert(WS_H == 205 * MiB && WS_END == 508 * MiB && WS_PART + (size_t)64 * 10752 * 128 == WS_W_MGU, "ws map");
constexpr int CW_TMO = 0, CW_CODE = 1, CW_BAR = 4096, CW_NTILES = 8192, CW_CONVQ = 8256, CW_KVQ = 8448;

constexpr int RING_OFF = 0, RING_BYTES = 131072;
constexpr int LDSCTL_OFF = RING_BYTES, MISC_OFF = LDSCTL_OFF + 320, XTRA_OFF = LDSCTL_OFF + 1024;
constexpr int LDS_BYTES = 155648;

#define RLX_AGENT __ATOMIC_RELAXED, __HIP_MEMORY_SCOPE_AGENT
#define LDS_WAIT() asm volatile("s_waitcnt lgkmcnt(0)" ::: "memory")
#define VM_WAIT() asm volatile("s_waitcnt vmcnt(0)" ::: "memory")
__device__ __forceinline__ unsigned f2bf(float f) { unsigned u = __builtin_bit_cast(unsigned, f); return (u + 0x7fffu + ((u >> 16) & 1u)) >> 16; }
__device__ __forceinline__ unsigned pk2(float lo, float hi) { return f2bf(lo) | (f2bf(hi) << 16); }
__device__ __forceinline__ unsigned cvt_pk_bf16(float lo, float hi) { unsigned r; asm volatile("v_cvt_pk_bf16_f32 %0, %1, %2" : "=v"(r) : "v"(lo), "v"(hi)); return r; }
typedef float f32x2v __attribute__((ext_vector_type(2)));
__device__ __forceinline__ void up4_fp8(unsigned w, float (&f)[4]) { const f32x2v lo = __builtin_amdgcn_cvt_pk_f32_fp8((int)w, false), hi = __builtin_amdgcn_cvt_pk_f32_fp8((int)w, true); f[0] = lo[0]; f[1] = lo[1]; f[2] = hi[0]; f[3] = hi[1]; }
__device__ __forceinline__ unsigned pk4_fp8(float a, float b, float c, float d) { int w = 0; w = __builtin_amdgcn_cvt_pk_fp8_f32(a, b, w, false); w = __builtin_amdgcn_cvt_pk_fp8_f32(c, d, w, true); return (unsigned)w; }
__device__ __forceinline__ float bflo(unsigned w) { return __builtin_bit_cast(float, w << 16); }
__device__ __forceinline__ float bfhi(unsigned w) { return __builtin_bit_cast(float, w & 0xffff0000u); }
__device__ __forceinline__ float wave_sum(float v) {
#pragma unroll
    for (int o = 1; o < 64; o <<= 1) v += __shfl_xor(v, o);
    return v;
}

namespace pg8 {
constexpr int BM = 256, BK = 64, HALF = 128, HTB = HALF * BK * 2, STAGE_BYTES = 8 * HTB, NXCD = 8, WGM = 8;
constexpr int GSLOT_OFF = 132096, RSLOT_OFF = 132096 + 8192;
__host__ __device__ __forceinline__ int lds_byte(int r, int c) { return (r >> 3) * 1024 + (r & 7) * 128 + ((((c >> 3) ^ (r >> 1)) & 7) << 4) + (c & 7) * 2; }
__host__ __device__ __forceinline__ void stage_rc(int b, int& R, int& C) { const int q = b / 1024, p = b % 1024, rr = p / 128, cq = (p % 128) / 16; R = q * 8 + rr; C = ((cq ^ (R >> 1)) & 7) * 8; }
__host__ __device__ __forceinline__ int perm32(int rho) { const int n = rho >> 4, i = rho & 15; return 8 * (i >> 2) + 4 * n + (i & 3); }
struct Unit { int pm, pn; };
struct StaticOrder {
    int nM, nN, nwg, G, c;
    __device__ void init(int nM_, int nN_, int G_, int c_) { nM = nM_; nN = nN_; nwg = nM * nN; G = G_; c = c_; }
    __device__ bool next(int i, Unit& u) const {
        const long L = (long)i * G + c; if (L >= nwg) return false;
        int wgid = (int)L; { const int q = nwg / NXCD, r = nwg % NXCD, xcd = wgid % NXCD, off = wgid / NXCD; wgid = (xcd < r ? xcd * (q + 1) : r * (q + 1) + (xcd - r) * q) + off; }
        const int nig = WGM * nN, gid = wgid / nig, fm = gid * WGM, gsz = (nM - fm) < WGM ? (nM - fm) : WGM;
        u.pm = fm + ((wgid % nig) % gsz); u.pn = (wgid % nig) / gsz; return true;
    }
};
template <class P, class Epi, class Sched>
__device__ __forceinline__ void gemm_phase(LAS unsigned char* lds, const P& pr, const Sched& S, const Epi& E) {
    int tid_ = threadIdx.x; asm volatile("" : "+v"(tid_));
    const int tid = tid_, wid = __builtin_amdgcn_readfirstlane(tid >> 6), lane = tid & 63, wr = wid >> 2, wc = wid & 3, fr = lane & 15, fq = lane >> 4;
    const int K = pr.K, nt = K / BK;
    unsigned voffB[2], vcA[2][2]; int Rr[2]; unsigned Cc[2];
#pragma unroll
    for (int i = 0; i < 2; ++i) { int R, C; stage_rc(tid * 16 + i * 8192, R, C); const int Rb = (R & ~31) + perm32(R & 31);
        voffB[i] = (unsigned)(Rb * K + C) * 2u; Rr[i] = R; Cc[i] = (unsigned)C * 2u; }
    const size_t kstep = (size_t)(BK * 2);
    const size_t hstepB = (size_t)HALF * K * 2;
    const unsigned ldsw = (unsigned)wid * 1024u;
    const int aoff0 = lds_byte(wr * 64 + fr, fq * 8), boff0 = lds_byte(wc * 32 + fr, fq * 8);
#define PG8_SA(b, h) (((b) * 2 + (h)) * HTB)
#define PG8_SB(b, h) ((4 + (b) * 2 + (h)) * HTB)
#define PG8_STAGE(bufoff, gbase, voff) do { _Pragma("unroll") for (int _i = 0; _i < 2; ++_i) { unsigned vo_ = (voff)[_i]; asm volatile("" : "+v"(vo_));     \
        __builtin_amdgcn_global_load_lds((const unsigned*)((const char*)(gbase) + vo_), (LAS unsigned*)(lds + (bufoff) + ldsw + _i * 8192), 16, 0, 0); } } while (0)
#define PG8_X64(o1, o0) int o1; asm volatile("v_xor_b32 %0, 64, %1" : "=v"(o1) : "v"(o0))
#define PG8_LDA(dst, b, h) do { PG8_X64(aoff1, aoff0); _Pragma("unroll") for (int m = 0; m < 4; ++m) { dst[m][0] = *(const LAS bf16x8*)(lds + PG8_SA(b, h) + aoff0 + m * 2048); dst[m][1] = *(const LAS bf16x8*)(lds + PG8_SA(b, h) + aoff1 + m * 2048); } } while (0)
#define PG8_LDB(dst, b, h) do { PG8_X64(boff1, boff0); _Pragma("unroll") for (int n = 0; n < 2; ++n) { dst[n][0] = *(const LAS bf16x8*)(lds + PG8_SB(b, h) + boff0 + n * 2048); dst[n][1] = *(const LAS bf16x8*)(lds + PG8_SB(b, h) + boff1 + n * 2048); } } while (0)
#define PG8_MMA(ai, bj, At, Bt) do { __builtin_amdgcn_s_setprio(1); \
        if constexpr (P::FP8) { _Pragma("unroll") for (int m = 0; m < 4; ++m) _Pragma("unroll") for (int n = 0; n < 2; ++n) { \
            const i32x8 a8_ = __builtin_shufflevector(__builtin_bit_cast(i32x4, At[m][0]), __builtin_bit_cast(i32x4, At[m][1]), 0, 1, 2, 3, 4, 5, 6, 7); \
            const i32x8 b8_ = __builtin_shufflevector(__builtin_bit_cast(i32x4, Bt[n][0]), __builtin_bit_cast(i32x4, Bt[n][1]), 0, 1, 2, 3, 4, 5, 6, 7); \
            asm volatile("v_mfma_scale_f32_16x16x128_f8f6f4 %0, %1, %2, %0, %3, %3 op_sel_hi:[0,0,0]" : "+v"(acc[ai][bj][m][n]) : "v"(b8_), "v"(a8_), "v"(sc1_)); } }     \
        else { _Pragma("unroll") for (int m = 0; m < 4; ++m) _Pragma("unroll") for (int n = 0; n < 2; ++n) _Pragma("unroll") for (int k = 0; k < 2; ++k) \
            acc[ai][bj][m][n] = __builtin_amdgcn_mfma_f32_16x16x32_bf16(Bt[n][k], At[m][k], acc[ai][bj][m][n], 0, 0, 0); } \
        __builtin_amdgcn_s_setprio(0); } while (0)
#define PG8_MMA0(ai, bj, At, Bt) do { __builtin_amdgcn_s_setprio(1);        \
        if constexpr (P::FP8) { _Pragma("unroll") for (int m = 0; m < 4; ++m) _Pragma("unroll") for (int n = 0; n < 2; ++n) { \
            const i32x8 a8_ = __builtin_shufflevector(__builtin_bit_cast(i32x4, At[m][0]), __builtin_bit_cast(i32x4, At[m][1]), 0, 1, 2, 3, 4, 5, 6, 7); \
            const i32x8 b8_ = __builtin_shufflevector(__builtin_bit_cast(i32x4, Bt[n][0]), __builtin_bit_cast(i32x4, Bt[n][1]), 0, 1, 2, 3, 4, 5, 6, 7); \
            asm volatile("v_mfma_scale_f32_16x16x128_f8f6f4 %0, %1, %2, 0, %3, %3 op_sel_hi:[0,0,0]" : "=v"(acc[ai][bj][m][n]) : "v"(b8_), "v"(a8_), "v"(sc1_)); } } \
        else { _Pragma("unroll") for (int m = 0; m < 4; ++m) _Pragma("unroll") for (int n = 0; n < 2; ++n) { \
            acc[ai][bj][m][n] = __builtin_amdgcn_mfma_f32_16x16x32_bf16(Bt[n][0], At[m][0], (f32x4){0.f, 0.f, 0.f, 0.f}, 0, 0, 0); \
            acc[ai][bj][m][n] = __builtin_amdgcn_mfma_f32_16x16x32_bf16(Bt[n][1], At[m][1], acc[ai][bj][m][n], 0, 0, 0); } } \
        __builtin_amdgcn_s_setprio(0); } while (0)
#define PG8_WAIT_V(n) asm volatile("s_waitcnt vmcnt(" #n ")" ::: "memory")
#define PG8_WAIT_L(n) asm volatile("s_waitcnt lgkmcnt(" #n ")" ::: "memory")
#define PG8_BAR __builtin_amdgcn_s_barrier()
#define PG8_SCHED __builtin_amdgcn_sched_barrier(0)
    Unit cur, nxt; int ui = 0;
    if (!S.next(0, cur)) return;
    int sc1_ = 0x7f7f7f7f; asm volatile("" : "+v"(sc1_));
    f32x4 acc[2][2][4][2];
    bf16x8 At[4][2], B0[2][2], B1[2][2];
    const char* cA = pr.a_base(cur); const char* cB = pr.b_base(cur);
    if constexpr (Epi::PREFETCH) E.prefetch(lds, cur, ldsw, lane);
    if constexpr (P::GATHER) {
        const unsigned* rl = pr.rows(cur);
#pragma unroll
        for (int h = 0; h < 2; ++h)
#pragma unroll
            for (int i = 0; i < 2; ++i) vcA[h][i] = rl[h * HALF + Rr[i]] + Cc[i];
    } else {
#pragma unroll
        for (int h = 0; h < 2; ++h)
#pragma unroll
            for (int i = 0; i < 2; ++i) vcA[h][i] = (unsigned)((h * HALF + Rr[i]) * pr.lda) * 2u + Cc[i];
    }
    PG8_STAGE(PG8_SB(0, 0), cB, voffB); PG8_STAGE(PG8_SB(0, 1), cB + hstepB, voffB); PG8_STAGE(PG8_SA(0, 0), cA, vcA[0]); PG8_STAGE(PG8_SA(0, 1), cA, vcA[1]);
    if (wr == 1) PG8_BAR;
    PG8_WAIT_V(2); PG8_BAR;
    PG8_STAGE(PG8_SB(1, 0), cB + kstep, voffB); PG8_STAGE(PG8_SA(1, 0), cA + kstep, vcA[0]); PG8_STAGE(PG8_SB(1, 1), cB + hstepB + kstep, voffB);
    PG8_WAIT_V(6); PG8_BAR;
    for (;;) {
        const bool has_next = S.next(ui + 1, nxt);
        const char* nA = has_next ? pr.a_base(nxt) : cA; const char* nB = has_next ? pr.b_base(nxt) : cB;
        if constexpr (P::GATHER) {
            if (has_next) { const unsigned* rn = pr.rows(nxt);
#pragma unroll
                for (int h = 0; h < 2; ++h)
#pragma unroll
                    for (int i = 0; i < 2; ++i) { int t2 = threadIdx.x; asm volatile("" : "+v"(t2)); int R2, C2; stage_rc(t2 * 16 + i * 8192, R2, C2);
                        __builtin_amdgcn_global_load_lds(rn + h * HALF + R2, (LAS unsigned*)(lds + GSLOT_OFF + ldsw + (h * 2 + i) * 256), 4, 0, 0); } }
        }
        for (int t = 0; t < nt; t += 2) {
            const bool last = (t == nt - 2);
            const char* a1 = cA + (size_t)(t + 1) * kstep;
            const char* a2 = last ? nA : cA + (size_t)(t + 2) * kstep; const char* b2 = last ? nB : cB + (size_t)(t + 2) * kstep;
            const char* a3 = a2 + kstep; const char* b3 = b2 + kstep;
            PG8_LDB(B0, 0, 0); PG8_LDB(B1, 0, 1); PG8_SCHED; PG8_LDA(At, 0, 0); PG8_STAGE(PG8_SA(1, 1), a1, vcA[1]);
            if constexpr (P::GATHER) { if (last && has_next) {
#pragma unroll
                for (int h = 0; h < 2; ++h)
#pragma unroll
                    for (int i = 0; i < 2; ++i) { int t3 = threadIdx.x; asm volatile("" : "+v"(t3)); int R3, C3; stage_rc(t3 * 16 + i * 8192, R3, C3);
                        vcA[h][i] = *(const LAS unsigned*)(lds + GSLOT_OFF + ldsw + (h * 2 + i) * 256 + (t3 & 63) * 4) + (unsigned)C3 * 2u; } } }
            PG8_WAIT_V(8); PG8_WAIT_L(0); PG8_BAR; if (t == 0) { PG8_MMA0(0, 0, At, B0); PG8_MMA0(0, 1, At, B1); } else { PG8_MMA(0, 0, At, B0); PG8_MMA(0, 1, At, B1); } PG8_BAR; PG8_SCHED;
            PG8_LDA(At, 0, 1); PG8_STAGE(PG8_SB(0, 0), b2, voffB); PG8_STAGE(PG8_SB(0, 1), b2 + hstepB, voffB); PG8_STAGE(PG8_SA(0, 0), a2, vcA[0]);
            PG8_WAIT_V(8); PG8_WAIT_L(0); PG8_BAR; if (t == 0) { PG8_MMA0(1, 0, At, B0); PG8_MMA0(1, 1, At, B1); } else { PG8_MMA(1, 0, At, B0); PG8_MMA(1, 1, At, B1); } PG8_BAR; PG8_SCHED;
            PG8_LDB(B0, 1, 0); PG8_LDB(B1, 1, 1); PG8_SCHED; PG8_LDA(At, 1, 0); PG8_STAGE(PG8_SA(0, 1), a2, vcA[1]);
            PG8_WAIT_V(8); PG8_WAIT_L(0); PG8_BAR; PG8_MMA(0, 0, At, B0); PG8_MMA(0, 1, At, B1); PG8_BAR; PG8_SCHED;
            PG8_LDA(At, 1, 1); PG8_STAGE(PG8_SB(1, 0), b3, voffB); PG8_STAGE(PG8_SB(1, 1), b3 + hstepB, voffB); PG8_STAGE(PG8_SA(1, 0), a3, vcA[0]);
            PG8_WAIT_V(8); PG8_WAIT_L(0); PG8_BAR; PG8_MMA(1, 0, At, B0); PG8_MMA(1, 1, At, B1); PG8_BAR; PG8_SCHED;
        }
        if (wr == 0) PG8_BAR;
        if constexpr (P::FP8) asm volatile("s_nop 15\n\ts_nop 15" ::: "memory");
        { int te_ = threadIdx.x; asm volatile("" : "+v"(te_)); const int fr_e = te_ & 15, fq_e = (te_ >> 4) & 3;
          if constexpr (Epi::PREFETCH) E.run(acc, cur, wr, wc, fr_e, fq_e, lds, ldsw); else E(acc, cur, wr, wc, fr_e, fq_e); }
        if (!has_next) break;
        cur = nxt; cA = nA; cB = nB; ++ui;
        if constexpr (Epi::PREFETCH) { int tp_ = threadIdx.x; asm volatile("" : "+v"(tp_)); E.prefetch(lds, cur, ldsw, tp_ & 63); }
        if (wr == 1) PG8_BAR;
    }
    PG8_WAIT_V(0);
    PG8_BAR;
#undef PG8_SA
#undef PG8_SB
#undef PG8_STAGE
#undef PG8_LDA
#undef PG8_X64
#undef PG8_LDB
#undef PG8_MMA
#undef PG8_MMA0
#undef PG8_WAIT_V
#undef PG8_WAIT_L
#undef PG8_BAR
#undef PG8_SCHED
}
}

#ifndef FFN1_FP8
#define FFN1_FP8 0
#endif
#ifndef FFN2_FP8
#define FFN2_FP8 1
#endif
#ifndef WO_FP8
#define WO_FP8 1
#endif
constexpr float O8S = 16.f;
constexpr float P8S = 16.f, Y8S = 16.f;
#ifndef QKV_FP8
#define QKV_FP8 1
#endif
template <bool F8> struct ProbDenseT {
    static constexpr bool GATHER = false, FP8 = F8;
    const char* A; const char* B; int K, lda; int a_pn_step;
    __device__ __forceinline__ const char* a_base(const pg8::Unit& u) const { return A + (size_t)u.pm * 256 * lda * 2 + (size_t)u.pn * a_pn_step; }
    __device__ __forceinline__ const char* b_base(const pg8::Unit& u) const { return B + (size_t)u.pn * 256 * K * 2; }
    __device__ __forceinline__ const unsigned* rows(const pg8::Unit&) const { return nullptr; }
};
typedef ProbDenseT<false> ProbDense;
__device__ __forceinline__ int moe_tile(int pm, int mt0, int nmain) { return pm < nmain ? mt0 + pm : 256 + pm - nmain; }
struct ProbMoeG1 {
    static constexpr bool GATHER = true, FP8 = true;
    const char* A; const char* B; int K, lda; const unsigned* soff; const LAS int* texp; int mt0, nmain;
    __device__ __forceinline__ const char* a_base(const pg8::Unit&) const { return A; }
    __device__ __forceinline__ const char* b_base(const pg8::Unit& u) const { const int e = texp[moe_tile(u.pm, mt0, nmain)]; return B + ((size_t)e * (2 * FE) + (size_t)u.pn * 256) * D; }
    __device__ __forceinline__ const unsigned* rows(const pg8::Unit& u) const { return soff + (size_t)moe_tile(u.pm, mt0, nmain) * 256; }
};
struct ProbMoeG2 {
    static constexpr bool GATHER = false, FP8 = true;
    const char* A; const char* A2; const char* B; int K, lda; const LAS int* texp; int mt0, nmain;
    __device__ __forceinline__ const char* a_base(const pg8::Unit& u) const { return u.pm < nmain ? A + (size_t)u.pm * 256 * FE : A2 + (size_t)(u.pm - nmain) * 256 * FE; }
    __device__ __forceinline__ const char* b_base(const pg8::Unit& u) const { const int e = texp[moe_tile(u.pm, mt0, nmain)]; return B + ((size_t)e * D + (size_t)u.pn * 256) * FE; }
    __device__ __forceinline__ const unsigned* rows(const pg8::Unit&) const { return nullptr; }
};
struct SkewOrder : pg8::StaticOrder {
    int e;
    __device__ bool next(int i, pg8::Unit& u) const {
        long L;
        if (c < e) { if (i >= 3) return false; L = (long)i * G + c; }
        else if (i < 7) L = (long)i * G + c;
        else { const int rho = c - e; if (i > 7 || rho >= 4 * e) return false; L = (long)(3 + rho / e) * G + (rho % e); }
        if (L >= nwg) return false;
        int wgid = (int)L; { const int q = nwg / pg8::NXCD, r = nwg % pg8::NXCD, xcd = wgid % pg8::NXCD, off = wgid / pg8::NXCD; wgid = (xcd < r ? xcd * (q + 1) : r * (q + 1) + (xcd - r) * q) + off; }
        const int nig = pg8::WGM * nN, gid = wgid / nig, fm = gid * pg8::WGM, gsz = (nM - fm) < pg8::WGM ? (nM - fm) : pg8::WGM;
        u.pm = fm + ((wgid % nig) % gsz); u.pn = (wgid % nig) / gsz; return true;
    }
};

__device__ __forceinline__ void rstd_rows(const float* ss, int row0  , int fq, float (&rs)[2][4]) {
#pragma unroll
    for (int ai = 0; ai < 2; ++ai)
#pragma unroll
        for (int m = 0; m < 4; ++m) {
            const f32x4 p = *(const f32x4*)(ss + (size_t)(row0 + ai * 128 + m * 16) * 16 + 4 * fq);
            float s = (p[0] + p[1]) + (p[2] + p[3]);
            s += __shfl_xor(s, 16); s += __shfl_xor(s, 32);
            rs[ai][m] = __builtin_amdgcn_rsqf(s * (1.0f / D) + EPS);
        }
}
struct RstdTable {
    const float* ss; mutable int prev_pm; mutable int par;
    __device__ __forceinline__ void update(LAS unsigned char* lds, const pg8::Unit& u) const {
        if (u.pm != prev_pm) { prev_pm = u.pm; par ^= 1;
            int t_ = threadIdx.x; asm volatile("" : "+v"(t_)); const int t = t_, row = t >> 1, hf = t & 1;
            const float* p = ss + ((size_t)u.pm * 256 + row) * 16 + hf * 8;
            const f32x4 a = *(const f32x4*)p, b = *(const f32x4*)(p + 4);
            float s = ((a[0] + a[1]) + (a[2] + a[3])) + ((b[0] + b[1]) + (b[2] + b[3]));
            s += __shfl_xor(s, 1);
            if (hf == 0) *(LAS float*)(lds + pg8::RSLOT_OFF + par * 1024 + row * 4) = __builtin_amdgcn_rsqf(s * (1.0f / D) + EPS); }
    }
    __device__ __forceinline__ void rows(LAS unsigned char* lds, int wr, int fr, float (&rs)[2][4]) const {
#pragma unroll
        for (int ai = 0; ai < 2; ++ai)
#pragma unroll
            for (int m = 0; m < 4; ++m) rs[ai][m] = *(const LAS float*)(lds + pg8::RSLOT_OFF + par * 1024 + (ai * 128 + wr * 64 + m * 16 + fr) * 4);
    }
};
__device__ __forceinline__ float silu_mul(float g, float u) { return g * u * __builtin_amdgcn_rcpf(1.0f + __builtin_amdgcn_exp2f(-1.4426950408889634f * g)); }
__device__ __forceinline__ f32x4 silu4(f32x4 gp, f32x4 up) {
    f32x4 e; e[0] = __builtin_amdgcn_exp2f(gp[0]); e[1] = __builtin_amdgcn_exp2f(gp[1]); e[2] = __builtin_amdgcn_exp2f(gp[2]); e[3] = __builtin_amdgcn_exp2f(gp[3]);
    const f32x4 d = e + 1.0f; f32x4 q; q[0] = __builtin_amdgcn_rcpf(d[0]); q[1] = __builtin_amdgcn_rcpf(d[1]); q[2] = __builtin_amdgcn_rcpf(d[2]); q[3] = __builtin_amdgcn_rcpf(d[3]);
    return (gp * up) * q;
}

template <bool BASE_F32> struct EpiRes {
    static constexpr bool PREFETCH = false;
    const float* x; bf16* h; float* ss; unsigned char* h8; float sc;
    __device__ __forceinline__ void operator()(const f32x4 (&acc)[2][2][4][2], const pg8::Unit& u, int wr, int wc, int fr, int fq) const {
        const int row0 = u.pm * 256 + wr * 64 + fr, col0 = u.pn * 256 + wc * 32 + 8 * fq;
#pragma unroll
        for (int ai = 0; ai < 2; ++ai)
#pragma unroll
            for (int m = 0; m < 4; ++m) {
                const int row = row0 + ai * 128 + m * 16; float q = 0.f;
#pragma unroll
                for (int bj = 0; bj < 2; ++bj) {
                    f32x4 v0, v1; const size_t off = (size_t)row * D + col0 + bj * 128;
                    if constexpr (BASE_F32) { v0 = *(const f32x4*)(x + off); v1 = *(const f32x4*)(x + off + 4); }
                    else { const u32x4 w = *(const u32x4*)(h + off); v0 = (f32x4){bflo(w.x), bfhi(w.x), bflo(w.y), bfhi(w.y)}; v1 = (f32x4){bflo(w.z), bfhi(w.z), bflo(w.w), bfhi(w.w)}; }
                    v0 += acc[ai][bj][m][0] * sc; v1 += acc[ai][bj][m][1] * sc;
                    q += (v0[0] * v0[0] + v0[1] * v0[1]) + (v0[2] * v0[2] + v0[3] * v0[3]) + (v1[0] * v1[0] + v1[1] * v1[1]) + (v1[2] * v1[2] + v1[3] * v1[3]);
                    u32x4 o; o.x = cvt_pk_bf16(v0[0], v0[1]); o.y = cvt_pk_bf16(v0[2], v0[3]); o.z = cvt_pk_bf16(v1[0], v1[1]); o.w = cvt_pk_bf16(v1[2], v1[3]);
                    *(u32x4*)(h + off) = o;
                    if (h8) { u32x2 o8; o8.x = pk4_fp8(v0[0], v0[1], v0[2], v0[3]); o8.y = pk4_fp8(v1[0], v1[1], v1[2], v1[3]); *(u32x2*)(h8 + off) = o8; }
                }
                q += __shfl_xor(q, 16); q += __shfl_xor(q, 32);
                if (fq == 0) ss[(size_t)row * 16 + u.pn * 4 + wc] = q;
            }
    }
};
template <bool MOE, int LDO, bool O8 = MOE, bool W8 = MOE> struct EpiSwiGLU {
    static constexpr bool PREFETCH = true;
    bf16* act; RstdTable tab; const float* srstd; int mt0; int nmain; bf16* act2;
    __device__ __forceinline__ void prefetch(LAS unsigned char* lds, const pg8::Unit& u, unsigned ldsw, int lane) const {
        if constexpr (!MOE) { tab.update(lds, u); return; }
        const float* sp = srstd + (size_t)moe_tile(u.pm, mt0, nmain) * 256 + lane;
#pragma unroll
        for (int k = 0; k < 4; ++k) __builtin_amdgcn_global_load_lds((const unsigned*)(sp + k * 64), (LAS unsigned*)(lds + pg8::RSLOT_OFF + ldsw + k * 256), 4, 0, 0);
    }
    __device__ __forceinline__ void run(const f32x4 (&acc)[2][2][4][2], const pg8::Unit& u, int wr, int wc, int fr, int fq, LAS unsigned char* lds, unsigned ldsw) const {
        float rs[2][4];
        if constexpr (MOE) {
#pragma unroll
            for (int ai = 0; ai < 2; ++ai)
#pragma unroll
                for (int m = 0; m < 4; ++m) rs[ai][m] = *(const LAS float*)(lds + pg8::RSLOT_OFF + ldsw + (ai * 128 + wr * 64 + m * 16 + fr) * 4);
        } else tab.rows(lds, wr, fr, rs);
        body(acc, u, wr, wc, fr, fq, rs);
    }
    __device__ __forceinline__ void body(const f32x4 (&acc)[2][2][4][2], const pg8::Unit& u, int wr, int wc, int fr, int fq, const float (&rs)[2][4]) const {
        constexpr int ES = O8 ? 1 : 2;
        char* ob = (MOE && u.pm >= nmain) ? (char*)act2 + ((size_t)(u.pm - nmain) * 256 * LDO + (size_t)u.pn * 128) * ES : (char*)act + ((size_t)u.pm * 256 * LDO + (size_t)u.pn * 128) * ES;
        const unsigned vo = (unsigned)((wr * 64 + fr) * LDO + wc * 32 + 8 * fq) * (unsigned)ES;
#pragma unroll
        for (int ai = 0; ai < 2; ++ai)
#pragma unroll
            for (int m = 0; m < 4; ++m) {
                const float r = W8 ? rs[ai][m] * (1.0f / W8S_GU) : rs[ai][m];
                const float rg = r * -1.4426950408889634f, ru = r * (O8 ? -0.6931471805599453f * ACT8S : -0.6931471805599453f);
                const f32x4 s0 = silu4(acc[ai][0][m][0] * rg, acc[ai][1][m][0] * ru), s1 = silu4(acc[ai][0][m][1] * rg, acc[ai][1][m][1] * ru);
                if constexpr (O8) { u32x2 o; o.x = pk4_fp8(s0[0], s0[1], s0[2], s0[3]); o.y = pk4_fp8(s1[0], s1[1], s1[2], s1[3]);
                    *(u32x2*)(ob + (size_t)((ai * 128 + m * 16) * LDO) + vo) = o; }
                else {
                u32x4 o; o.x = cvt_pk_bf16(s0[0], s0[1]); o.y = cvt_pk_bf16(s0[2], s0[3]); o.z = cvt_pk_bf16(s1[0], s1[1]); o.w = cvt_pk_bf16(s1[2], s1[3]);
                *(u32x4*)(ob + (size_t)((ai * 128 + m * 16) * LDO * 2) + vo) = o; }
            }
    }
};
struct EpiQKV {
    static constexpr bool PREFETCH = true;
    bf16* Q; RstdTable tab; const float* rc; const float* rsn; float* kmean;
    __device__ __forceinline__ void prefetch(LAS unsigned char* lds, const pg8::Unit& u, unsigned ldsw, int lane) const { tab.update(lds, u); }
    __device__ __forceinline__ void run(const f32x4 (&acc)[2][2][4][2], const pg8::Unit& u, int wr, int wc, int fr, int fq, LAS unsigned char* lds, unsigned ldsw) const {
        const int row0 = u.pm * 256 + wr * 64 + fr; const int which = u.pn >> 2;
        bf16* O = Q + (size_t)which * ((WS_K - WS_Q) / 2);
        const int col0 = (u.pn & 3) * 256 + wc * 32 + 8 * fq;
        float rs[2][4]; tab.rows(lds, wr, fr, rs);
        f32x4 ks[2][2];
#pragma unroll
        for (int bj = 0; bj < 2; ++bj) { ks[bj][0] = (f32x4){0.f, 0.f, 0.f, 0.f}; ks[bj][1] = (f32x4){0.f, 0.f, 0.f, 0.f}; }
#pragma unroll
        for (int ai = 0; ai < 2; ++ai)
#pragma unroll
            for (int m = 0; m < 4; ++m) {
                const int row = row0 + ai * 128 + m * 16; const float r = QKV_FP8 ? rs[ai][m] * (1.0f / W8S_GU) : rs[ai][m];
                f32x4 cs = (f32x4){1.f, 1.f, 1.f, 1.f}, sn = (f32x4){0.f, 0.f, 0.f, 0.f};
                if (which < 2 && wc == 0) { const int pos = row & (SEQ - 1); cs = *(const f32x4*)(rc + pos * 16 + 4 * fq); sn = *(const f32x4*)(rsn + pos * 16 + 4 * fq); }
#pragma unroll
                for (int bj = 0; bj < 2; ++bj) {
                    f32x4 v0 = acc[ai][bj][m][0] * r, v1 = acc[ai][bj][m][1] * r;
                    if (which < 2 && wc == 0) { const f32x4 a = v0 * cs - v1 * sn, b = v1 * cs + v0 * sn; v0 = a; v1 = b; }
                    if (which == 1) { ks[bj][0] += v0; ks[bj][1] += v1; }
                    u32x4 o; o.x = cvt_pk_bf16(v0[0], v0[1]); o.y = cvt_pk_bf16(v0[2], v0[3]); o.z = cvt_pk_bf16(v1[0], v1[1]); o.w = cvt_pk_bf16(v1[2], v1[3]);
                    *(u32x4*)(O + (size_t)row * D + col0 + bj * 128) = o;
                }
            }
        if (which == 1) {
            const int b = u.pm >> 4, blk = u.pm & 15;
#pragma unroll
            for (int bj = 0; bj < 2; ++bj)
#pragma unroll
                for (int n = 0; n < 2; ++n) { f32x4 s = ks[bj][n];
#pragma unroll
                    for (int o = 1; o < 16; o <<= 1) { s[0] += __shfl_xor(s[0], o); s[1] += __shfl_xor(s[1], o); s[2] += __shfl_xor(s[2], o); s[3] += __shfl_xor(s[3], o); }
                    if (fr == 0) { const int head = (u.pn & 3) * 2 + bj; float* kp = kmean + ((size_t)(b * NH + head) * NBLK + blk) * HD + wc * 32 + 8 * fq + 4 * n;
                        atomicAdd(kp + 0, s[0]); atomicAdd(kp + 1, s[1]); atomicAdd(kp + 2, s[2]); atomicAdd(kp + 3, s[3]); } }
        }
    }
};
struct EpiMoeOut {
    static constexpr bool PREFETCH = false;
    unsigned char* Y; const int* sdst; const float* sgw; int mt0, nmain;
    __device__ __forceinline__ void operator()(const f32x4 (&acc)[2][2][4][2], const pg8::Unit& u, int wr, int wc, int fr, int fq) const {
        const int row0 = moe_tile(u.pm, mt0, nmain) * 256 + wr * 64 + fr, col0 = u.pn * 256 + wc * 32 + 8 * fq;
#pragma unroll
        for (int ai = 0; ai < 2; ++ai)
#pragma unroll
            for (int m = 0; m < 4; ++m) {
                const int sr = row0 + ai * 128 + m * 16; const int dst = sdst[sr]; const float g = sgw[sr] * (Y8S / (W8S_DN * ACT8S));
                if (dst >= 0) {
#pragma unroll
                    for (int bj = 0; bj < 2; ++bj) { const f32x4 v0 = acc[ai][bj][m][0] * g, v1 = acc[ai][bj][m][1] * g;
                        u32x2 o; o.x = pk4_fp8(v0[0], v0[1], v0[2], v0[3]); o.y = pk4_fp8(v1[0], v1[1], v1[2], v1[3]);
                        *(u32x2*)(Y + (size_t)dst * D + col0 + bj * 128) = o; }
                }
            }
    }
};

namespace att {
constexpr int KVBLK = 64, LDX = D;
constexpr float SCALE = 0.088388347648318440f, THR = 8.f;
constexpr size_t SHM_V = KVBLK * HD * 2, SHM_K = KVBLK * HD * 2, SHM_ATTN = 2 * SHM_V + 2 * SHM_K + NWAVES * 64 * 4;
#define KSWZ(row, colB) ((row) * 256 + ((colB) ^ (((row) & 7) << 4)))
#define SBAR() __builtin_amdgcn_sched_barrier(0)
__device__ __forceinline__ int crow(int r, int hi) { return (r & 3) + 8 * (r >> 2) + 4 * hi; }
__device__ __forceinline__ void partialSM(f32x16& p0, f32x16& p1, float& m_reg, float& mn, float& alpha) {
    constexpr float C = SCALE * 1.4426950408889634f;
    float pmax = p0[0];
#pragma unroll
    for (int r = 1; r < 16; ++r) pmax = fmaxf(pmax, p0[r]);
#pragma unroll
    for (int r = 0; r < 16; ++r) pmax = fmaxf(pmax, p1[r]);
    { auto rr = __builtin_amdgcn_permlane32_swap(__float_as_uint(pmax), __float_as_uint(pmax), false, false);
      pmax = fmaxf(__uint_as_float(rr[0]), __uint_as_float(rr[1])); }
    if (__builtin_expect(__all(pmax - m_reg <= THR / SCALE), 1)) { mn = m_reg; alpha = 1.f; }
    else { mn = fmaxf(m_reg, pmax); alpha = __builtin_amdgcn_exp2f((m_reg - mn) * C); m_reg = mn; }
    const float mnC = -mn * C;
#pragma unroll
    for (int r = 0; r < 16; ++r) p0[r] = fmaf(p0[r], C, mnC);
#pragma unroll
    for (int r = 0; r < 16; ++r) p1[r] = fmaf(p1[r], C, mnC);
#pragma unroll
    for (int r = 0; r < 16; ++r) p0[r] = __builtin_amdgcn_exp2f(p0[r]);
}
__device__ __forceinline__ void finishSM(f32x16& p0, f32x16& p1, float alpha, float& l_reg, bf16x8& pa0, bf16x8& pa1, bf16x8& pa2, bf16x8& pa3) {
#pragma unroll
    for (int r = 0; r < 16; ++r) p1[r] = __builtin_amdgcn_exp2f(p1[r]);
    float ps = 0;
#pragma unroll
    for (int r = 0; r < 16; ++r) ps += p0[r];
#pragma unroll
    for (int r = 0; r < 16; ++r) ps += p1[r];
    { auto rr = __builtin_amdgcn_permlane32_swap(__float_as_uint(ps), __float_as_uint(ps), false, false);
      ps = __uint_as_float(rr[0]) + __uint_as_float(rr[1]); }
    l_reg = l_reg * alpha + ps;
#define PK4(P, BASE, OUT) do { unsigned a0 = cvt_pk_bf16(P[BASE + 0], P[BASE + 1]), a1 = cvt_pk_bf16(P[BASE + 2], P[BASE + 3]);   \
    unsigned b0 = cvt_pk_bf16(P[BASE + 4], P[BASE + 5]), b1 = cvt_pk_bf16(P[BASE + 6], P[BASE + 7]);                              \
    auto r0 = __builtin_amdgcn_permlane32_swap(a0, b0, false, false); auto r1 = __builtin_amdgcn_permlane32_swap(a1, b1, false, false); \
    u32x4 w = {r0[0], r1[0], r0[1], r1[1]}; OUT = *reinterpret_cast<bf16x8*>(&w); } while (0)
    PK4(p0, 0, pa0); PK4(p0, 8, pa1); PK4(p1, 0, pa2); PK4(p1, 8, pa3);
#undef PK4
}
__device__ __forceinline__ void qkt(f32x16& p0, f32x16& p1, const char* Ks, const bf16x8* qr, int r32, int hi) {
    p0 = f32x16{}; p1 = f32x16{};
#pragma unroll
    for (int d0 = 0; d0 < 8; ++d0) { const int cb = (d0 * 16 + hi * 8) * 2;
        const bf16x8 b0 = *reinterpret_cast<const bf16x8*>(Ks + KSWZ(r32, cb));
        const bf16x8 b1 = *reinterpret_cast<const bf16x8*>(Ks + KSWZ(32 + r32, cb));
        p0 = __builtin_amdgcn_mfma_f32_32x32x16_bf16(b0, qr[d0], p0, 0, 0, 0);
        p1 = __builtin_amdgcn_mfma_f32_32x32x16_bf16(b1, qr[d0], p1, 0, 0, 0); }
}
__device__ __forceinline__ int v_st(int k, int c) { const int kk = (k & ~0xC) | ((k & 4) << 1) | ((k & 8) >> 1); return ((kk >> 3) * 4 + (c >> 5)) * 512 + ((kk & 7) * 32 + (c & 31)) * 2; }
__device__ __forceinline__ int v_rd_base(int lane) { return ((lane & 3) << 3) | (((lane >> 2) & 3) << 6) | (((lane >> 4) & 1) << 5) | (((lane >> 5) & 1) << 8); }
constexpr int v_rd_off(int d0, int ks, int half) { return d0 * 512 + ks * 4096 + half * 2048; }
template <int OFF> __device__ __forceinline__ s16x4 tr_read(int vb) {
    s16x4 r; asm volatile("ds_read_b64_tr_b16 %0, %1 offset:%2" : "=&v"(r) : "v"(vb), "i"(OFF) : "memory"); return r;
}
template <int D0, bool FIRST = false> __device__ __forceinline__ void pv_one(f32x16& od, int vb, bf16x8 pa0, bf16x8 pa1, bf16x8 pa2, bf16x8 pa3) {
    const s16x4 l0 = tr_read<v_rd_off(D0, 0, 0)>(vb), h0 = tr_read<v_rd_off(D0, 0, 1)>(vb), l1 = tr_read<v_rd_off(D0, 1, 0)>(vb), h1 = tr_read<v_rd_off(D0, 1, 1)>(vb);
    const s16x4 l2 = tr_read<v_rd_off(D0, 2, 0)>(vb), h2 = tr_read<v_rd_off(D0, 2, 1)>(vb), l3 = tr_read<v_rd_off(D0, 3, 0)>(vb), h3 = tr_read<v_rd_off(D0, 3, 1)>(vb);
    asm volatile("s_waitcnt lgkmcnt(0)" ::: "memory"); SBAR();
#define PK(L, H) (bf16x8){L[0], L[1], L[2], L[3], H[0], H[1], H[2], H[3]}
    if constexpr (FIRST) od = __builtin_amdgcn_mfma_f32_32x32x16_bf16(PK(l0, h0), pa0, f32x16{}, 0, 0, 0);
    else od = __builtin_amdgcn_mfma_f32_32x32x16_bf16(PK(l0, h0), pa0, od, 0, 0, 0);
    od = __builtin_amdgcn_mfma_f32_32x32x16_bf16(PK(l1, h1), pa1, od, 0, 0, 0);
    od = __builtin_amdgcn_mfma_f32_32x32x16_bf16(PK(l2, h2), pa2, od, 0, 0, 0);
    od = __builtin_amdgcn_mfma_f32_32x32x16_bf16(PK(l3, h3), pa3, od, 0, 0, 0);
#undef PK
}
template <bool FIRST = false> __device__ __forceinline__ void pv_d0(f32x16* o, int vb, bf16x8 pa0, bf16x8 pa1, bf16x8 pa2, bf16x8 pa3) {
    pv_one<0, FIRST>(o[0], vb, pa0, pa1, pa2, pa3); pv_one<1, FIRST>(o[1], vb, pa0, pa1, pa2, pa3); pv_one<2, FIRST>(o[2], vb, pa0, pa1, pa2, pa3); pv_one<3, FIRST>(o[3], vb, pa0, pa1, pa2, pa3);
}
constexpr int PROWS = 10752;
__device__ __forceinline__ int nsl_of(int i) { return i < 3 ? i : 3; }
__device__ __forceinline__ int rowoff_of(int i) { return 256 * (i <= 1 ? 0 : (i == 2 ? 1 : 3 * i - 6)); }

__device__ __forceinline__ void sel_load(const bf16* Qb, bf16x8 (&qr)[8]) {
    const int tid = threadIdx.x, wid = __builtin_amdgcn_readfirstlane(tid >> 6), lane = tid & 63, r32 = lane & 31, hi = lane >> 5;
    const char* Qc = (const char*)Qb; const unsigned qoff = (unsigned)((wid * 32 + r32) * LDX + hi * 8) * 2u;
#pragma unroll
    for (int d0 = 0; d0 < 8; ++d0) qr[d0] = *reinterpret_cast<const bf16x8*>(Qc + qoff + d0 * 32);
}
__device__ __forceinline__ void sel_unit(const bf16x8 (&qr)[8], const float* kmL  , unsigned short* selo  , int iblk) {
    const int tid = threadIdx.x, wid = __builtin_amdgcn_readfirstlane(tid >> 6), lane = tid & 63, r32 = lane & 31, hi = lane >> 5;
    unsigned sel = 0;
    float v1 = -__builtin_inff(), v2 = v1, v3 = v1; int i1 = -1, i2 = -1, i3 = -1;
#pragma unroll 1
    for (int n = 0; n < iblk; ++n) {
        float s = 0.f; const float* kp = kmL + n * 128 + hi * 8;
#pragma unroll
        for (int d0 = 0; d0 < 8; ++d0) { const f32x4 k0 = *(const f32x4*)(kp + d0 * 16), k1 = *(const f32x4*)(kp + d0 * 16 + 4); const bf16x8 q = qr[d0];
#pragma unroll
            for (int e = 0; e < 4; ++e) { s += __builtin_bit_cast(float, ((unsigned)(unsigned short)q[e]) << 16) * k0[e]; s += __builtin_bit_cast(float, ((unsigned)(unsigned short)q[4 + e]) << 16) * k1[e]; } }
        s += __shfl_xor(s, 32);
        if (s > v1) { v3 = v2; i3 = i2; v2 = v1; i2 = i1; v1 = s; i1 = n; }
        else if (s > v2) { v3 = v2; i3 = i2; v2 = s; i2 = n; }
        else if (s > v3) { v3 = s; i3 = n; }
    }
    if (i1 >= 0) sel |= 1u << i1; if (i2 >= 0) sel |= 1u << i2; if (i3 >= 0) sel |= 1u << i3;
    if (hi == 0) selo[wid * 32 + r32] = (unsigned short)sel;
}

__device__ __forceinline__ void tile_step(f32x16 (&o)[4], float& m_reg, float& l_reg, const char* Kt, int vb, bf16x8 (&qr)[8], int r32, int hi, float* al_l, bool do_mask, int thr, bool hasn, const char* Qbase, unsigned enext) {
    f32x16 p0, p1; qkt(p0, p1, Kt, qr, r32, hi); SBAR();
    if (do_mask && hasn) { const char* qnext = Qbase + (unsigned)((int)(enext & 4095u) * LDX + hi * 8) * 2u;
#pragma unroll
        for (int d0 = 0; d0 < 8; ++d0) qr[d0] = *reinterpret_cast<const bf16x8*>(qnext + d0 * 32); }
    if (do_mask) { const float ninf = -__builtin_inff(); asm volatile("" : "+v"(thr));
#pragma unroll
        for (int r = 0; r < 16; ++r) { const int c = (r & 3) + 8 * (r >> 2); p0[r] = (c <= thr) ? p0[r] : ninf; p1[r] = (c + 32 <= thr) ? p1[r] : ninf; } }
    float mn, alpha; partialSM(p0, p1, m_reg, mn, alpha);
    if (__any(alpha < 1.f)) {
#pragma unroll
        for (int d = 0; d < 4; ++d)
#pragma unroll
            for (int r = 0; r < 16; ++r) o[d][r] *= alpha; }
    bf16x8 pa0, pa1, pa2, pa3; finishSM(p0, p1, alpha, l_reg, pa0, pa1, pa2, pa3); SBAR();
    pv_d0(o, vb, pa0, pa1, pa2, pa3);
}

__device__ __forceinline__ void flash4(f32x16 (&o)[4], float& m_reg, float& l_reg, const char* K_lds, int vbase, bf16x8 (&qr)[8], int r32, int hi, bool hasn, const char* Qbase, unsigned enext) {
    f32x16 pA0, pA1, pB0, pB1; float mnA, mnB, alA, alB; bf16x8 pa0, pa1, pa2, pa3;
#define RESC1(a) do { if (__any((a) < 1.f)) { _Pragma("unroll") for (int d = 0; d < 4; ++d) _Pragma("unroll") for (int r = 0; r < 16; ++r) o[d][r] *= (a); } } while (0)
    qkt(pA0, pA1, K_lds, qr, r32, hi); partialSM(pA0, pA1, m_reg, mnA, alA);
    SBAR(); qkt(pB0, pB1, K_lds + 16384, qr, r32, hi); finishSM(pA0, pA1, alA, l_reg, pa0, pa1, pa2, pa3); SBAR();
    pv_d0<true>(o, vbase, pa0, pa1, pa2, pa3); partialSM(pB0, pB1, m_reg, mnB, alB); RESC1(alB);
    SBAR(); qkt(pA0, pA1, K_lds + 2 * 16384, qr, r32, hi); finishSM(pB0, pB1, alB, l_reg, pa0, pa1, pa2, pa3); SBAR();
    pv_d0(o, vbase + 16384, pa0, pa1, pa2, pa3); partialSM(pA0, pA1, m_reg, mnA, alA); RESC1(alA);
    SBAR(); qkt(pB0, pB1, K_lds + 3 * 16384, qr, r32, hi); SBAR();
    if (hasn) { const char* qnext = Qbase + (unsigned)((int)(enext & 4095u) * LDX + hi * 8) * 2u;
#pragma unroll
        for (int d0 = 0; d0 < 8; ++d0) qr[d0] = *reinterpret_cast<const bf16x8*>(qnext + d0 * 32); }
    finishSM(pA0, pA1, alA, l_reg, pa0, pa1, pa2, pa3); SBAR();
    pv_d0(o, vbase + 2 * 16384, pa0, pa1, pa2, pa3); partialSM(pB0, pB1, m_reg, mnB, alB); RESC1(alB);
    finishSM(pB0, pB1, alB, l_reg, pa0, pa1, pa2, pa3); SBAR();
    pv_d0(o, vbase + 3 * 16384, pa0, pa1, pa2, pa3);
#undef RESC1
}

__device__ __forceinline__ void kv_unit(const bf16* Qh, const bf16* Kh, const bf16* Vh, const unsigned short* selb, unsigned char* Oown, float* mlown, unsigned char* P, float* mlp, int j, char* lds, LAS unsigned char* ldsq) {
    const int tid = threadIdx.x, wid = __builtin_amdgcn_readfirstlane(tid >> 6), lane = tid & 63, r32 = lane & 31, hi = lane >> 5;
    char* K_lds = lds; char* V_lds = lds + 65536; char* xt = lds + XTRA_OFF;
    float* wsf = (float*)xt + wid * 64; float* li_l = wsf; float* al_l = wsf + 32;
    int* drow = (int*)(xt + 2048) + wid * 32;
    LAS int* cnt = (LAS int*)(ldsq + XTRA_OFF + 3072);
    LAS unsigned short* list = (LAS unsigned short*)(ldsq + XTRA_OFF + 3200);
    if (tid == 0) { int z_ = 0; asm volatile("" : "+v"(z_)); cnt[0] = z_; cnt[1] = z_; }
    int tid_s = threadIdx.x; asm volatile("" : "+v"(tid_s));
    const int sr = tid_s >> 4, sc = (tid_s & 15) * 8, vst0 = v_st(sr, sc), vst1 = v_st(32 + sr, sc);
    const unsigned ldoff0 = (unsigned)(sr * LDX + sc) * 2u, ldoff1 = ldoff0 + 32u * LDX * 2u;
    const char* kb = (const char*)Kh + (size_t)(j * 256) * (LDX * 2); const char* vbp = (const char*)Vh + (size_t)(j * 256) * (LDX * 2);
    bf16x8 kk[4][2], vv[4][2];
#pragma unroll
    for (int t = 0; t < 4; ++t) { const size_t to = (size_t)(t * 64) * (LDX * 2);
        kk[t][0] = *reinterpret_cast<const bf16x8*>(kb + to + ldoff0); kk[t][1] = *reinterpret_cast<const bf16x8*>(kb + to + ldoff1);
        vv[t][0] = *reinterpret_cast<const bf16x8*>(vbp + to + ldoff0); vv[t][1] = *reinterpret_cast<const bf16x8*>(vbp + to + ldoff1); }
    __syncthreads();
    {   unsigned sv[8];
#pragma unroll
        for (int k = 0; k < 8; ++k) { const int s = 256 * (j + 1) + k * 512 + tid_s; sv[k] = (s < SEQ) ? (unsigned)selb[s] : 0u; }
#pragma unroll
        for (int k = 0; k < 8; ++k) { const int s0 = 256 * (j + 1) + wid * 64 + k * 512;
            if (s0 < SEQ) { const int s = 256 * (j + 1) + k * 512 + tid_s; const unsigned v = sv[k];
                const bool hit = (v >> j) & 1u; const unsigned long long mk = __ballot(hit); const int nw = __builtin_popcountll(mk);
                int base = 0; if (lane == 0 && nw) base = __hip_atomic_fetch_add(&cnt[0], nw, __ATOMIC_RELAXED, __HIP_MEMORY_SCOPE_WORKGROUP);
                base = __builtin_amdgcn_readfirstlane(base);
                if (hit) list[base + __builtin_popcountll(mk & ((1ull << lane) - 1ull))] = (unsigned short)(s | (__builtin_popcount(v & ((1u << j) - 1u)) << 12)); } } }
#pragma unroll
    for (int t = 0; t < 4; ++t) { const int kc = sc * 2;
        *(bf16x8*)(K_lds + t * 16384 + KSWZ(sr, kc)) = kk[t][0]; *(bf16x8*)(K_lds + t * 16384 + KSWZ(32 + sr, kc)) = kk[t][1];
        *(bf16x8*)(V_lds + t * 16384 + vst0) = vv[t][0]; *(bf16x8*)(V_lds + t * 16384 + vst1) = vv[t][1]; }
    __syncthreads();
    const int n = cnt[0]; const int ngath = (n + 31) >> 5; const int ng = ngath + 8;
    const int vbase = (int)(uintptr_t)V_lds + v_rd_base(lane);
#define KV_TICKET(gv) do { int t_ = 0; if (lane == 0) t_ = __hip_atomic_fetch_add(&cnt[1], 1, __ATOMIC_RELAXED, __HIP_MEMORY_SCOPE_WORKGROUP); gv = __builtin_amdgcn_readfirstlane(t_); } while (0)
#define KV_META(gv, own_, wq_, e_, ntl_) do { own_ = (gv) >= ngath; wq_ = 7 - ((gv) - ngath);     \
        if (own_) { e_ = (unsigned)(256 * j + 32 * wq_ + r32) | 0x8000u; ntl_ = (wq_ >> 1) + 1; }          \
        else { const int idx_ = (gv) * 32 + r32; const bool v_ = idx_ < n; e_ = (unsigned)list[v_ ? idx_ : n - 1] | (v_ ? 0x8000u : 0u); ntl_ = 4; } } while (0)
#define KV_QOFF(e_) ((unsigned)((int)((e_) & 4095u) * LDX + hi * 8) * 2u)
#define KV_LOADQ(e_, q_) do { const char* Qc_ = (const char*)Qh; const unsigned qoff_ = KV_QOFF(e_); \
        _Pragma("unroll") for (int d0 = 0; d0 < 8; ++d0) q_[d0] = *reinterpret_cast<const bf16x8*>(Qc_ + qoff_ + d0 * 32); } while (0)
    int g; KV_TICKET(g);
    bool own = false; int wq = 0, ntl = 0; unsigned ecur = 0; bf16x8 qr[8];
    if (g < ng) { KV_META(g, own, wq, ecur, ntl); KV_LOADQ(ecur, qr); }
    while (g < ng) {
        int gn; KV_TICKET(gn);
        bool ownn = false; int wqn = 0, ntln = 0; unsigned enext = 0;
        const bool hasn = gn < ng;
        if (hasn) { KV_META(gn, ownn, wqn, enext, ntln); }
        float m_reg = -1e30f, l_reg = 0; f32x16 o[4];
        if (!own) flash4(o, m_reg, l_reg, K_lds, vbase, qr, r32, hi, hasn, (const char*)Qh, enext);
        else {
#pragma unroll
            for (int d = 0; d < 4; ++d) o[d] = f32x16{};
#pragma unroll 1
            for (int t = 0; t < ntl - 1; ++t)
                tile_step(o, m_reg, l_reg, K_lds + t * 16384, vbase + t * 16384, qr, r32, hi, al_l, false, 0, false, nullptr, 0u);
            { const int t = ntl - 1;
              tile_step(o, m_reg, l_reg, K_lds + t * 16384, vbase + t * 16384, qr, r32, hi, al_l, true, 32 * wq + r32 - 64 * t - 4 * hi, hasn, (const char*)Qh, enext); }
        }
        const float rl = __builtin_amdgcn_rcpf(l_reg);
        const int qs = (int)(ecur & 4095u), slot = (int)((ecur >> 12) & 3u); const bool valid = (ecur & 0x8000u) != 0u;
        char* rowp;
        if (own) { rowp = (char*)Oown + (size_t)qs * LDX; if (hi == 0) { float* mp = mlown + (size_t)qs * 2; mp[0] = m_reg; mp[1] = l_reg; } }
        else { const int i = qs >> 8; const int ns = nsl_of(i); const int prow = rowoff_of(i) + (qs & 255) * ns + slot; rowp = (char*)P + (size_t)prow * HD;
               if (hi == 0 && valid) { float* mp = mlp + (size_t)prow * 2; mp[0] = m_reg; mp[1] = l_reg; } }
        if (valid) { const float rs = rl * P8S;
#pragma unroll
            for (int d0 = 0; d0 < 4; ++d0)
#pragma unroll
                for (int kp = 0; kp < 2; ++kp) {
                    const unsigned a = pk4_fp8(o[d0][8 * kp + 0] * rs, o[d0][8 * kp + 1] * rs, o[d0][8 * kp + 2] * rs, o[d0][8 * kp + 3] * rs);
                    const unsigned b = pk4_fp8(o[d0][8 * kp + 4] * rs, o[d0][8 * kp + 5] * rs, o[d0][8 * kp + 6] * rs, o[d0][8 * kp + 7] * rs);
                    auto r = __builtin_amdgcn_permlane32_swap(a, b, false, false);
                    const u32x2 w = {r[0], r[1]};
                    *(u32x2*)(rowp + d0 * 32 + kp * 16 + hi * 8) = w; }
        }
        g = gn; own = ownn; wq = wqn; ecur = enext; ntl = ntln;
    }
#undef KV_TICKET
#undef KV_META
#undef KV_QOFF
#undef KV_LOADQ
    __syncthreads();
}
}

#define XB_TMO      128
#define XB_XCNT(j)  (256  + 64 * (j))
#define XB_XSUB(j)  (1280 + 64 * (j))
#define XB_XGEN(j)  (2304 + 64 * (j))
#define XB_TOP      3328
#define XB_TOPGEN   3392
#define XCD_BAR_WORDS 3456
#define XB_SPIN_CAP (1u << 18)
__device__ __forceinline__ unsigned xb_ld(unsigned* p)              { return __hip_atomic_load(p, __ATOMIC_RELAXED, __HIP_MEMORY_SCOPE_AGENT); }
__device__ __forceinline__ unsigned xb_add(unsigned* p, unsigned v) { return __hip_atomic_fetch_add(p, v, __ATOMIC_RELAXED, __HIP_MEMORY_SCOPE_AGENT); }
__device__ __forceinline__ unsigned xb_xcc_id() { return (unsigned)__builtin_amdgcn_s_getreg((3 << 11) | 20) & 0xFu; }
#define XB_SPIN(cond, bar) do { unsigned _sp = 0; while (cond) { __builtin_amdgcn_s_sleep(1); \
    if ((++_sp & 255u) == 0u) { if (xb_ld(&(bar)[XB_TMO])) break; if (_sp > XB_SPIN_CAP) { atomicAdd(&(bar)[XB_TMO], 1u); break; } } } } while (0)
struct XcdBarrier { unsigned* bar; unsigned x; volatile LAS unsigned* st; };
__device__ __forceinline__ XcdBarrier xcd_barrier_post(unsigned* bar, volatile LAS unsigned* st) {
    XcdBarrier b; b.bar = bar; b.x = xb_xcc_id(); b.st = st;
    if (threadIdx.x == 0) (void)xb_add(&bar[XB_XCNT(b.x)], 1u);
    return b;
}
__device__ __forceinline__ void xcd_barrier_complete(unsigned* bar, unsigned x, unsigned& nloc, unsigned& nx) {
    const unsigned G = gridDim.x * gridDim.y * gridDim.z;
    unsigned sum, cnt, mine, sp = 0u;
    for (;;) {
        sum = 0u; cnt = 0u; mine = 0u;
#pragma unroll
        for (unsigned j = 0; j < 16; ++j) { const unsigned c = xb_ld(&bar[XB_XCNT(j)]); sum += c; cnt += (c > 0u) ? 1u : 0u; mine = (j == x) ? c : mine; }
        if (sum == G) break;
        __builtin_amdgcn_s_sleep(1);
        if ((++sp & 255u) == 0u) { if (xb_ld(&bar[XB_TMO])) break; if (sp > XB_SPIN_CAP) { atomicAdd(&bar[XB_TMO], 1u); break; } }
    }
    nloc = mine > 0u ? mine : 1u; nx = cnt > 0u ? cnt : 1u;
}
__device__ __forceinline__ void xcd_barrier(const XcdBarrier& b) {
    asm volatile("s_waitcnt vmcnt(0)" ::: "memory");
    __syncthreads();
    if (threadIdx.x == 0) {
        unsigned* bar = b.bar;
        __builtin_amdgcn_s_waitcnt(0);
        unsigned nloc = b.st[0], nx = b.st[1];
        if (nloc == 0u) { xcd_barrier_complete(bar, b.x, nloc, nx); b.st[0] = nloc; b.st[1] = nx; }
        const unsigned old = xb_add(&bar[XB_XSUB(b.x)], 1u);
        const unsigned gen = old / nloc;
        if (old + 1u == (gen + 1u) * nloc) {
            __builtin_amdgcn_fence(__ATOMIC_RELEASE, "agent");
            asm volatile("s_waitcnt vmcnt(0)" ::: "memory");
            const unsigned og = xb_add(&bar[XB_TOP], 1u);
            const unsigned tg = og / nx;
            if (og + 1u == (tg + 1u) * nx) xb_add(&bar[XB_TOPGEN], 1u);
            else XB_SPIN(xb_ld(&bar[XB_TOPGEN]) == tg, bar);
            __builtin_amdgcn_fence(__ATOMIC_ACQUIRE, "agent");
            xb_add(&bar[XB_XGEN(b.x)], 1u);
            asm volatile("s_waitcnt vmcnt(0)" ::: "memory");
        } else {
            XB_SPIN(xb_ld(&bar[XB_XGEN(b.x)]) == gen, bar);
            __builtin_amdgcn_fence(__ATOMIC_ACQUIRE, "agent");
            asm volatile("s_waitcnt vmcnt(0)" ::: "memory");
        }
    }
    __syncthreads();
}

__constant__ double ROPE_C1[16] = {
    0.5403023058681398, 0.9045954518793624, 0.9812558362840286, 0.996355883049411, 0.9992929765482185, 0.9998628790459692, 0.9999734086383661, 0.9999948433117433,
    0.9999990000001666, 0.9999998060772615, 0.9999999623939693, 0.9999999927073353, 0.9999999985857865, 0.9999999997257518, 0.999999999946817, 0.9999999999896866};
__constant__ double ROPE_S1[16] = {
    0.8414709848078965, 0.4262711208130009, 0.19270958398204202, 0.08529334272279625, 0.0375971677311151, 0.01655968314629382, 0.007292600096474083, 0.0032114404746087437,
    0.0014142130909686214, 0.0006227723816580176, 0.00027424817223841217, 0.00012076973711788731, 5.31829589443792e-05, 2.3419998959268378e-05, 1.0313385377029628e-05, 4.541670480592256e-06};

__device__ __forceinline__ int sig32(int p) { return (p & 4) ? 16 + 4 * (p >> 3) + (p & 3) : 4 * (p >> 3) + (p & 3); }
__device__ __forceinline__ void tr_item(const float* src, int ldw, int k0, bf16* out, int K, const float* gk, const float* gn, bool sigma, LAS float* scr, int lane) {
    const int lr = lane >> 3, lc = (lane & 7) * 4;
#pragma unroll
    for (int i = 0; i < 8; ++i) { const int kk = 8 * i + lr; f32x4 v = *(const f32x4*)(src + (size_t)(k0 + kk) * ldw + lc); if (gk) v *= gk[k0 + kk];
        LAS float* d = scr + kk * 33 + lc; d[0] = v[0]; d[1] = v[1]; d[2] = v[2]; d[3] = v[3]; }
    LDS_WAIT(); asm volatile("" ::: "memory");
    const int c = lane & 7;
#pragma unroll
    for (int j = 0; j < 4; ++j) { const int n = (lane >> 3) + 8 * j; const int ns = sigma ? sig32(n) : n; const LAS float* s = scr + (8 * c) * 33 + ns; const float sc = gn ? gn[n] : 1.0f;
        u32x4 o; o.x = pk2(s[0 * 33] * sc, s[1 * 33] * sc); o.y = pk2(s[2 * 33] * sc, s[3 * 33] * sc); o.z = pk2(s[4 * 33] * sc, s[5 * 33] * sc); o.w = pk2(s[6 * 33] * sc, s[7 * 33] * sc);
        *(GAS u32x4*)(out + (size_t)n * K + k0 + 8 * c) = o; }
    LDS_WAIT(); asm volatile("" ::: "memory");
}

__device__ __forceinline__ void tr_load(const float* src, int ldw, int k0, int lane, f32x4 (&v)[8]) {
    const int lr = lane >> 3, lc = (lane & 7) * 4;
#pragma unroll
    for (int i = 0; i < 8; ++i) v[i] = __builtin_nontemporal_load((const GAS f32x4*)(src + (size_t)(k0 + 8 * i + lr) * ldw + lc));
}
__device__ __forceinline__ void tr_finish(const f32x4 (&v)[8], int k0, bf16* out, int K, const LAS float* gk, LAS float* scr, int lane) {
    const int lr = lane >> 3, lc = (lane & 7) * 4;
#pragma unroll
    for (int i = 0; i < 8; ++i) { LAS float* d = scr + (8 * i + lr) * 33 + lc; d[0] = v[i][0]; d[1] = v[i][1]; d[2] = v[i][2]; d[3] = v[i][3]; }
    LDS_WAIT(); asm volatile("" ::: "memory");
    const int c = lane & 7;
    f32x4 g0 = (f32x4){1.f, 1.f, 1.f, 1.f}, g1 = g0;
    if (gk) { g0 = *(const LAS f32x4*)(gk + k0 + 8 * c); g1 = *(const LAS f32x4*)(gk + k0 + 8 * c + 4); }
    float tv[4][8];
#pragma unroll
    for (int j = 0; j < 4; ++j) { const LAS float* s = scr + (8 * c) * 33 + (lane >> 3) + 8 * j;
#pragma unroll
        for (int e = 0; e < 8; ++e) tv[j][e] = s[e * 33]; }
    LDS_WAIT(); asm volatile("" ::: "memory");
#pragma unroll
    for (int j = 0; j < 4; ++j) { const int n = (lane >> 3) + 8 * j;
        u32x4 o; o.x = cvt_pk_bf16(tv[j][0] * g0[0], tv[j][1] * g0[1]); o.y = cvt_pk_bf16(tv[j][2] * g0[2], tv[j][3] * g0[3]); o.z = cvt_pk_bf16(tv[j][4] * g1[0], tv[j][5] * g1[1]); o.w = cvt_pk_bf16(tv[j][6] * g1[2], tv[j][7] * g1[3]);
        *(GAS u32x4*)(out + (size_t)n * K + k0 + 8 * c) = o; }
}

__device__ __forceinline__ void tr_finish8(const f32x4 (&v)[8], int k0, unsigned char* out, int Kb, const LAS float* gk, float sc, LAS float* scr, int lane, bool sigma = false) {
    const int lr = lane >> 3, lc = (lane & 7) * 4;
#pragma unroll
    for (int i = 0; i < 8; ++i) { LAS float* d = scr + (8 * i + lr) * 33 + lc; d[0] = v[i][0]; d[1] = v[i][1]; d[2] = v[i][2]; d[3] = v[i][3]; }
    LDS_WAIT(); asm volatile("" ::: "memory");
    const int c = lane & 7;
    f32x4 g0 = (f32x4){1.f, 1.f, 1.f, 1.f}, g1 = g0;
    if (gk) { g0 = *(const LAS f32x4*)(gk + k0 + 8 * c); g1 = *(const LAS f32x4*)(gk + k0 + 8 * c + 4); }
    g0 *= sc; g1 *= sc;
    float tv[4][8];
#pragma unroll
    for (int j = 0; j < 4; ++j) { const int n_ = (lane >> 3) + 8 * j; const LAS float* s = scr + (8 * c) * 33 + (sigma ? sig32(n_) : n_);
#pragma unroll
        for (int e = 0; e < 8; ++e) tv[j][e] = s[e * 33]; }
    LDS_WAIT(); asm volatile("" ::: "memory");
#pragma unroll
    for (int j = 0; j < 4; ++j) { const int n = (lane >> 3) + 8 * j;
        u32x2 o; o.x = pk4_fp8(tv[j][0] * g0[0], tv[j][1] * g0[1], tv[j][2] * g0[2], tv[j][3] * g0[3]); o.y = pk4_fp8(tv[j][4] * g1[0], tv[j][5] * g1[1], tv[j][6] * g1[2], tv[j][7] * g1[3]);
        *(GAS u32x2*)(out + (size_t)n * Kb + k0 + 8 * c) = o; }
}

#define rope_c ((float*)(unsigned char*)(wsp + WS_ROPE_C))
#define rope_s ((float*)(unsigned char*)(wsp + WS_ROPE_S))
#define kmean ((float*)(unsigned char*)(wsp + WS_KMEAN))
#define ss1 ((float*)(unsigned char*)(wsp + WS_SS1))
#define ss2 ((float*)(unsigned char*)(wsp + WS_SS2))
#define ss3 ((float*)(unsigned char*)(wsp + WS_SS3))
#define rstd3 ((float*)(unsigned char*)(wsp + WS_RSTD3))
#define gatew ((float*)(unsigned char*)(wsp + WS_GATEW))
#define ent ((unsigned*)(unsigned char*)(wsp + WS_ENT))
#define bcnt ((int*)(unsigned char*)(wsp + WS_BCNT))
#define soff ((unsigned*)(unsigned char*)(wsp + WS_SOFF))
#define srstd ((float*)(unsigned char*)(wsp + WS_SRSTD))
#define sdst ((int*)(unsigned char*)(wsp + WS_SDST))
#define sgw ((float*)(unsigned char*)(wsp + WS_SGW))
#define texp ((int*)(unsigned char*)(wsp + WS_TEXP))
#define w_pool ((bf16*)(unsigned char*)(wsp + WS_W_POOL))
#define w_qkv ((bf16*)(unsigned char*)(wsp + WS_W_QKV))
#define w_wo ((bf16*)(unsigned char*)(wsp + WS_W_WO))
#define w_fgu ((bf16*)(unsigned char*)(wsp + WS_W_FGU))
#define w_fd ((bf16*)(unsigned char*)(wsp + WS_W_FD))
#define w_mgu ((bf16*)(unsigned char*)(wsp + WS_W_MGU))
#define w_md ((bf16*)(unsigned char*)(wsp + WS_W_MD))
#define w_mgu8 ((unsigned char*)(wsp + WS_W_MGU))
#define w_md8 ((unsigned char*)(wsp + WS_W_MD))
#define h8buf ((unsigned char*)(wsp + WS_H8))
#define o8buf ((unsigned char*)(wsp + WS_Q))
#define h8abuf ((unsigned char*)(wsp + WS_PART))
#define hbuf ((bf16*)(unsigned char*)(wsp + WS_H))
#define pooled ((bf16*)(unsigned char*)(wsp + WS_POOLED))
#define fact ((bf16*)(unsigned char*)(wsp + WS_FACT))
#define qbuf ((bf16*)(unsigned char*)(wsp + WS_Q))
#define kbuf ((bf16*)(unsigned char*)(wsp + WS_K))
#define vbuf ((bf16*)(unsigned char*)(wsp + WS_V))
struct Args { const float* in[18]; float* out; unsigned char* ws; int ph_lo, ph_hi; };
constexpr int PH_P0 = 0, PH_POOL = 1, PH_FFN1 = 2, PH_FFN2 = 3, PH_QKV = 4, PH_SEL = 5, PH_KV = 6, PH_COMB = 7, PH_WO = 8, PH_ROUTE = 9, PH_LIST = 10, PH_MOE0 = 11, PH_FINAL = PH_MOE0 + MOE_STEPS, PH_COUNT = PH_FINAL + 1;

__global__ void __launch_bounds__(NWAVES * 64, 2) yoco_fwd(Args args) {
    extern __shared__ __attribute__((aligned(16))) unsigned char lds_raw[];
    LAS unsigned char* lds = (LAS unsigned char*)lds_raw;
    volatile LAS unsigned* MISC = (volatile LAS unsigned*)(lds + MISC_OFF);
    const int tid = threadIdx.x, lane = tid & 63, wave = __builtin_amdgcn_readfirstlane(tid >> 6);
    const int G = gridDim.x; const int bx = blockIdx.x; const int vcu = (G % 8 == 0) ? (bx % 8) * (G / 8) + bx / 8 : bx;
    unsigned char* ws = args.ws;
    unsigned* ctl = (unsigned*)(ws + WS_CTL);
    typedef const __attribute__((address_space(4))) Args* KArgs;
    KArgs kap = (KArgs)__builtin_amdgcn_kernarg_segment_ptr();
#define PIN_ARGS() asm volatile("" : "+s"(kap))
    GAS unsigned char* wsp = (GAS unsigned char*)ws;
#define obuf ((unsigned char*)kap->out)
#define y8buf ((unsigned char*)(wsp + WS_Y8))
    for (int u = tid; u < (LDS_BYTES - LDSCTL_OFF) / 4; u += NWAVES * 64) ((LAS unsigned*)(lds + LDSCTL_OFF))[u] = 0u;
    __syncthreads();
    const bool one_launch = (args.ph_hi - args.ph_lo) > 1;
    XcdBarrier bar; bar.bar = ctl + CW_BAR; bar.x = 0; bar.st = nullptr;
    if (one_launch) bar = xcd_barrier_post(ctl + CW_BAR, MISC + 8);
    const int lo = args.ph_lo, hi = args.ph_hi;
#ifndef PHMASK
#define PHMASK 0xffffffffu
#endif
#define IN(k) (((PHMASK >> ((k) < 31 ? (k) : 31)) & 1u) && lo <= (k) && (k) < hi)
#define SEAM(k) do { if (IN(k) && IN((k) + 1)) xcd_barrier(bar); } while (0)
    const int gw = vcu * NWAVES + wave, NGW = G * NWAVES;

#ifndef REP_P0
#define REP_P0 1
#endif
    for (int rep = 0; rep < REP_P0; ++rep) { if (rep) xcd_barrier(bar);
    if (IN(PH_P0)) {
        wsp = (GAS unsigned char*)ws; asm volatile("" : "+s"(wsp)); PIN_ARGS(); const float* x = kap->in[0]; const float* attn_norm = kap->in[1]; const float* ffn_norm = kap->in[2]; const float* pool_w = kap->in[3]; const float* pool_scale = kap->in[4]; const float* wq = kap->in[5]; const float* wo = kap->in[6]; const float* kv_norm = kap->in[7]; const float* wk = kap->in[8]; const float* wv = kap->in[9]; const float* fwg = kap->in[10]; const float* fwu = kap->in[11]; const float* fwd = kap->in[12];
        for (int i = bx * 512 + tid; i < SEQ * 16; i += G * 512) { const int s = i >> 4, d = i & 15; double c = 1.0, sn = 0.0, bc = ROPE_C1[d], bs = ROPE_S1[d];
            for (int b = 0; b < 12; ++b) { if ((s >> b) & 1) { const double nc = c * bc - sn * bs, ns = sn * bc + c * bs; c = nc; sn = ns; } const double nbc = bc * bc - bs * bs, nbs = 2.0 * bc * bs; bc = nbc; bs = nbs; }
            rope_c[i] = (float)c; rope_s[i] = (float)sn; }
        for (int i = bx * 512 + tid; i < NBATCH * NH * NBLK * HD; i += G * 512) kmean[i] = 0.f;
        {
            LAS float* rsl = (LAS float*)(lds + XTRA_OFF);
            for (int chunk = vcu; chunk < T / 128; chunk += G) {
                const int t0 = chunk * 128, p0 = t0 & (SEQ - 1);
                for (int r0 = wave; r0 < 143; r0 += 6 * NWAVES) {
                    float s6[6];
#pragma unroll
                    for (int q = 0; q < 6; ++q) { const int rr = r0 + q * NWAVES; const int t = t0 - 15 + rr; float s = 0.f;
                        if (rr < 143 && p0 + rr - 15 >= 0) { const GAS f32x4* xr = (const GAS f32x4*)(x + (size_t)t * D) + lane;
#pragma unroll
                            for (int j = 0; j < 4; ++j) { const f32x4 v = xr[64 * j]; s += (v[0] * v[0] + v[1] * v[1]) + (v[2] * v[2] + v[3] * v[3]); } }
                        s6[q] = s; }
#pragma unroll
                    for (int q = 0; q < 6; ++q) { const int rr = r0 + q * NWAVES; const float s = wave_sum(s6[q]); if (lane == 0 && rr < 143) rsl[rr] = 1.0f / sqrtf(s * (1.0f / D) + EPS); }
                }
                __syncthreads();
                const int tb = t0 + wave * 16;
                const int pb = tb & (SEQ - 1);
#pragma unroll
                for (int jh = 0; jh < 8; ++jh) {
                    const int j = jh >> 1, hh = jh & 1; const int w = 2 << j; const int tq = tb + 8 * hh, pq = pb + 8 * hh;
                    const f32x4 g = *(const f32x4*)(attn_norm + 256 * j + 4 * lane);
                    f32x4 v[23];
                    const char* xb = (const char*)x + ((size_t)(tq - 15) * D + 256 * j) * 4; const unsigned lo = (unsigned)lane * 16u;
#pragma unroll
                    for (int r = 0; r < 23; ++r) { const bool need = (r >= 16 - w) && (pq - 15 + r >= 0);
                        if (need) { const float rs = __builtin_bit_cast(float, __builtin_amdgcn_readfirstlane(__builtin_bit_cast(int, rsl[wave * 16 + 8 * hh + r]))); v[r] = *(const f32x4*)(xb + (size_t)r * (D * 4) + lo) * (rs * g); }
                        else v[r] = (f32x4){0.f, 0.f, 0.f, 0.f}; }
#pragma unroll
                    for (int i = 0; i < 8; ++i) { const int pos = pq + i; f32x4 S = v[15 + i];
#pragma unroll
                        for (int d = 1; d < w; ++d) S += v[15 + i - d];
                        const float inv = 1.0f / (float)(pos + 1 < w ? pos + 1 : w); const f32x4 o = S * inv - v[15 + i];
                        u32x2 pk; pk.x = pk2(o[0], o[1]); pk.y = pk2(o[2], o[3]); *(u32x2*)(pooled + (size_t)(tq + i) * D + 256 * j + 4 * lane) = pk; }
                    asm volatile("" ::: "memory");
                }
                __syncthreads();
            }
        }
        {
            LAS float* scr = (LAS float*)(lds + RING_OFF + wave * 16384);
            for (int it = gw; it < 128; it += NGW) { const int g = it >> 5, r = it & 31, kb = r >> 3, nb = r & 7;
                tr_item(pool_w + (size_t)g * 65536 + nb * 32, 256, kb * 64, w_pool + (size_t)(g * 256 + nb * 32) * 256, 256, nullptr, pool_scale + g * 256 + nb * 32, false, scr, lane); }
#if QKV_FP8
            LAS float* gq = (LAS float*)(lds + XTRA_OFF + 12288); LAS float* gkv = gq + D;
            for (int i = tid; i < D; i += NWAVES * 64) { gq[i] = attn_norm[D + i]; gkv[i] = kv_norm[i]; }
            __syncthreads();
#endif
            for (int it = gw; it < 1536; it += NGW) { const int which = it >> 9, r = it & 511, kb = r >> 5, nb = r & 31;
                const float* W = which == 0 ? wq : (which == 1 ? wk : wv);
#if QKV_FP8
                f32x4 b8[8]; tr_load(W + nb * 32, D, kb * 64, lane, b8); tr_finish8(b8, kb * 64, (unsigned char*)w_qkv + (size_t)(which * 1024 + nb * 32) * D, D, which == 0 ? gq : gkv, W8S_GU, scr, lane, which < 2 && (nb & 3) == 0); LDS_WAIT();
#else
                const float* gk = which == 0 ? attn_norm + D : kv_norm;
                tr_item(W + nb * 32, D, kb * 64, w_qkv + (size_t)(which * 1024 + nb * 32) * D, D, gk, nullptr, which < 2 && (nb & 3) == 0, scr, lane);
#endif
            }
            for (int it = gw; it < 512; it += NGW) { const int kb = it >> 5, nb = it & 31;
#if WO_FP8
                f32x4 b8[8]; tr_load(wo + nb * 32, D, kb * 64, lane, b8); tr_finish8(b8, kb * 64, (unsigned char*)w_wo + (size_t)(nb * 32) * D, D, nullptr, W8S_GU, scr, lane); LDS_WAIT();
#else
                tr_item(wo + nb * 32, D, kb * 64, w_wo + (size_t)(nb * 32) * D, D, nullptr, nullptr, false, scr, lane);
#endif
            }
#if FFN1_FP8
            LAS float* gk0 = (LAS float*)(lds + XTRA_OFF + 8192);
            for (int i = tid; i < D; i += NWAVES * 64) gk0[i] = ffn_norm[i];
            __syncthreads();
#endif
            for (int it = gw; it < 16 * 176; it += NGW) { const int kb = it / 176, nb = it % 176, n0 = nb * 32, pn = n0 >> 8, r = n0 & 255;
                const float* W = (r < 128 ? fwg : fwu) + pn * 128 + (r & 127);
#if FFN1_FP8
                f32x4 b8[8]; tr_load(W, FF, kb * 64, lane, b8); tr_finish8(b8, kb * 64, (unsigned char*)w_fgu + (size_t)n0 * D, D, gk0, W8S_GU, scr, lane); LDS_WAIT();
#else
                tr_item(W, FF, kb * 64, w_fgu + (size_t)n0 * D, D, ffn_norm, nullptr, false, scr, lane);
#endif
            }
            for (int it = gw; it < 44 * 32; it += NGW) { const int kb = it >> 5, nb = it & 31;
#if FFN2_FP8
                f32x4 b8[8]; tr_load(fwd + nb * 32, D, kb * 64, lane, b8); tr_finish8(b8, kb * 64, (unsigned char*)w_fd + (size_t)(nb * 32) * FF, FF, nullptr, W8S_DN, scr, lane); LDS_WAIT();
#else
                tr_item(fwd + nb * 32, D, kb * 64, w_fd + (size_t)(nb * 32) * FF, FF, nullptr, nullptr, false, scr, lane);
#endif
            }
        }
    }
    }
    SEAM(PH_P0);

    if (IN(PH_POOL)) {
        wsp = (GAS unsigned char*)ws; asm volatile("" : "+s"(wsp)); PIN_ARGS(); const float* x = kap->in[0];
        ProbDense pr{(const char*)pooled, (const char*)w_pool, 256, D, 512};
        pg8::StaticOrder S; S.init(T / 256, 4, G, bx);
        EpiRes<true> E{x, hbuf, ss1, FFN1_FP8 ? h8abuf : nullptr, 1.0f};
        pg8::gemm_phase(lds + RING_OFF, pr, S, E);
    }
    SEAM(PH_POOL);

#ifndef REP_FFN1
#define REP_FFN1 1
#endif
    for (int rep = 0; rep < REP_FFN1; ++rep) { if (rep) xcd_barrier(bar);
    if (IN(PH_FFN1)) {
        wsp = (GAS unsigned char*)ws; asm volatile("" : "+s"(wsp)); PIN_ARGS();
        ProbDenseT<FFN1_FP8 != 0> pr{FFN1_FP8 ? (const char*)h8abuf : (const char*)hbuf, (const char*)w_fgu, FFN1_FP8 ? D / 2 : D, FFN1_FP8 ? D / 2 : D, 0};
        pg8::StaticOrder S; S.init(T / 256, 2 * FF / 256, G, bx);
        EpiSwiGLU<false, FF, FFN2_FP8 != 0, FFN1_FP8 != 0> E{fact, RstdTable{ss1, -1, 0}, nullptr, 0, 1 << 30, nullptr};
        pg8::gemm_phase(lds + RING_OFF, pr, S, E);
    }
    }
    SEAM(PH_FFN1);

    if (IN(PH_FFN2)) {
        wsp = (GAS unsigned char*)ws; asm volatile("" : "+s"(wsp)); PIN_ARGS();
        ProbDenseT<FFN2_FP8 != 0> pr{(const char*)fact, (const char*)w_fd, FFN2_FP8 ? FF / 2 : FF, FFN2_FP8 ? FF / 2 : FF, 0};
        pg8::StaticOrder S; S.init(T / 256, 4, G, bx);
        EpiRes<false> E{nullptr, hbuf, ss2, QKV_FP8 ? h8abuf : nullptr, FFN2_FP8 ? 1.0f / (W8S_DN * ACT8S) : 1.0f};
        pg8::gemm_phase(lds + RING_OFF, pr, S, E);
    }
    SEAM(PH_FFN2);

    if (IN(PH_QKV)) {
        wsp = (GAS unsigned char*)ws; asm volatile("" : "+s"(wsp)); PIN_ARGS();
        ProbDenseT<QKV_FP8 != 0> pr{QKV_FP8 ? (const char*)h8abuf : (const char*)hbuf, (const char*)w_qkv, QKV_FP8 ? D / 2 : D, QKV_FP8 ? D / 2 : D, 0};
        pg8::StaticOrder S; S.init(T / 256, 12, G, bx);
        EpiQKV E{qbuf, RstdTable{ss2, -1, 0}, rope_c, rope_s, kmean};
        pg8::gemm_phase(lds + RING_OFF, pr, S, E);
    }
    SEAM(PH_QKV);

#ifndef REP_SEL
#define REP_SEL 1
#endif
    for (int rep = 0; rep < REP_SEL; ++rep) { if (rep) xcd_barrier(bar);
    if (IN(PH_SEL)) {
        wsp = (GAS unsigned char*)ws; asm volatile("" : "+s"(wsp)); PIN_ARGS();
        unsigned short* selbuf = (unsigned short*)((unsigned char*)(wsp + WS_SEL));
        float* kmL = (float*)((char*)lds_raw + XTRA_OFF + 4096);
        for (int v2 = vcu; v2 < 256; v2 += G) {
            const int bh = v2 >> 2, s4 = v2 & 3, b = bh >> 3, h = bh & 7;
            bf16x8 q4[4][8];
#pragma unroll
            for (int k = 0; k < 4; ++k) att::sel_load(qbuf + ((size_t)(b * SEQ + (4 * s4 + k) * 256)) * D + h * HD, q4[k]);
            *(f32x4*)(kmL + tid * 4) = *(const f32x4*)((const char*)(kmean + (size_t)bh * NBLK * HD) + (unsigned)tid * 16u);
            __syncthreads();
#pragma unroll
            for (int k = 0; k < 4; ++k) att::sel_unit(q4[k], kmL, selbuf + (size_t)bh * SEQ + (4 * s4 + k) * 256, 4 * s4 + k);
            __syncthreads();
        }
    }
    }
    SEAM(PH_SEL);

#ifndef REP_KV
#define REP_KV 1
#endif
    for (int rep = 0; rep < REP_KV; ++rep) { if (rep) xcd_barrier(bar);
    if (IN(PH_KV)) {
        wsp = (GAS unsigned char*)ws; asm volatile("" : "+s"(wsp)); PIN_ARGS();
        const bool convfirst = (G == 256) && bx >= G - CONV_WGS;
        auto conv_pass = [&]() {
            wsp = (GAS unsigned char*)ws; asm volatile("" : "+s"(wsp)); PIN_ARGS();
            int tid_c = threadIdx.x; asm volatile("" : "+v"(tid_c)); const int tid = tid_c;
            const float* ffn_norm = kap->in[2]; const float* mwg = kap->in[14]; const float* mwu = kap->in[15]; const float* mwd = kap->in[16];
            constexpr int N_GU = NE * 16 * 224, N_DN = NE * 56 * 32, TK_ITEMS = 64;
            LAS float* scr = (LAS float*)(lds + RING_OFF + wave * 16384); int lane_c = threadIdx.x; asm volatile("" : "+v"(lane_c)); lane_c &= 63;
            LAS float* gkL = (LAS float*)(lds + XTRA_OFF + 16384);
            LAS int* tkL = (LAS int*)(lds + XTRA_OFF + 20480);
            for (int i = tid; i < D; i += NWAVES * 64) gkL[i] = ffn_norm[D + i];
#define MOE_ITEM(it_, S_, L_, K0_, O_, KK_, G_) do { if ((it_) < N_GU) { const int e_ = (it_) / (16 * 224), r2_ = (it_) % (16 * 224), kb_ = r2_ / 224, nb_ = r2_ % 224, n0_ = nb_ * 32, pn_ = n0_ >> 8, r_ = n0_ & 255; \
        S_ = (r_ < 128 ? mwg : mwu) + (size_t)e_ * D * FE + pn_ * 128 + (r_ & 127); L_ = FE; K0_ = kb_ * 64; O_ = w_mgu8 + ((size_t)e_ * 2 * FE + n0_) * D; KK_ = D; G_ = gkL; } \
    else { const int i2_ = (it_) - N_GU; const int e_ = i2_ / (56 * 32), r2_ = i2_ % (56 * 32), kb_ = r2_ >> 5, nb_ = r2_ & 31; \
        S_ = mwd + (size_t)e_ * FE * D + nb_ * 32; L_ = D; K0_ = kb_ * 64; O_ = w_md8 + ((size_t)e_ * D + nb_ * 32) * FE; KK_ = FE; G_ = nullptr; } } while (0)
            for (;;) {
                __syncthreads();
                if (tid == 0) tkL[0] = (int)__hip_atomic_fetch_add(ctl + CW_CONVQ, 1u, RLX_AGENT);
                __syncthreads();
                const int tk = tkL[0];
                if (tk * TK_ITEMS >= N_GU + N_DN) break;
                const int i0 = tk * TK_ITEMS + wave * 8;
                const float sc = (tk * TK_ITEMS < N_GU) ? W8S_GU : W8S_DN;
                f32x4 bA[8], bB[8], bC[8]; const float* sA; const float* sB; const float* sC; int lA, lB, lC, kA, kB, kC, KA, KB, KC; unsigned char* oA; unsigned char* oB; unsigned char* oC; const LAS float* gA; const LAS float* gB; const LAS float* gC;
                MOE_ITEM(i0, sA, lA, kA, oA, KA, gA); tr_load(sA, lA, kA, lane_c, bA);
                MOE_ITEM(i0 + 1, sB, lB, kB, oB, KB, gB); tr_load(sB, lB, kB, lane_c, bB);
                MOE_ITEM(i0 + 2, sC, lC, kC, oC, KC, gC); tr_load(sC, lC, kC, lane_c, bC);
                tr_finish8(bA, kA, oA, KA, gA, sc, scr, lane_c); MOE_ITEM(i0 + 3, sA, lA, kA, oA, KA, gA); tr_load(sA, lA, kA, lane_c, bA);
                tr_finish8(bB, kB, oB, KB, gB, sc, scr, lane_c); MOE_ITEM(i0 + 4, sB, lB, kB, oB, KB, gB); tr_load(sB, lB, kB, lane_c, bB);
                tr_finish8(bC, kC, oC, KC, gC, sc, scr, lane_c); MOE_ITEM(i0 + 5, sC, lC, kC, oC, KC, gC); tr_load(sC, lC, kC, lane_c, bC);
                tr_finish8(bA, kA, oA, KA, gA, sc, scr, lane_c); MOE_ITEM(i0 + 6, sA, lA, kA, oA, KA, gA); tr_load(sA, lA, kA, lane_c, bA);
                tr_finish8(bB, kB, oB, KB, gB, sc, scr, lane_c); MOE_ITEM(i0 + 7, sB, lB, kB, oB, KB, gB); tr_load(sB, lB, kB, lane_c, bB);
                tr_finish8(bC, kC, oC, KC, gC, sc, scr, lane_c);
                tr_finish8(bA, kA, oA, KA, gA, sc, scr, lane_c);
                tr_finish8(bB, kB, oB, KB, gB, sc, scr, lane_c);
            }
#undef MOE_ITEM
            __syncthreads();
        };
        if (convfirst) conv_pass();
        {
            wsp = (GAS unsigned char*)ws; asm volatile("" : "+s"(wsp)); PIN_ARGS();
            const unsigned short* selbuf = (const unsigned short*)((unsigned char*)(wsp + WS_SEL));
            unsigned char* part = (unsigned char*)(wsp + WS_PART); float* mlp = (float*)((unsigned char*)(wsp + WS_MLP)); float* mlown = (float*)((unsigned char*)(wsp + WS_MLOWN));
            const int xq = bx & 7; unsigned* kvq = ctl + CW_KVQ + (rep * 8 + xq) * 64;
            LAS int* tkq = (LAS int*)(lds + XTRA_OFF + 3088);
            for (;;) {
                if (tid == 0) tkq[0] = (int)__hip_atomic_fetch_add(kvq, 1u, RLX_AGENT);
                __syncthreads();
                const int tk = tkq[0];
                if (tk >= 128) break;
                const int jb = tk >> 3, bh = 8 * xq + (tk & 7), b = bh >> 3, h = bh & 7;
                const size_t hb = (size_t)b * SEQ * D + h * HD;
                att::kv_unit(qbuf + hb, kbuf + hb, vbuf + hb, selbuf + (size_t)bh * SEQ, obuf + hb, mlown + (size_t)bh * SEQ * 2, part + (size_t)bh * att::PROWS * HD, mlp + (size_t)bh * att::PROWS * 2, jb,
                             (char*)lds_raw + RING_OFF, lds + RING_OFF);
            }
            __syncthreads();
        }
        if (!convfirst) conv_pass();
    }
    }
    SEAM(PH_KV);

    if (IN(PH_COMB)) {
        wsp = (GAS unsigned char*)ws; asm volatile("" : "+s"(wsp)); PIN_ARGS();
        const unsigned char* part = (const unsigned char*)(wsp + WS_PART); const float* mlp = (const float*)((unsigned char*)(wsp + WS_MLP)); const float* mlown = (const float*)((unsigned char*)(wsp + WS_MLOWN));
        constexpr float C = att::SCALE * 1.4426950408889634f;
        constexpr int NIT = T * NH * 16;
        const int stride = G * 512;
#pragma unroll 1
        for (int base = vcu * 512 + tid; base < NIT; base += 4 * stride) {
            u32x2 ow[4]; u32x2 pw[4][3]; float m0[4], l0[4], mk[4][3], lk[4][3]; int nsv[4]; size_t opv[4];
#pragma unroll
            for (int u = 0; u < 4; ++u) {
                const int idx = base + u * stride; const int c8 = idx & 15; const int qh = idx >> 4; const int h = qh & 7, tq = qh >> 3, b = tq >> 12, s = tq & (SEQ - 1), i = s >> 8, ns = att::nsl_of(i), bh = b * NH + h;
                opv[u] = (size_t)tq * D + h * HD + c8 * 8; nsv[u] = ns;
                ow[u] = *(const u32x2*)(obuf + opv[u]);
                const f32x2 ml0 = *(const f32x2*)(mlown + ((size_t)bh * SEQ + s) * 2); m0[u] = ml0[0]; l0[u] = ml0[1];
                const size_t prow = (size_t)bh * att::PROWS + att::rowoff_of(i) + (s & 255) * ns;
#pragma unroll
                for (int k = 0; k < 3; ++k) { const size_t pr = prow + (k < ns ? k : 0);
                    const f32x2 mlk = *(const f32x2*)(mlp + pr * 2); mk[u][k] = mlk[0]; lk[u][k] = mlk[1]; pw[u][k] = *(const u32x2*)(part + pr * HD + c8 * 8); }
            }
#pragma unroll
            for (int u = 0; u < 4; ++u) {
                float M = m0[u];
#pragma unroll
                for (int k = 0; k < 3; ++k) if (k < nsv[u]) M = fmaxf(M, mk[u][k]);
                const float w0 = l0[u] * __builtin_amdgcn_exp2f((m0[u] - M) * C); float W = w0;
                float acc[8]; { float f0[4], f1[4]; up4_fp8(ow[u].x, f0); up4_fp8(ow[u].y, f1); const float ws0 = w0 * (1.0f / P8S);
                    acc[0] = f0[0] * ws0; acc[1] = f0[1] * ws0; acc[2] = f0[2] * ws0; acc[3] = f0[3] * ws0; acc[4] = f1[0] * ws0; acc[5] = f1[1] * ws0; acc[6] = f1[2] * ws0; acc[7] = f1[3] * ws0; }
#pragma unroll
                for (int k = 0; k < 3; ++k) { const float wk = (k < nsv[u]) ? lk[u][k] * __builtin_amdgcn_exp2f((mk[u][k] - M) * C) : 0.f; W += wk; const u32x2 p = pw[u][k];
                    float f0[4], f1[4]; up4_fp8(p.x, f0); up4_fp8(p.y, f1); const float ws = wk * (1.0f / P8S);
                    acc[0] += f0[0] * ws; acc[1] += f0[1] * ws; acc[2] += f0[2] * ws; acc[3] += f0[3] * ws; acc[4] += f1[0] * ws; acc[5] += f1[1] * ws; acc[6] += f1[2] * ws; acc[7] += f1[3] * ws; }
                const float iw = (WO_FP8 ? O8S : 1.0f) / W;
                u32x4 o; o.x = cvt_pk_bf16(acc[0] * iw, acc[1] * iw); o.y = cvt_pk_bf16(acc[2] * iw, acc[3] * iw); o.z = cvt_pk_bf16(acc[4] * iw, acc[5] * iw); o.w = cvt_pk_bf16(acc[6] * iw, acc[7] * iw);
#if WO_FP8
                { u32x2 o8; o8.x = pk4_fp8(acc[0] * iw, acc[1] * iw, acc[2] * iw, acc[3] * iw); o8.y = pk4_fp8(acc[4] * iw, acc[5] * iw, acc[6] * iw, acc[7] * iw); *(u32x2*)(o8buf + opv[u]) = o8; }
#else
                *(u32x4*)opv[u] = o;
#endif
            }
        }
    }
    SEAM(PH_COMB);

    if (IN(PH_WO)) {
        wsp = (GAS unsigned char*)ws; asm volatile("" : "+s"(wsp)); PIN_ARGS();
        ProbDenseT<WO_FP8 != 0> pr{WO_FP8 ? (const char*)o8buf : (const char*)obuf, (const char*)w_wo, WO_FP8 ? D / 2 : D, WO_FP8 ? D / 2 : D, 0};
        pg8::StaticOrder S; S.init(T / 256, 4, G, bx);
        EpiRes<false> E{nullptr, hbuf, ss3, h8buf, WO_FP8 ? 1.0f / (W8S_GU * O8S) : 1.0f};
        pg8::gemm_phase(lds + RING_OFF, pr, S, E);
    }
    SEAM(PH_WO);

    if (IN(PH_ROUTE)) {
        wsp = (GAS unsigned char*)ws; asm volatile("" : "+s"(wsp)); PIN_ARGS(); const float* ffn_norm = kap->in[2]; const float* router_w = kap->in[13];
        LAS unsigned* entL = (LAS unsigned*)(lds + XTRA_OFF);
        LAS unsigned* rankL = entL + 256;
        int lane_r = threadIdx.x; asm volatile("" : "+v"(lane_r) :: "memory"); lane_r &= 63;
        float wr_[16][8];
#pragma unroll
        for (int j = 0; j < 16; ++j) { const int k = (j < 8) ? 8 * lane_r + j : 512 + 8 * lane_r + (j - 8); const float gk = ffn_norm[D + k];
            const f32x4 a = *(const f32x4*)(router_w + (size_t)k * 8), b2 = *(const f32x4*)(router_w + (size_t)k * 8 + 4);
            wr_[j][0] = a[0] * gk; wr_[j][1] = a[1] * gk; wr_[j][2] = a[2] * gk; wr_[j][3] = a[3] * gk; wr_[j][4] = b2[0] * gk; wr_[j][5] = b2[1] * gk; wr_[j][6] = b2[2] * gk; wr_[j][7] = b2[3] * gk; }
        for (int chunk = vcu; chunk < T / 128; chunk += G) {
            const int t0 = chunk * 128;
            for (int i0 = 0; i0 < 16; i0 += 4) {
                float lg[4][8], sq4[4];
#pragma unroll
                for (int q = 0; q < 4; ++q) { const int t = t0 + wave * 16 + i0 + q;
                    const u32x4 h0 = *(const u32x4*)(hbuf + (size_t)t * D + 8 * lane_r), h1 = *(const u32x4*)(hbuf + (size_t)t * D + 512 + 8 * lane_r);
                    const float hv[16] = {bflo(h0.x), bfhi(h0.x), bflo(h0.y), bfhi(h0.y), bflo(h0.z), bfhi(h0.z), bflo(h0.w), bfhi(h0.w), bflo(h1.x), bfhi(h1.x), bflo(h1.y), bfhi(h1.y), bflo(h1.z), bfhi(h1.z), bflo(h1.w), bfhi(h1.w)};
#pragma unroll
                    for (int e = 0; e < 8; ++e) { float s = 0.f;
#pragma unroll
                        for (int j = 0; j < 16; ++j) s += hv[j] * wr_[j][e];
                        lg[q][e] = s; }
                    sq4[q] = (lane_r < 16) ? ss3[(size_t)t * 16 + lane_r] : 0.f; }
#pragma unroll
                for (int q = 0; q < 4; ++q) {
#pragma unroll
                    for (int e = 0; e < 8; ++e) lg[q][e] = wave_sum(lg[q][e]);
                    sq4[q] = wave_sum(sq4[q]); }
#pragma unroll
                for (int q = 0; q < 4; ++q) { const int tl = wave * 16 + i0 + q, t = t0 + tl;
                    const float rstd = 1.0f / sqrtf(sq4[q] * (1.0f / D) + EPS);
                    int i1 = 0; float v1 = lg[q][0];
#pragma unroll
                    for (int e = 1; e < 8; ++e) if (lg[q][e] > v1) { v1 = lg[q][e]; i1 = e; }
                    int i2 = -1; float v2 = -__builtin_inff();
#pragma unroll
                    for (int e = 0; e < 8; ++e) if (e != i1 && lg[q][e] > v2) { v2 = lg[q][e]; i2 = e; }
                    const float w1 = 1.0f / (1.0f + __expf((v2 - v1) * rstd));
                    if (lane_r == 0) { entL[tl * 2] = (unsigned)i1; entL[tl * 2 + 1] = (unsigned)i2; gatew[(size_t)t * 2] = w1; gatew[(size_t)t * 2 + 1] = 1.0f - w1; rstd3[t] = rstd; } }
            }
            __syncthreads();
            if (tid < 8) { unsigned c = 0; for (int j = 0; j < 256; ++j) if (entL[j] == (unsigned)tid) { rankL[j] = c; ++c; } bcnt[chunk * 8 + tid] = (int)c; }
            __syncthreads();
            if (tid < 256) ent[(size_t)t0 * 2 + tid] = entL[tid] | (rankL[tid] << 8);
            __syncthreads();
        }
    }
    SEAM(PH_ROUTE);

    if (IN(PH_LIST)) {
        wsp = (GAS unsigned char*)ws; asm volatile("" : "+s"(wsp)); PIN_ARGS();
        LAS int* cntL = (LAS int*)(lds + XTRA_OFF);
        LAS int* baseL = cntL + 2048;
        for (int chunk = vcu; chunk < T / 128; chunk += G) {
            for (int i = tid; i < 2048; i += 512) cntL[i] = bcnt[i];
            __syncthreads();
            if (tid < 8) { int tot = 0, pre = 0; for (int v2 = 0; v2 < 256; ++v2) { if (v2 == chunk) pre = tot; tot += cntL[v2 * 8 + tid]; } baseL[tid] = pre; baseL[16 + tid] = tot; }
            __syncthreads();
            if (tid == 0) { int seg = 0; for (int e = 0; e < 8; ++e) { baseL[8 + e] = seg; seg += (baseL[16 + e] + 255) & ~255; } baseL[24] = seg; }
            __syncthreads();
            if (tid < 256) { const unsigned en = ent[(size_t)chunk * 256 + tid]; const int e = en & 255, rk = en >> 8; const int t = chunk * 128 + (tid >> 1);
                const int pos = baseL[8 + e] + baseL[e] + rk;
                soff[pos] = (unsigned)t * D; srstd[pos] = rstd3[t]; sdst[pos] = t * 2 + (tid & 1); sgw[pos] = gatew[(size_t)t * 2 + (tid & 1)]; }
            if (chunk < 8) { const int e = chunk; const int tot = baseL[16 + e], seg = baseL[8 + e]; for (int p = tot + tid; p < ((tot + 255) & ~255); p += 512) { soff[seg + p] = 0u; srstd[seg + p] = 0.f; sdst[seg + p] = -1; sgw[seg + p] = 0.f; } }
            if (chunk == 0) { const int ntl = baseL[24] >> 8; for (int mt = tid; mt < ntl; mt += 512) { int e = 0; for (int q = 1; q < 8; ++q) if (mt * 256 >= baseL[8 + q]) e = q; texp[mt] = e; } if (tid == 0) ctl[CW_NTILES] = (unsigned)ntl; }
            __syncthreads();
        }
    }
    SEAM(PH_LIST);

#ifndef REP_G1
#define REP_G1 1
#endif
#ifndef REP_G2
#define REP_G2 1
#endif
#ifndef REP_MOE
#define REP_MOE 1
#endif
    for (int rep = 0; rep < REP_MOE; ++rep) { if (rep) xcd_barrier(bar);
#pragma unroll 1
    for (int st = 0; st < MOE_STEPS; ++st) {
        if (IN(PH_MOE0 + st)) {
            wsp = (GAS unsigned char*)ws; asm volatile("" : "+s"(wsp)); PIN_ARGS(); const float* mwd = kap->in[16];
            const int ntiles = (int)__hip_atomic_load(ctl + CW_NTILES, RLX_AGENT);
            const int nrem = ntiles > 256 ? ntiles - 256 : 0;
            bf16* act2 = (bf16*)(unsigned char*)(wsp + WS_ACT2);
            LAS int* texpL = (LAS int*)(lds + XTRA_OFF + 16384);
            { int tm_ = threadIdx.x; asm volatile("" : "+v"(tm_)); for (int i = tm_; i < MOE_TILES_MAX; i += NWAVES * 64) texpL[i] = texp[i]; }
            __syncthreads();
#ifndef MOE_NO_G2
            if (st >= 1) { const int c = st - 1; const int nM = CHUNK_TILES + (c == 0 ? nrem : 0);
                ProbMoeG2 pr{(const char*)(unsigned char*)(wsp + ((c & 1) ? WS_ACT1 : WS_ACT0)), (const char*)act2, (const char*)w_md8, FE / 2, FE / 2, texpL, c * CHUNK_TILES, CHUNK_TILES};
                pg8::StaticOrder S; S.init(nM, 4, G, bx);
                EpiMoeOut E{y8buf, sdst, sgw, c * CHUNK_TILES, CHUNK_TILES};
                for (int r2 = 0; r2 < REP_G2; ++r2) pg8::gemm_phase(lds + RING_OFF, pr, S, E); }
#endif
#ifndef MOE_NO_G1
            if (st < MOE_STEPS - 1) { const int c = st; const int nM = CHUNK_TILES + (c == 0 ? nrem : 0);
                ProbMoeG1 pr{(const char*)h8buf, (const char*)w_mgu8, D / 2, D / 2, soff, texpL, c * CHUNK_TILES, CHUNK_TILES};
                EpiSwiGLU<true, FE> E{(bf16*)(unsigned char*)(wsp + ((c & 1) ? WS_ACT1 : WS_ACT0)), RstdTable{nullptr, -1, 0}, srstd, c * CHUNK_TILES, CHUNK_TILES, act2};
                if (st == 1 && nrem > 0 && G == 256) { SkewOrder S; S.init(nM, 2 * FE / 256, G, bx); S.e = 4 * nrem; pg8::gemm_phase(lds + RING_OFF, pr, S, E); }
                else { pg8::StaticOrder S; S.init(nM, 2 * FE / 256, G, bx); for (int r1 = 0; r1 < REP_G1; ++r1) pg8::gemm_phase(lds + RING_OFF, pr, S, E); } }
#endif
        }
        SEAM(PH_MOE0 + st);
    }
    }

    if (IN(PH_FINAL)) {
        wsp = (GAS unsigned char*)ws; asm volatile("" : "+s"(wsp)); PIN_ARGS(); const float* final_norm = kap->in[17]; float* out_f = kap->out;
        int tf_ = threadIdx.x; asm volatile("" : "+v"(tf_)); const int lane_f = tf_ & 63;
        const unsigned tmo = __hip_atomic_load(ctl + CW_BAR + XB_TMO, RLX_AGENT);
        f32x4 gn[4];
#pragma unroll
        for (int j = 0; j < 4; ++j) gn[j] = *(const f32x4*)(final_norm + 16 * lane_f + 4 * j);
        for (int t0 = gw; t0 < T; t0 += 2 * NGW) {
            f32x4 v[2][4]; float s2[2];
#pragma unroll
            for (int q = 0; q < 2; ++q) { const int t = t0 + q * NGW;
                const u32x4 a0 = *(const u32x4*)(hbuf + (size_t)t * D + 16 * lane_f), a1 = *(const u32x4*)(hbuf + (size_t)t * D + 16 * lane_f + 8);
                const u32x4 y = *(const u32x4*)(y8buf + (size_t)t * 2 * D + 16 * lane_f), z = *(const u32x4*)(y8buf + (size_t)t * 2 * D + D + 16 * lane_f);
                float yf[4][4], zf[4][4]; up4_fp8(y.x, yf[0]); up4_fp8(y.y, yf[1]); up4_fp8(y.z, yf[2]); up4_fp8(y.w, yf[3]); up4_fp8(z.x, zf[0]); up4_fp8(z.y, zf[1]); up4_fp8(z.z, zf[2]); up4_fp8(z.w, zf[3]);
                constexpr float YI = 1.0f / Y8S;
                v[q][0] = (f32x4){bflo(a0.x) + (yf[0][0] + zf[0][0]) * YI, bfhi(a0.x) + (yf[0][1] + zf[0][1]) * YI, bflo(a0.y) + (yf[0][2] + zf[0][2]) * YI, bfhi(a0.y) + (yf[0][3] + zf[0][3]) * YI};
                v[q][1] = (f32x4){bflo(a0.z) + (yf[1][0] + zf[1][0]) * YI, bfhi(a0.z) + (yf[1][1] + zf[1][1]) * YI, bflo(a0.w) + (yf[1][2] + zf[1][2]) * YI, bfhi(a0.w) + (yf[1][3] + zf[1][3]) * YI};
                v[q][2] = (f32x4){bflo(a1.x) + (yf[2][0] + zf[2][0]) * YI, bfhi(a1.x) + (yf[2][1] + zf[2][1]) * YI, bflo(a1.y) + (yf[2][2] + zf[2][2]) * YI, bfhi(a1.y) + (yf[2][3] + zf[2][3]) * YI};
                v[q][3] = (f32x4){bflo(a1.z) + (yf[3][0] + zf[3][0]) * YI, bfhi(a1.z) + (yf[3][1] + zf[3][1]) * YI, bflo(a1.w) + (yf[3][2] + zf[3][2]) * YI, bfhi(a1.w) + (yf[3][3] + zf[3][3]) * YI};
                float s = 0.f;
#pragma unroll
                for (int j = 0; j < 4; ++j) s += (v[q][j][0] * v[q][j][0] + v[q][j][1] * v[q][j][1]) + (v[q][j][2] * v[q][j][2] + v[q][j][3] * v[q][j][3]);
                s2[q] = s; }
            s2[0] = wave_sum(s2[0]); s2[1] = wave_sum(s2[1]);
            asm volatile("s_waitcnt vmcnt(0)" ::: "memory");
#pragma unroll
            for (int q = 0; q < 2; ++q) { const int t = t0 + q * NGW;
                float rstd = 1.0f / sqrtf(s2[q] * (1.0f / D) + EPS);
                if (tmo) rstd = __builtin_nanf("");
#pragma unroll
                for (int j = 0; j < 4; ++j) *(f32x4*)(out_f + (size_t)t * D + 16 * lane_f + 4 * j) = v[q][j] * rstd * gn[j]; }
        }
    }
#undef IN
#undef SEAM
}

#ifndef MK_ONE_LAUNCH
#define MK_ONE_LAUNCH 1
#endif
extern "C" void kernel_launch(void* const* d_in, const int* in_sizes, int n_in, void* d_out, int out_size, void* d_ws, size_t ws_size, hipStream_t stream) {
    static int grid = 0;
    if (grid == 0) {
        if (n_in != 18 || in_sizes[0] != T * D || out_size != T * D || ws_size < WS_END) { fprintf(stderr, "kernel_launch: shape mismatch n_in %d in0 %d out %d ws %zu (need %zu)\n", n_in, n_in > 0 ? in_sizes[0] : -1, out_size, ws_size, (size_t)WS_END); grid = -1; return; }
        int dev = 0, cus = 0, per_cu = 0;
        if (hipGetDevice(&dev) != hipSuccess || hipDeviceGetAttribute(&cus, hipDeviceAttributeMultiprocessorCount, dev) != hipSuccess) { grid = -1; return; }
        if (hipFuncSetAttribute((const void*)yoco_fwd, hipFuncAttributeMaxDynamicSharedMemorySize, LDS_BYTES) != hipSuccess) { fprintf(stderr, "kernel_launch: hipFuncSetAttribute failed\n"); grid = -1; return; }
        if (hipOccupancyMaxActiveBlocksPerMultiprocessor(&per_cu, (const void*)yoco_fwd, NWAVES * 64, LDS_BYTES) != hipSuccess || per_cu < 1) fprintf(stderr, "kernel_launch: occupancy query says %d\n", per_cu);
        (void)hipGetLastError();
        grid = cus;
    }
    if (grid < 0) return;
    (void)hipMemsetAsync((char*)d_ws + WS_CTL, 0, CTL_ZERO_BYTES, stream);
    Args a{};
    for (int i = 0; i < 18; ++i) a.in[i] = (const float*)d_in[i];
    a.out = (float*)d_out; a.ws = (unsigned char*)d_ws;
#if MK_ONE_LAUNCH
    a.ph_lo = 0; a.ph_hi = PH_COUNT;
    hipLaunchKernelGGL(yoco_fwd, dim3(grid), dim3(NWAVES * 64), LDS_BYTES, stream, a);
#else
    for (int p = 0; p < PH_COUNT; ++p) { a.ph_lo = p; a.ph_hi = p + 1; hipLaunchKernelGGL(yoco_fwd, dim3(grid), dim3(NWAVES * 64), LDS_BYTES, stream, a); }
#endif
}
```

```cpp
#include <hip/hip_runtime.h>
#include <cstdio>
#include <cstdint>

#define LAS __attribute__((address_space(3)))
#define GAS __attribute__((address_space(1)))
typedef unsigned short bf16;
typedef short bf16x8 __attribute__((ext_vector_type(8)));
typedef short s16x4 __attribute__((ext_vector_type(4)));
typedef float f32x4 __attribute__((ext_vector_type(4)));
typedef float f32x16 __attribute__((ext_vector_type(16)));
typedef unsigned u32x4 __attribute__((ext_vector_type(4)));
typedef unsigned u32x2 __attribute__((ext_vector_type(2)));
typedef float f32x2 __attribute__((ext_vector_type(2)));
typedef long l64x2 __attribute__((ext_vector_type(2)));
typedef int i32x4 __attribute__((ext_vector_type(4)));
typedef int i32x8 __attribute__((ext_vector_type(8)));

constexpr int T = 32768, D = 1024, SEQ = 4096, NBATCH = 8, NH = 8, HD = 128, FF = 2816, FE = 3584, NE = 8, NBLK = 16;
constexpr float EPS = 1e-6f;
constexpr int NWAVES = 8;
constexpr int MOE_ROWS_MAX = 2 * T + NE * 256;
constexpr int MOE_TILES_MAX = MOE_ROWS_MAX / 256;
constexpr int CHUNK_TILES = 64;
constexpr int CONV_WGS = 80;
constexpr int MOE_STEPS = 5;

constexpr size_t MiB = 1u << 20, KiB = 1u << 10;
constexpr size_t WS_CTL = 0, CTL_ZERO_BYTES = 64 * KiB;
constexpr size_t WS_ROPE_C = 1 * MiB, WS_ROPE_S = 1 * MiB + 256 * KiB;
constexpr size_t WS_KMEAN = 1 * MiB + 512 * KiB;
constexpr size_t WS_SS1 = 2 * MiB, WS_SS2 = 4 * MiB, WS_SS3 = 6 * MiB;
constexpr size_t WS_RSTD3 = 8 * MiB;
constexpr size_t WS_GATEW = 8 * MiB + 128 * KiB;
constexpr size_t WS_ENT = 8 * MiB + 384 * KiB;
constexpr size_t WS_BCNT = 8 * MiB + 640 * KiB;
constexpr size_t WS_SOFF = 9 * MiB, WS_SRSTD = 9 * MiB + 512 * KiB, WS_SDST = 10 * MiB, WS_SGW = 10 * MiB + 512 * KiB;
constexpr size_t WS_TEXP = 11 * MiB;
constexpr size_t WS_W_POOL = 12 * MiB;
constexpr size_t WS_W_QKV = WS_W_POOL + 512 * KiB;
constexpr size_t WS_W_WO = WS_W_QKV + 6 * MiB;
constexpr size_t WS_W_FGU = WS_W_WO + 2 * MiB;
constexpr size_t WS_W_FD = WS_W_FGU + 11 * MiB;
constexpr size_t WS_PART = WS_W_FD + 5 * MiB + 512 * KiB;
constexpr size_t WS_W_MGU = WS_PART + 84 * MiB;
constexpr size_t WS_W_MD = WS_W_MGU + 56 * MiB;
constexpr size_t WS_H = WS_W_MD + 28 * MiB;
constexpr size_t WS_R = WS_H + 64 * MiB;
constexpr size_t WS_POOLED = WS_R;
constexpr size_t WS_FACT = WS_R;
constexpr size_t WS_Q = WS_R, WS_K = WS_R + 64 * MiB, WS_V = WS_R + 128 * MiB;
constexpr size_t WS_MLP = WS_R + 192 * MiB;
constexpr size_t WS_MLOWN = WS_R + 198 * MiB;
constexpr size_t WS_SEL = WS_SS1;
constexpr size_t WS_ACT0 = WS_R, WS_ACT1 = WS_R + 56 * MiB;
constexpr size_t WS_ACT2 = WS_R + 112 * MiB;
constexpr size_t WS_H8 = WS_R + 120 * MiB;
constexpr size_t WS_Y8 = WS_R + 152 * MiB;
constexpr size_t WS_END = WS_R + 239 * MiB;
constexpr float W8S_GU = 32.f, W8S_DN = 64.f, ACT8S = 4.f;
static_assert(WS_H == 205 * MiB && WS_END == 508 * MiB && WS_PART + (size_t)64 * 10752 * 128 == WS_W_MGU, "ws map");
constexpr int CW_TMO = 0, CW_CODE = 1, CW_BAR = 4096, CW_NTILES = 8192, CW_CONVQ = 8256, CW_KVQ = 8448;

constexpr int RING_OFF = 0, RING_BYTES = 131072;
constexpr int LDSCTL_OFF = RING_BYTES, MISC_OFF = LDSCTL_OFF + 320, XTRA_OFF = LDSCTL_OFF + 1024;
constexpr int LDS_BYTES = 155648;

#define RLX_AGENT __ATOMIC_RELAXED, __HIP_MEMORY_SCOPE_AGENT
#define LDS_WAIT() asm volatile("s_waitcnt lgkmcnt(0)" ::: "memory")
#define VM_WAIT() asm volatile("s_waitcnt vmcnt(0)" ::: "memory")
__device__ __forceinline__ unsigned f2bf(float f) { unsigned u = __builtin_bit_cast(unsigned, f); return (u + 0x7fffu + ((u >> 16) & 1u)) >> 16; }
__device__ __forceinline__ unsigned pk2(float lo, float hi) { return f2bf(lo) | (f2bf(hi) << 16); }
__device__ __forceinline__ unsigned cvt_pk_bf16(float lo, float hi) { unsigned r; asm volatile("v_cvt_pk_bf16_f32 %0, %1, %2" : "=v"(r) : "v"(lo), "v"(hi)); return r; }
typedef float f32x2v __attribute__((ext_vector_type(2)));
__device__ __forceinline__ void up4_fp8(unsigned w, float (&f)[4]) { const f32x2v lo = __builtin_amdgcn_cvt_pk_f32_fp8((int)w, false), hi = __builtin_amdgcn_cvt_pk_f32_fp8((int)w, true); f[0] = lo[0]; f[1] = lo[1]; f[2] = hi[0]; f[3] = hi[1]; }
__device__ __forceinline__ unsigned pk4_fp8(float a, float b, float c, float d) { int w = 0; w = __builtin_amdgcn_cvt_pk_fp8_f32(a, b, w, false); w = __builtin_amdgcn_cvt_pk_fp8_f32(c, d, w, true); return (unsigned)w; }
__device__ __forceinline__ float bflo(unsigned w) { return __builtin_bit_cast(float, w << 16); }
__device__ __forceinline__ float bfhi(unsigned w) { return __builtin_bit_cast(float, w & 0xffff0000u); }
__device__ __forceinline__ float wave_sum(float v) {
#pragma unroll
    for (int o = 1; o < 64; o <<= 1) v += __shfl_xor(v, o);
    return v;
}

namespace pg8 {
constexpr int BM = 256, BK = 64, HALF = 128, HTB = HALF * BK * 2, STAGE_BYTES = 8 * HTB, NXCD = 8, WGM = 8;
constexpr int GSLOT_OFF = 132096, RSLOT_OFF = 132096 + 8192;
__host__ __device__ __forceinline__ int lds_byte(int r, int c) { return (r >> 3) * 1024 + (r & 7) * 128 + ((((c >> 3) ^ (r >> 1)) & 7) << 4) + (c & 7) * 2; }
__host__ __device__ __forceinline__ void stage_rc(int b, int& R, int& C) { const int q = b / 1024, p = b % 1024, rr = p / 128, cq = (p % 128) / 16; R = q * 8 + rr; C = ((cq ^ (R >> 1)) & 7) * 8; }
__host__ __device__ __forceinline__ int perm32(int rho) { const int n = rho >> 4, i = rho & 15; return 8 * (i >> 2) + 4 * n + (i & 3); }
struct Unit { int pm, pn; };
struct StaticOrder {
    int nM, nN, nwg, G, c;
    __device__ void init(int nM_, int nN_, int G_, int c_) { nM = nM_; nN = nN_; nwg = nM * nN; G = G_; c = c_; }
    __device__ bool next(int i, Unit& u) const {
        const long L = (long)i * G + c; if (L >= nwg) return false;
        int wgid = (int)L; { const int q = nwg / NXCD, r = nwg % NXCD, xcd = wgid % NXCD, off = wgid / NXCD; wgid = (xcd < r ? xcd * (q + 1) : r * (q + 1) + (xcd - r) * q) + off; }
        const int nig = WGM * nN, gid = wgid / nig, fm = gid * WGM, gsz = (nM - fm) < WGM ? (nM - fm) : WGM;
        u.pm = fm + ((wgid % nig) % gsz); u.pn = (wgid % nig) / gsz; return true;
    }
};
template <class P, class Epi, class Sched>
__device__ __forceinline__ void gemm_phase(LAS unsigned char* lds, const P& pr, const Sched& S, const Epi& E) {
    int tid_ = threadIdx.x; asm volatile("" : "+v"(tid_));
    const int tid = tid_, wid = __builtin_amdgcn_readfirstlane(tid >> 6), lane = tid & 63, wr = wid >> 2, wc = wid & 3, fr = lane & 15, fq = lane >> 4;
    const int K = pr.K, nt = K / BK;
    unsigned voffB[2], vcA[2][2]; int Rr[2]; unsigned Cc[2];
#pragma unroll
    for (int i = 0; i < 2; ++i) { int R, C; stage_rc(tid * 16 + i * 8192, R, C); const int Rb = (R & ~31) + perm32(R & 31);
        voffB[i] = (unsigned)(Rb * K + C) * 2u; Rr[i] = R; Cc[i] = (unsigned)C * 2u; }
    const size_t kstep = (size_t)(BK * 2);
    const size_t hstepB = (size_t)HALF * K * 2;
    const unsigned ldsw = (unsigned)wid * 1024u;
    const int aoff0 = lds_byte(wr * 64 + fr, fq * 8), boff0 = lds_byte(wc * 32 + fr, fq * 8);
#define PG8_SA(b, h) (((b) * 2 + (h)) * HTB)
#define PG8_SB(b, h) ((4 + (b) * 2 + (h)) * HTB)
#define PG8_STAGE(bufoff, gbase, voff) do { _Pragma("unroll") for (int _i = 0; _i < 2; ++_i) { unsigned vo_ = (voff)[_i]; asm volatile("" : "+v"(vo_));     \
        __builtin_amdgcn_global_load_lds((const unsigned*)((const char*)(gbase) + vo_), (LAS unsigned*)(lds + (bufoff) + ldsw + _i * 8192), 16, 0, 0); } } while (0)
#define PG8_X64(o1, o0) int o1; asm volatile("v_xor_b32 %0, 64, %1" : "=v"(o1) : "v"(o0))
#define PG8_LDA(dst, b, h) do { PG8_X64(aoff1, aoff0); _Pragma("unroll") for (int m = 0; m < 4; ++m) { dst[m][0] = *(const LAS bf16x8*)(lds + PG8_SA(b, h) + aoff0 + m * 2048); dst[m][1] = *(const LAS bf16x8*)(lds + PG8_SA(b, h) + aoff1 + m * 2048); } } while (0)
#define PG8_LDB(dst, b, h) do { PG8_X64(boff1, boff0); _Pragma("unroll") for (int n = 0; n < 2; ++n) { dst[n][0] = *(const LAS bf16x8*)(lds + PG8_SB(b, h) + boff0 + n * 2048); dst[n][1] = *(const LAS bf16x8*)(lds + PG8_SB(b, h) + boff1 + n * 2048); } } while (0)
#define PG8_MMA(ai, bj, At, Bt) do { __builtin_amdgcn_s_setprio(1); \
        if constexpr (P::FP8) { _Pragma("unroll") for (int m = 0; m < 4; ++m) _Pragma("unroll") for (int n = 0; n < 2; ++n) { \
            const i32x8 a8_ = __builtin_shufflevector(__builtin_bit_cast(i32x4, At[m][0]), __builtin_bit_cast(i32x4, At[m][1]), 0, 1, 2, 3, 4, 5, 6, 7); \
            const i32x8 b8_ = __builtin_shufflevector(__builtin_bit_cast(i32x4, Bt[n][0]), __builtin_bit_cast(i32x4, Bt[n][1]), 0, 1, 2, 3, 4, 5, 6, 7); \
            asm volatile("v_mfma_scale_f32_16x16x128_f8f6f4 %0, %1, %2, %0, %3, %3 op_sel_hi:[0,0,0]" : "+v"(acc[ai][bj][m][n]) : "v"(b8_), "v"(a8_), "v"(sc1_)); } }     \
        else { _Pragma("unroll") for (int m = 0; m < 4; ++m) _Pragma("unroll") for (int n = 0; n < 2; ++n) _Pragma("unroll") for (int k = 0; k < 2; ++k) \
            acc[ai][bj][m][n] = __builtin_amdgcn_mfma_f32_16x16x32_bf16(Bt[n][k], At[m][k], acc[ai][bj][m][n], 0, 0, 0); } \
        __builtin_amdgcn_s_setprio(0); } while (0)
#define PG8_MMA0(ai, bj, At, Bt) do { __builtin_amdgcn_s_setprio(1);        \
        if constexpr (P::FP8) { _Pragma("unroll") for (int m = 0; m < 4; ++m) _Pragma("unroll") for (int n = 0; n < 2; ++n) { \
            const i32x8 a8_ = __builtin_shufflevector(__builtin_bit_cast(i32x4, At[m][0]), __builtin_bit_cast(i32x4, At[m][1]), 0, 1, 2, 3, 4, 5, 6, 7); \
            const i32x8 b8_ = __builtin_shufflevector(__builtin_bit_cast(i32x4, Bt[n][0]), __builtin_bit_cast(i32x4, Bt[n][1]), 0, 1, 2, 3, 4, 5, 6, 7); \
            asm volatile("v_mfma_scale_f32_16x16x128_f8f6f4 %0, %1, %2, 0, %3, %3 op_sel_hi:[0,0,0]" : "=v"(acc[ai][bj][m][n]) : "v"(b8_), "v"(a8_), "v"(sc1_)); } } \
        else { _Pragma("unroll") for (int m = 0; m < 4; ++m) _Pragma("unroll") for (int n = 0; n < 2; ++n) { \
            acc[ai][bj][m][n] = __builtin_amdgcn_mfma_f32_16x16x32_bf16(Bt[n][0], At[m][0], (f32x4){0.f, 0.f, 0.f, 0.f}, 0, 0, 0); \
            acc[ai][bj][m][n] = __builtin_amdgcn_mfma_f32_16x16x32_bf16(Bt[n][1], At[m][1], acc[ai][bj][m][n], 0, 0, 0); } } \
        __builtin_amdgcn_s_setprio(0); } while (0)
#define PG8_WAIT_V(n) asm volatile("s_waitcnt vmcnt(" #n ")" ::: "memory")
#define PG8_WAIT_L(n) asm volatile("s_waitcnt lgkmcnt(" #n ")" ::: "memory")
#define PG8_BAR __builtin_amdgcn_s_barrier()
#define PG8_SCHED __builtin_amdgcn_sched_barrier(0)
    Unit cur, nxt; int ui = 0;
    if (!S.next(0, cur)) return;
    int sc1_ = 0x7f7f7f7f; asm volatile("" : "+v"(sc1_));
    f32x4 acc[2][2][4][2];
    bf16x8 At[4][2], B0[2][2], B1[2][2];
    const char* cA = pr.a_base(cur); const char* cB = pr.b_base(cur);
    if constexpr (Epi::PREFETCH) E.prefetch(lds, cur, ldsw, lane);
    if constexpr (P::GATHER) {
        const unsigned* rl = pr.rows(cur);
#pragma unroll
        for (int h = 0; h < 2; ++h)
#pragma unroll
            for (int i = 0; i < 2; ++i) vcA[h][i] = rl[h * HALF + Rr[i]] + Cc[i];
    } else {
#pragma unroll
        for (int h = 0; h < 2; ++h)
#pragma unroll
            for (int i = 0; i < 2; ++i) vcA[h][i] = (unsigned)((h * HALF + Rr[i]) * pr.lda) * 2u + Cc[i];
    }
    PG8_STAGE(PG8_SB(0, 0), cB, voffB); PG8_STAGE(PG8_SB(0, 1), cB + hstepB, voffB); PG8_STAGE(PG8_SA(0, 0), cA, vcA[0]); PG8_STAGE(PG8_SA(0, 1), cA, vcA[1]);
    if (wr == 1) PG8_BAR;
    PG8_WAIT_V(2); PG8_BAR;
    PG8_STAGE(PG8_SB(1, 0), cB + kstep, voffB); PG8_STAGE(PG8_SA(1, 0), cA + kstep, vcA[0]); PG8_STAGE(PG8_SB(1, 1), cB + hstepB + kstep, voffB);
    PG8_WAIT_V(6); PG8_BAR;
    for (;;) {
        const bool has_next = S.next(ui + 1, nxt);
        const char* nA = has_next ? pr.a_base(nxt) : cA; const char* nB = has_next ? pr.b_base(nxt) : cB;
        if constexpr (P::GATHER) {
            if (has_next) { const unsigned* rn = pr.rows(nxt);
#pragma unroll
                for (int h = 0; h < 2; ++h)
#pragma unroll
                    for (int i = 0; i < 2; ++i) { int t2 = threadIdx.x; asm volatile("" : "+v"(t2)); int R2, C2; stage_rc(t2 * 16 + i * 8192, R2, C2);
                        __builtin_amdgcn_global_load_lds(rn + h * HALF + R2, (LAS unsigned*)(lds + GSLOT_OFF + ldsw + (h * 2 + i) * 256), 4, 0, 0); } }
        }
        for (int t = 0; t < nt; t += 2) {
            const bool last = (t == nt - 2);
            const char* a1 = cA + (size_t)(t + 1) * kstep;
            const char* a2 = last ? nA : cA + (size_t)(t + 2) * kstep; const char* b2 = last ? nB : cB + (size_t)(t + 2) * kstep;
            const char* a3 = a2 + kstep; const char* b3 = b2 + kstep;
            PG8_LDB(B0, 0, 0); PG8_LDB(B1, 0, 1); PG8_SCHED; PG8_LDA(At, 0, 0); PG8_STAGE(PG8_SA(1, 1), a1, vcA[1]);
            if constexpr (P::GATHER) { if (last && has_next) {
#pragma unroll
                for (int h = 0; h < 2; ++h)
#pragma unroll
                    for (int i = 0; i < 2; ++i) { int t3 = threadIdx.x; asm volatile("" : "+v"(t3)); int R3, C3; stage_rc(t3 * 16 + i * 8192, R3, C3);
                        vcA[h][i] = *(const LAS unsigned*)(lds + GSLOT_OFF + ldsw + (h * 2 + i) * 256 + (t3 & 63) * 4) + (unsigned)C3 * 2u; } } }
            PG8_WAIT_V(8); PG8_WAIT_L(0); PG8_BAR; if (t == 0) { PG8_MMA0(0, 0, At, B0); PG8_MMA0(0, 1, At, B1); } else { PG8_MMA(0, 0, At, B0); PG8_MMA(0, 1, At, B1); } PG8_BAR; PG8_SCHED;
            PG8_LDA(At, 0, 1); PG8_STAGE(PG8_SB(0, 0), b2, voffB); PG8_STAGE(PG8_SB(0, 1), b2 + hstepB, voffB); PG8_STAGE(PG8_SA(0, 0), a2, vcA[0]);
            PG8_WAIT_V(8); PG8_WAIT_L(0); PG8_BAR; if (t == 0) { PG8_MMA0(1, 0, At, B0); PG8_MMA0(1, 1, At, B1); } else { PG8_MMA(1, 0, At, B0); PG8_MMA(1, 1, At, B1); } PG8_BAR; PG8_SCHED;
            PG8_LDB(B0, 1, 0); PG8_LDB(B1, 1, 1); PG8_SCHED; PG8_LDA(At, 1, 0); PG8_STAGE(PG8_SA(0, 1), a2, vcA[1]);
            PG8_WAIT_V(8); PG8_WAIT_L(0); PG8_BAR; PG8_MMA(0, 0, At, B0); PG8_MMA(0, 1, At, B1); PG8_BAR; PG8_SCHED;
            PG8_LDA(At, 1, 1); PG8_STAGE(PG8_SB(1, 0), b3, voffB); PG8_STAGE(PG8_SB(1, 1), b3 + hstepB, voffB); PG8_STAGE(PG8_SA(1, 0), a3, vcA[0]);
            PG8_WAIT_V(8); PG8_WAIT_L(0); PG8_BAR; PG8_MMA(1, 0, At, B0); PG8_MMA(1, 1, At, B1); PG8_BAR; PG8_SCHED;
        }
        if (wr == 0) PG8_BAR;
        if constexpr (P::FP8) asm volatile("s_nop 15\n\ts_nop 15" ::: "memory");
        { int te_ = threadIdx.x; asm volatile("" : "+v"(te_)); const int fr_e = te_ & 15, fq_e = (te_ >> 4) & 3;
          if constexpr (Epi::PREFETCH) E.run(acc, cur, wr, wc, fr_e, fq_e, lds, ldsw); else E(acc, cur, wr, wc, fr_e, fq_e); }
        if (!has_next) break;
        cur = nxt; cA = nA; cB = nB; ++ui;
        if constexpr (Epi::PREFETCH) { int tp_ = threadIdx.x; asm volatile("" : "+v"(tp_)); E.prefetch(lds, cur, ldsw, tp_ & 63); }
        if (wr == 1) PG8_BAR;
    }
    PG8_WAIT_V(0);
    PG8_BAR;
#undef PG8_SA
#undef PG8_SB
#undef PG8_STAGE
#undef PG8_LDA
#undef PG8_X64
#undef PG8_LDB
#undef PG8_MMA
#undef PG8_MMA0
#undef PG8_WAIT_V
#undef PG8_WAIT_L
#undef PG8_BAR
#undef PG8_SCHED
}
}

#ifndef FFN1_FP8
#define FFN1_FP8 0
#endif
#ifndef FFN2_FP8
#define FFN2_FP8 1
#endif
#ifndef WO_FP8
#define WO_FP8 1
#endif
constexpr float O8S = 16.f;
constexpr float P8S = 16.f, Y8S = 16.f;
#ifndef QKV_FP8
#define QKV_FP8 1
#endif
template <bool F8> struct ProbDenseT {
    static constexpr bool GATHER = false, FP8 = F8;
    const char* A; const char* B; int K, lda; int a_pn_step;
    __device__ __forceinline__ const char* a_base(const pg8::Unit& u) const { return A + (size_t)u.pm * 256 * lda * 2 + (size_t)u.pn * a_pn_step; }
    __device__ __forceinline__ const char* b_base(const pg8::Unit& u) const { return B + (size_t)u.pn * 256 * K * 2; }
    __device__ __forceinline__ const unsigned* rows(const pg8::Unit&) const { return nullptr; }
};
typedef ProbDenseT<false> ProbDense;
__device__ __forceinline__ int moe_tile(int pm, int mt0, int nmain) { return pm < nmain ? mt0 + pm : 256 + pm - nmain; }
struct ProbMoeG1 {
    static constexpr bool GATHER = true, FP8 = true;
    const char* A; const char* B; int K, lda; const unsigned* soff; const LAS int* texp; int mt0, nmain;
    __device__ __forceinline__ const char* a_base(const pg8::Unit&) const { return A; }
    __device__ __forceinline__ const char* b_base(const pg8::Unit& u) const { const int e = texp[moe_tile(u.pm, mt0, nmain)]; return B + ((size_t)e * (2 * FE) + (size_t)u.pn * 256) * D; }
    __device__ __forceinline__ const unsigned* rows(const pg8::Unit& u) const { return soff + (size_t)moe_tile(u.pm, mt0, nmain) * 256; }
};
struct ProbMoeG2 {
    static constexpr bool GATHER = false, FP8 = true;
    const char* A; const char* A2; const char* B; int K, lda; const LAS int* texp; int mt0, nmain;
    __device__ __forceinline__ const char* a_base(const pg8::Unit& u) const { return u.pm < nmain ? A + (size_t)u.pm * 256 * FE : A2 + (size_t)(u.pm - nmain) * 256 * FE; }
    __device__ __forceinline__ const char* b_base(const pg8::Unit& u) const { const int e = texp[moe_tile(u.pm, mt0, nmain)]; return B + ((size_t)e * D + (size_t)u.pn * 256) * FE; }
    __device__ __forceinline__ const unsigned* rows(const pg8::Unit&) const { return nullptr; }
};
struct SkewOrder : pg8::StaticOrder {
    int e;
    __device__ bool next(int i, pg8::Unit& u) const {
        long L;
        if (c < e) { if (i >= 3) return false; L = (long)i * G + c; }
        else if (i < 7) L = (long)i * G + c;
        else { const int rho = c - e; if (i > 7 || rho >= 4 * e) return false; L = (long)(3 + rho / e) * G + (rho % e); }
        if (L >= nwg) return false;
        int wgid = (int)L; { const int q = nwg / pg8::NXCD, r = nwg % pg8::NXCD, xcd = wgid % pg8::NXCD, off = wgid / pg8::NXCD; wgid = (xcd < r ? xcd * (q + 1) : r * (q + 1) + (xcd - r) * q) + off; }
        const int nig = pg8::WGM * nN, gid = wgid / nig, fm = gid * pg8::WGM, gsz = (nM - fm) < pg8::WGM ? (nM - fm) : pg8::WGM;
        u.pm = fm + ((wgid % nig) % gsz); u.pn = (wgid % nig) / gsz; return true;
    }
};

__device__ __forceinline__ void rstd_rows(const float* ss, int row0  , int fq, float (&rs)[2][4]) {
#pragma unroll
    for (int ai = 0; ai < 2; ++ai)
#pragma unroll
        for (int m = 0; m < 4; ++m) {
            const f32x4 p = *(const f32x4*)(ss + (size_t)(row0 + ai * 128 + m * 16) * 16 + 4 * fq);
            float s = (p[0] + p[1]) + (p[2] + p[3]);
            s += __shfl_xor(s, 16); s += __shfl_xor(s, 32);
            rs[ai][m] = __builtin_amdgcn_rsqf(s * (1.0f / D) + EPS);
        }
}
struct RstdTable {
    const float* ss; mutable int prev_pm; mutable int par;
    __device__ __forceinline__ void update(LAS unsigned char* lds, const pg8::Unit& u) const {
        if (u.pm != prev_pm) { prev_pm = u.pm; par ^= 1;
            int t_ = threadIdx.x; asm volatile("" : "+v"(t_)); const int t = t_, row = t >> 1, hf = t & 1;
            const float* p = ss + ((size_t)u.pm * 256 + row) * 16 + hf * 8;
            const f32x4 a = *(const f32x4*)p, b = *(const f32x4*)(p + 4);
            float s = ((a[0] + a[1]) + (a[2] + a[3])) + ((b[0] + b[1]) + (b[2] + b[3]));
            s += __shfl_xor(s, 1);
            if (hf == 0) *(LAS float*)(lds + pg8::RSLOT_OFF + par * 1024 + row * 4) = __builtin_amdgcn_rsqf(s * (1.0f / D) + EPS); }
    }
    __device__ __forceinline__ void rows(LAS unsigned char* lds, int wr, int fr, float (&rs)[2][4]) const {
#pragma unroll
        for (int ai = 0; ai < 2; ++ai)
#pragma unroll
            for (int m = 0; m < 4; ++m) rs[ai][m] = *(const LAS float*)(lds + pg8::RSLOT_OFF + par * 1024 + (ai * 128 + wr * 64 + m * 16 + fr) * 4);
    }
};
__device__ __forceinline__ float silu_mul(float g, float u) { return g * u * __builtin_amdgcn_rcpf(1.0f + __builtin_amdgcn_exp2f(-1.4426950408889634f * g)); }
__device__ __forceinline__ f32x4 silu4(f32x4 gp, f32x4 up) {
    f32x4 e; e[0] = __builtin_amdgcn_exp2f(gp[0]); e[1] = __builtin_amdgcn_exp2f(gp[1]); e[2] = __builtin_amdgcn_exp2f(gp[2]); e[3] = __builtin_amdgcn_exp2f(gp[3]);
    const f32x4 d = e + 1.0f; f32x4 q; q[0] = __builtin_amdgcn_rcpf(d[0]); q[1] = __builtin_amdgcn_rcpf(d[1]); q[2] = __builtin_amdgcn_rcpf(d[2]); q[3] = __builtin_amdgcn_rcpf(d[3]);
    return (gp * up) * q;
}

template <bool BASE_F32> struct EpiRes {
    static constexpr bool PREFETCH = false;
    const float* x; bf16* h; float* ss; unsigned char* h8; float sc;
    __device__ __forceinline__ void operator()(const f32x4 (&acc)[2][2][4][2], const pg8::Unit& u, int wr, int wc, int fr, int fq) const {
        const int row0 = u.pm * 256 + wr * 64 + fr, col0 = u.pn * 256 + wc * 32 + 8 * fq;
#pragma unroll
        for (int ai = 0; ai < 2; ++ai)
#pragma unroll
            for (int m = 0; m < 4; ++m) {
                const int row = row0 + ai * 128 + m * 16; float q = 0.f;
#pragma unroll
                for (int bj = 0; bj < 2; ++bj) {
                    f32x4 v0, v1; const size_t off = (size_t)row * D + col0 + bj * 128;
                    if constexpr (BASE_F32) { v0 = *(const f32x4*)(x + off); v1 = *(const f32x4*)(x + off + 4); }
                    else { const u32x4 w = *(const u32x4*)(h + off); v0 = (f32x4){bflo(w.x), bfhi(w.x), bflo(w.y), bfhi(w.y)}; v1 = (f32x4){bflo(w.z), bfhi(w.z), bflo(w.w), bfhi(w.w)}; }
                    v0 += acc[ai][bj][m][0] * sc; v1 += acc[ai][bj][m][1] * sc;
                    q += (v0[0] * v0[0] + v0[1] * v0[1]) + (v0[2] * v0[2] + v0[3] * v0[3]) + (v1[0] * v1[0] + v1[1] * v1[1]) + (v1[2] * v1[2] + v1[3] * v1[3]);
                    u32x4 o; o.x = cvt_pk_bf16(v0[0], v0[1]); o.y = cvt_pk_bf16(v0[2], v0[3]); o.z = cvt_pk_bf16(v1[0], v1[1]); o.w = cvt_pk_bf16(v1[2], v1[3]);
                    *(u32x4*)(h + off) = o;
                    if (h8) { u32x2 o8; o8.x = pk4_fp8(v0[0], v0[1], v0[2], v0[3]); o8.y = pk4_fp8(v1[0], v1[1], v1[2], v1[3]); *(u32x2*)(h8 + off) = o8; }
                }
                q += __shfl_xor(q, 16); q += __shfl_xor(q, 32);
                if (fq == 0) ss[(size_t)row * 16 + u.pn * 4 + wc] = q;
            }
    }
};
template <bool MOE, int LDO, bool O8 = MOE, bool W8 = MOE> struct EpiSwiGLU {
    static constexpr bool PREFETCH = true;
    bf16* act; RstdTable tab; const float* srstd; int mt0; int nmain; bf16* act2;
    __device__ __forceinline__ void prefetch(LAS unsigned char* lds, const pg8::Unit& u, unsigned ldsw, int lane) const {
        if constexpr (!MOE) { tab.update(lds, u); return; }
        const float* sp = srstd + (size_t)moe_tile(u.pm, mt0, nmain) * 256 + lane;
#pragma unroll
        for (int k = 0; k < 4; ++k) __builtin_amdgcn_global_load_lds((const unsigned*)(sp + k * 64), (LAS unsigned*)(lds + pg8::RSLOT_OFF + ldsw + k * 256), 4, 0, 0);
    }
    __device__ __forceinline__ void run(const f32x4 (&acc)[2][2][4][2], const pg8::Unit& u, int wr, int wc, int fr, int fq, LAS unsigned char* lds, unsigned ldsw) const {
        float rs[2][4];
        if constexpr (MOE) {
#pragma unroll
            for (int ai = 0; ai < 2; ++ai)
#pragma unroll
                for (int m = 0; m < 4; ++m) rs[ai][m] = *(const LAS float*)(lds + pg8::RSLOT_OFF + ldsw + (ai * 128 + wr * 64 + m * 16 + fr) * 4);
        } else tab.rows(lds, wr, fr, rs);
        body(acc, u, wr, wc, fr, fq, rs);
    }
    __device__ __forceinline__ void body(const f32x4 (&acc)[2][2][4][2], const pg8::Unit& u, int wr, int wc, int fr, int fq, const float (&rs)[2][4]) const {
        constexpr int ES = O8 ? 1 : 2;
        char* ob = (MOE && u.pm >= nmain) ? (char*)act2 + ((size_t)(u.pm - nmain) * 256 * LDO + (size_t)u.pn * 128) * ES : (char*)act + ((size_t)u.pm * 256 * LDO + (size_t)u.pn * 128) * ES;
        const unsigned vo = (unsigned)((wr * 64 + fr) * LDO + wc * 32 + 8 * fq) * (unsigned)ES;
#pragma unroll
        for (int ai = 0; ai < 2; ++ai)
#pragma unroll
            for (int m = 0; m < 4; ++m) {
                const float r = W8 ? rs[ai][m] * (1.0f / W8S_GU) : rs[ai][m];
                const float rg = r * -1.4426950408889634f, ru = r * (O8 ? -0.6931471805599453f * ACT8S : -0.6931471805599453f);
                const f32x4 s0 = silu4(acc[ai][0][m][0] * rg, acc[ai][1][m][0] * ru), s1 = silu4(acc[ai][0][m][1] * rg, acc[ai][1][m][1] * ru);
                if constexpr (O8) { u32x2 o; o.x = pk4_fp8(s0[0], s0[1], s0[2], s0[3]); o.y = pk4_fp8(s1[0], s1[1], s1[2], s1[3]);
                    *(u32x2*)(ob + (size_t)((ai * 128 + m * 16) * LDO) + vo) = o; }
                else {
                u32x4 o; o.x = cvt_pk_bf16(s0[0], s0[1]); o.y = cvt_pk_bf16(s0[2], s0[3]); o.z = cvt_pk_bf16(s1[0], s1[1]); o.w = cvt_pk_bf16(s1[2], s1[3]);
                *(u32x4*)(ob + (size_t)((ai * 128 + m * 16) * LDO * 2) + vo) = o; }
            }
    }
};
struct EpiQKV {
    static constexpr bool PREFETCH = true;
    bf16* Q; RstdTable tab; const float* rc; const float* rsn; float* kmean;
    __device__ __forceinline__ void prefetch(LAS unsigned char* lds, const pg8::Unit& u, unsigned ldsw, int lane) const { tab.update(lds, u); }
    __device__ __forceinline__ void run(const f32x4 (&acc)[2][2][4][2], const pg8::Unit& u, int wr, int wc, int fr, int fq, LAS unsigned char* lds, unsigned ldsw) const {
        const int row0 = u.pm * 256 + wr * 64 + fr; const int which = u.pn >> 2;
        bf16* O = Q + (size_t)which * ((WS_K - WS_Q) / 2);
        const int col0 = (u.pn & 3) * 256 + wc * 32 + 8 * fq;
        float rs[2][4]; tab.rows(lds, wr, fr, rs);
        f32x4 ks[2][2];
#pragma unroll
        for (int bj = 0; bj < 2; ++bj) { ks[bj][0] = (f32x4){0.f, 0.f, 0.f, 0.f}; ks[bj][1] = (f32x4){0.f, 0.f, 0.f, 0.f}; }
#pragma unroll
        for (int ai = 0; ai < 2; ++ai)
#pragma unroll
            for (int m = 0; m < 4; ++m) {
                const int row = row0 + ai * 128 + m * 16; const float r = QKV_FP8 ? rs[ai][m] * (1.0f / W8S_GU) : rs[ai][m];
                f32x4 cs = (f32x4){1.f, 1.f, 1.f, 1.f}, sn = (f32x4){0.f, 0.f, 0.f, 0.f};
                if (which < 2 && wc == 0) { const int pos = row & (SEQ - 1); cs = *(const f32x4*)(rc + pos * 16 + 4 * fq); sn = *(const f32x4*)(rsn + pos * 16 + 4 * fq); }
#pragma unroll
                for (int bj = 0; bj < 2; ++bj) {
                    f32x4 v0 = acc[ai][bj][m][0] * r, v1 = acc[ai][bj][m][1] * r;
                    if (which < 2 && wc == 0) { const f32x4 a = v0 * cs - v1 * sn, b = v1 * cs + v0 * sn; v0 = a; v1 = b; }
                    if (which == 1) { ks[bj][0] += v0; ks[bj][1] += v1; }
                    u32x4 o; o.x = cvt_pk_bf16(v0[0], v0[1]); o.y = cvt_pk_bf16(v0[2], v0[3]); o.z = cvt_pk_bf16(v1[0], v1[1]); o.w = cvt_pk_bf16(v1[2], v1[3]);
                    *(u32x4*)(O + (size_t)row * D + col0 + bj * 128) = o;
                }
            }
        if (which == 1) {
            const int b = u.pm >> 4, blk = u.pm & 15;
#pragma unroll
            for (int bj = 0; bj < 2; ++bj)
#pragma unroll
                for (int n = 0; n < 2; ++n) { f32x4 s = ks[bj][n];
#pragma unroll
                    for (int o = 1; o < 16; o <<= 1) { s[0] += __shfl_xor(s[0], o); s[1] += __shfl_xor(s[1], o); s[2] += __shfl_xor(s[2], o); s[3] += __shfl_xor(s[3], o); }
                    if (fr == 0) { const int head = (u.pn & 3) * 2 + bj; float* kp = kmean + ((size_t)(b * NH + head) * NBLK + blk) * HD + wc * 32 + 8 * fq + 4 * n;
                        atomicAdd(kp + 0, s[0]); atomicAdd(kp + 1, s[1]); atomicAdd(kp + 2, s[2]); atomicAdd(kp + 3, s[3]); } }
        }
    }
};
struct EpiMoeOut {
    static constexpr bool PREFETCH = false;
    unsigned char* Y; const int* sdst; const float* sgw; int mt0, nmain;
    __device__ __forceinline__ void operator()(const f32x4 (&acc)[2][2][4][2], const pg8::Unit& u, int wr, int wc, int fr, int fq) const {
        const int row0 = moe_tile(u.pm, mt0, nmain) * 256 + wr * 64 + fr, col0 = u.pn * 256 + wc * 32 + 8 * fq;
#pragma unroll
        for (int ai = 0; ai < 2; ++ai)
#pragma unroll
            for (int m = 0; m < 4; ++m) {
                const int sr = row0 + ai * 128 + m * 16; const int dst = sdst[sr]; const float g = sgw[sr] * (Y8S / (W8S_DN * ACT8S));
                if (dst >= 0) {
#pragma unroll
                    for (int bj = 0; bj < 2; ++bj) { const f32x4 v0 = acc[ai][bj][m][0] * g, v1 = acc[ai][bj][m][1] * g;
                        u32x2 o; o.x = pk4_fp8(v0[0], v0[1], v0[2], v0[3]); o.y = pk4_fp8(v1[0], v1[1], v1[2], v1[3]);
                        *(u32x2*)(Y + (size_t)dst * D + col0 + bj * 128) = o; }
                }
            }
    }
};

namespace att {
constexpr int KVBLK = 64, LDX = D;
constexpr float SCALE = 0.088388347648318440f, THR = 8.f;
constexpr size_t SHM_V = KVBLK * HD * 2, SHM_K = KVBLK * HD * 2, SHM_ATTN = 2 * SHM_V + 2 * SHM_K + NWAVES * 64 * 4;
#define KSWZ(row, colB) ((row) * 256 + ((colB) ^ (((row) & 7) << 4)))
#define SBAR() __builtin_amdgcn_sched_barrier(0)
__device__ __forceinline__ int crow(int r, int hi) { return (r & 3) + 8 * (r >> 2) + 4 * hi; }
__device__ __forceinline__ void partialSM(f32x16& p0, f32x16& p1, float& m_reg, float& mn, float& alpha) {
    constexpr float C = SCALE * 1.4426950408889634f;
    float pmax = p0[0];
#pragma unroll
    for (int r = 1; r < 16; ++r) pmax = fmaxf(pmax, p0[r]);
#pragma unroll
    for (int r = 0; r < 16; ++r) pmax = fmaxf(pmax, p1[r]);
    { auto rr = __builtin_amdgcn_permlane32_swap(__float_as_uint(pmax), __float_as_uint(pmax), false, false);
      pmax = fmaxf(__uint_as_float(rr[0]), __uint_as_float(rr[1])); }
    if (__builtin_expect(__all(pmax - m_reg <= THR / SCALE), 1)) { mn = m_reg; alpha = 1.f; }
    else { mn = fmaxf(m_reg, pmax); alpha = __builtin_amdgcn_exp2f((m_reg - mn) * C); m_reg = mn; }
    const float mnC = -mn * C;
#pragma unroll
    for (int r = 0; r < 16; ++r) p0[r] = fmaf(p0[r], C, mnC);
#pragma unroll
    for (int r = 0; r < 16; ++r) p1[r] = fmaf(p1[r], C, mnC);
#pragma unroll
    for (int r = 0; r < 16; ++r) p0[r] = __builtin_amdgcn_exp2f(p0[r]);
}
__device__ __forceinline__ void finishSM(f32x16& p0, f32x16& p1, float alpha, float& l_reg, bf16x8& pa0, bf16x8& pa1, bf16x8& pa2, bf16x8& pa3) {
#pragma unroll
    for (int r = 0; r < 16; ++r) p1[r] = __builtin_amdgcn_exp2f(p1[r]);
    float ps = 0;
#pragma unroll
    for (int r = 0; r < 16; ++r) ps += p0[r];
#pragma unroll
    for (int r = 0; r < 16; ++r) ps += p1[r];
    { auto rr = __builtin_amdgcn_permlane32_swap(__float_as_uint(ps), __float_as_uint(ps), false, false);
      ps = __uint_as_float(rr[0]) + __uint_as_float(rr[1]); }
    l_reg = l_reg * alpha + ps;
#define PK4(P, BASE, OUT) do { unsigned a0 = cvt_pk_bf16(P[BASE + 0], P[BASE + 1]), a1 = cvt_pk_bf16(P[BASE + 2], P[BASE + 3]);   \
    unsigned b0 = cvt_pk_bf16(P[BASE + 4], P[BASE + 5]), b1 = cvt_pk_bf16(P[BASE + 6], P[BASE + 7]);                              \
    auto r0 = __builtin_amdgcn_permlane32_swap(a0, b0, false, false); auto r1 = __builtin_amdgcn_permlane32_swap(a1, b1, false, false); \
    u32x4 w = {r0[0], r1[0], r0[1], r1[1]}; OUT = *reinterpret_cast<bf16x8*>(&w); } while (0)
    PK4(p0, 0, pa0); PK4(p0, 8, pa1); PK4(p1, 0, pa2); PK4(p1, 8, pa3);
#undef PK4
}
__device__ __forceinline__ void qkt(f32x16& p0, f32x16& p1, const char* Ks, const bf16x8* qr, int r32, int hi) {
    p0 = f32x16{}; p1 = f32x16{};
#pragma unroll
    for (int d0 = 0; d0 < 8; ++d0) { const int cb = (d0 * 16 + hi * 8) * 2;
        const bf16x8 b0 = *reinterpret_cast<const bf16x8*>(Ks + KSWZ(r32, cb));
        const bf16x8 b1 = *reinterpret_cast<const bf16x8*>(Ks + KSWZ(32 + r32, cb));
        p0 = __builtin_amdgcn_mfma_f32_32x32x16_bf16(b0, qr[d0], p0, 0, 0, 0);
        p1 = __builtin_amdgcn_mfma_f32_32x32x16_bf16(b1, qr[d0], p1, 0, 0, 0); }
}
__device__ __forceinline__ int v_st(int k, int c) { const int kk = (k & ~0xC) | ((k & 4) << 1) | ((k & 8) >> 1); return ((kk >> 3) * 4 + (c >> 5)) * 512 + ((kk & 7) * 32 + (c & 31)) * 2; }
__device__ __forceinline__ int v_rd_base(int lane) { return ((lane & 3) << 3) | (((lane >> 2) & 3) << 6) | (((lane >> 4) & 1) << 5) | (((lane >> 5) & 1) << 8); }
constexpr int v_rd_off(int d0, int ks, int half) { return d0 * 512 + ks * 4096 + half * 2048; }
template <int OFF> __device__ __forceinline__ s16x4 tr_read(int vb) {
    s16x4 r; asm volatile("ds_read_b64_tr_b16 %0, %1 offset:%2" : "=&v"(r) : "v"(vb), "i"(OFF) : "memory"); return r;
}
template <int D0, bool FIRST = false> __device__ __forceinline__ void pv_one(f32x16& od, int vb, bf16x8 pa0, bf16x8 pa1, bf16x8 pa2, bf16x8 pa3) {
    const s16x4 l0 = tr_read<v_rd_off(D0, 0, 0)>(vb), h0 = tr_read<v_rd_off(D0, 0, 1)>(vb), l1 = tr_read<v_rd_off(D0, 1, 0)>(vb), h1 = tr_read<v_rd_off(D0, 1, 1)>(vb);
    const s16x4 l2 = tr_read<v_rd_off(D0, 2, 0)>(vb), h2 = tr_read<v_rd_off(D0, 2, 1)>(vb), l3 = tr_read<v_rd_off(D0, 3, 0)>(vb), h3 = tr_read<v_rd_off(D0, 3, 1)>(vb);
    asm volatile("s_waitcnt lgkmcnt(0)" ::: "memory"); SBAR();
#define PK(L, H) (bf16x8){L[0], L[1], L[2], L[3], H[0], H[1], H[2], H[3]}
    if constexpr (FIRST) od = __builtin_amdgcn_mfma_f32_32x32x16_bf16(PK(l0, h0), pa0, f32x16{}, 0, 0, 0);
    else od = __builtin_amdgcn_mfma_f32_32x32x16_bf16(PK(l0, h0), pa0, od, 0, 0, 0);
    od = __builtin_amdgcn_mfma_f32_32x32x16_bf16(PK(l1, h1), pa1, od, 0, 0, 0);
    od = __builtin_amdgcn_mfma_f32_32x32x16_bf16(PK(l2, h2), pa2, od, 0, 0, 0);
    od = __builtin_amdgcn_mfma_f32_32x32x16_bf16(PK(l3, h3), pa3, od, 0, 0, 0);
#undef PK
}
template <bool FIRST = false> __device__ __forceinline__ void pv_d0(f32x16* o, int vb, bf16x8 pa0, bf16x8 pa1, bf16x8 pa2, bf16x8 pa3) {
    pv_one<0, FIRST>(o[0], vb, pa0, pa1, pa2, pa3); pv_one<1, FIRST>(o[1], vb, pa0, pa1, pa2, pa3); pv_one<2, FIRST>(o[2], vb, pa0, pa1, pa2, pa3); pv_one<3, FIRST>(o[3], vb, pa0, pa1, pa2, pa3);
}
constexpr int PROWS = 10752;
__device__ __forceinline__ int nsl_of(int i) { return i < 3 ? i : 3; }
__device__ __forceinline__ int rowoff_of(int i) { return 256 * (i <= 1 ? 0 : (i == 2 ? 1 : 3 * i - 6)); }

__device__ __forceinline__ void sel_load(const bf16* Qb, bf16x8 (&qr)[8]) {
    const int tid = threadIdx.x, wid = __builtin_amdgcn_readfirstlane(tid >> 6), lane = tid & 63, r32 = lane & 31, hi = lane >> 5;
    const char* Qc = (const char*)Qb; const unsigned qoff = (unsigned)((wid * 32 + r32) * LDX + hi * 8) * 2u;
#pragma unroll
    for (int d0 = 0; d0 < 8; ++d0) qr[d0] = *reinterpret_cast<const bf16x8*>(Qc + qoff + d0 * 32);
}
__device__ __forceinline__ void sel_unit(const bf16x8 (&qr)[8], const float* kmL  , unsigned short* selo  , int iblk) {
    const int tid = threadIdx.x, wid = __builtin_amdgcn_readfirstlane(tid >> 6), lane = tid & 63, r32 = lane & 31, hi = lane >> 5;
    unsigned sel = 0;
    float v1 = -__builtin_inff(), v2 = v1, v3 = v1; int i1 = -1, i2 = -1, i3 = -1;
#pragma unroll 1
    for (int n = 0; n < iblk; ++n) {
        float s = 0.f; const float* kp = kmL + n * 128 + hi * 8;
#pragma unroll
        for (int d0 = 0; d0 < 8; ++d0) { const f32x4 k0 = *(const f32x4*)(kp + d0 * 16), k1 = *(const f32x4*)(kp + d0 * 16 + 4); const bf16x8 q = qr[d0];
#pragma unroll
            for (int e = 0; e < 4; ++e) { s += __builtin_bit_cast(float, ((unsigned)(unsigned short)q[e]) << 16) * k0[e]; s += __builtin_bit_cast(float, ((unsigned)(unsigned short)q[4 + e]) << 16) * k1[e]; } }
        s += __shfl_xor(s, 32);
        if (s > v1) { v3 = v2; i3 = i2; v2 = v1; i2 = i1; v1 = s; i1 = n; }
        else if (s > v2) { v3 = v2; i3 = i2; v2 = s; i2 = n; }
        else if (s > v3) { v3 = s; i3 = n; }
    }
    if (i1 >= 0) sel |= 1u << i1; if (i2 >= 0) sel |= 1u << i2; if (i3 >= 0) sel |= 1u << i3;
    if (hi == 0) selo[wid * 32 + r32] = (unsigned short)sel;
}

__device__ __forceinline__ void tile_step(f32x16 (&o)[4], float& m_reg, float& l_reg, const char* Kt, int vb, bf16x8 (&qr)[8], int r32, int hi, float* al_l, bool do_mask, int thr, bool hasn, const char* Qbase, unsigned enext) {
    f32x16 p0, p1; qkt(p0, p1, Kt, qr, r32, hi); SBAR();
    if (do_mask && hasn) { const char* qnext = Qbase + (unsigned)((int)(enext & 4095u) * LDX + hi * 8) * 2u;
#pragma unroll
        for (int d0 = 0; d0 < 8; ++d0) qr[d0] = *reinterpret_cast<const bf16x8*>(qnext + d0 * 32); }
    if (do_mask) { const float ninf = -__builtin_inff(); asm volatile("" : "+v"(thr));
#pragma unroll
        for (int r = 0; r < 16; ++r) { const int c = (r & 3) + 8 * (r >> 2); p0[r] = (c <= thr) ? p0[r] : ninf; p1[r] = (c + 32 <= thr) ? p1[r] : ninf; } }
    float mn, alpha; partialSM(p0, p1, m_reg, mn, alpha);
    if (__any(alpha < 1.f)) {
#pragma unroll
        for (int d = 0; d < 4; ++d)
#pragma unroll
            for (int r = 0; r < 16; ++r) o[d][r] *= alpha; }
    bf16x8 pa0, pa1, pa2, pa3; finishSM(p0, p1, alpha, l_reg, pa0, pa1, pa2, pa3); SBAR();
    pv_d0(o, vb, pa0, pa1, pa2, pa3);
}

__device__ __forceinline__ void flash4(f32x16 (&o)[4], float& m_reg, float& l_reg, const char* K_lds, int vbase, bf16x8 (&qr)[8], int r32, int hi, bool hasn, const char* Qbase, unsigned enext) {
    f32x16 pA0, pA1, pB0, pB1; float mnA, mnB, alA, alB; bf16x8 pa0, pa1, pa2, pa3;
#define RESC1(a) do { if (__any((a) < 1.f)) { _Pragma("unroll") for (int d = 0; d < 4; ++d) _Pragma("unroll") for (int r = 0; r < 16; ++r) o[d][r] *= (a); } } while (0)
    qkt(pA0, pA1, K_lds, qr, r32, hi); partialSM(pA0, pA1, m_reg, mnA, alA);
    SBAR(); qkt(pB0, pB1, K_lds + 16384, qr, r32, hi); finishSM(pA0, pA1, alA, l_reg, pa0, pa1, pa2, pa3); SBAR();
    pv_d0<true>(o, vbase, pa0, pa1, pa2, pa3); partialSM(pB0, pB1, m_reg, mnB, alB); RESC1(alB);
    SBAR(); qkt(pA0, pA1, K_lds + 2 * 16384, qr, r32, hi); finishSM(pB0, pB1, alB, l_reg, pa0, pa1, pa2, pa3); SBAR();
    pv_d0(o, vbase + 16384, pa0, pa1, pa2, pa3); partialSM(pA0, pA1, m_reg, mnA, alA); RESC1(alA);
    SBAR(); qkt(pB0, pB1, K_lds + 3 * 16384, qr, r32, hi); SBAR();
    if (hasn) { const char* qnext = Qbase + (unsigned)((int)(enext & 4095u) * LDX + hi * 8) * 2u;
#pragma unroll
        for (int d0 = 0; d0 < 8; ++d0) qr[d0] = *reinterpret_cast<const bf16x8*>(qnext + d0 * 32); }
    finishSM(pA0, pA1, alA, l_reg, pa0, pa1, pa2, pa3); SBAR();
    pv_d0(o, vbase + 2 * 16384, pa0, pa1, pa2, pa3); partialSM(pB0, pB1, m_reg, mnB, alB); RESC1(alB);
    finishSM(pB0, pB1, alB, l_reg, pa0, pa1, pa2, pa3); SBAR();
    pv_d0(o, vbase + 3 * 16384, pa0, pa1, pa2, pa3);
#undef RESC1
}

__device__ __forceinline__ void kv_unit(const bf16* Qh, const bf16* Kh, const bf16* Vh, const unsigned short* selb, unsigned char* Oown, float* mlown, unsigned char* P, float* mlp, int j, char* lds, LAS unsigned char* ldsq) {
    const int tid = threadIdx.x, wid = __builtin_amdgcn_readfirstlane(tid >> 6), lane = tid & 63, r32 = lane & 31, hi = lane >> 5;
    char* K_lds = lds; char* V_lds = lds + 65536; char* xt = lds + XTRA_OFF;
    float* wsf = (float*)xt + wid * 64; float* li_l = wsf; float* al_l = wsf + 32;
    int* drow = (int*)(xt + 2048) + wid * 32;
    LAS int* cnt = (LAS int*)(ldsq + XTRA_OFF + 3072);
    LAS unsigned short* list = (LAS unsigned short*)(ldsq + XTRA_OFF + 3200);
    if (tid == 0) { int z_ = 0; asm volatile("" : "+v"(z_)); cnt[0] = z_; cnt[1] = z_; }
    int tid_s = threadIdx.x; asm volatile("" : "+v"(tid_s));
    const int sr = tid_s >> 4, sc = (tid_s & 15) * 8, vst0 = v_st(sr, sc), vst1 = v_st(32 + sr, sc);
    const unsigned ldoff0 = (unsigned)(sr * LDX + sc) * 2u, ldoff1 = ldoff0 + 32u * LDX * 2u;
    const char* kb = (const char*)Kh + (size_t)(j * 256) * (LDX * 2); const char* vbp = (const char*)Vh + (size_t)(j * 256) * (LDX * 2);
    bf16x8 kk[4][2], vv[4][2];
#pragma unroll
    for (int t = 0; t < 4; ++t) { const size_t to = (size_t)(t * 64) * (LDX * 2);
        kk[t][0] = *reinterpret_cast<const bf16x8*>(kb + to + ldoff0); kk[t][1] = *reinterpret_cast<const bf16x8*>(kb + to + ldoff1);
        vv[t][0] = *reinterpret_cast<const bf16x8*>(vbp + to + ldoff0); vv[t][1] = *reinterpret_cast<const bf16x8*>(vbp + to + ldoff1); }
    __syncthreads();
    {   unsigned sv[8];
#pragma unroll
        for (int k = 0; k < 8; ++k) { const int s = 256 * (j + 1) + k * 512 + tid_s; sv[k] = (s < SEQ) ? (unsigned)selb[s] : 0u; }
#pragma unroll
        for (int k = 0; k < 8; ++k) { const int s0 = 256 * (j + 1) + wid * 64 + k * 512;
            if (s0 < SEQ) { const int s = 256 * (j + 1) + k * 512 + tid_s; const unsigned v = sv[k];
                const bool hit = (v >> j) & 1u; const unsigned long long mk = __ballot(hit); const int nw = __builtin_popcountll(mk);
                int base = 0; if (lane == 0 && nw) base = __hip_atomic_fetch_add(&cnt[0], nw, __ATOMIC_RELAXED, __HIP_MEMORY_SCOPE_WORKGROUP);
                base = __builtin_amdgcn_readfirstlane(base);
                if (hit) list[base + __builtin_popcountll(mk & ((1ull << lane) - 1ull))] = (unsigned short)(s | (__builtin_popcount(v & ((1u << j) - 1u)) << 12)); } } }
#pragma unroll
    for (int t = 0; t < 4; ++t) { const int kc = sc * 2;
        *(bf16x8*)(K_lds + t * 16384 + KSWZ(sr, kc)) = kk[t][0]; *(bf16x8*)(K_lds + t * 16384 + KSWZ(32 + sr, kc)) = kk[t][1];
        *(bf16x8*)(V_lds + t * 16384 + vst0) = vv[t][0]; *(bf16x8*)(V_lds + t * 16384 + vst1) = vv[t][1]; }
    __syncthreads();
    const int n = cnt[0]; const int ngath = (n + 31) >> 5; const int ng = ngath + 8;
    const int vbase = (int)(uintptr_t)V_lds + v_rd_base(lane);
#define KV_TICKET(gv) do { int t_ = 0; if (lane == 0) t_ = __hip_atomic_fetch_add(&cnt[1], 1, __ATOMIC_RELAXED, __HIP_MEMORY_SCOPE_WORKGROUP); gv = __builtin_amdgcn_readfirstlane(t_); } while (0)
#define KV_META(gv, own_, wq_, e_, ntl_) do { own_ = (gv) >= ngath; wq_ = 7 - ((gv) - ngath);     \
        if (own_) { e_ = (unsigned)(256 * j + 32 * wq_ + r32) | 0x8000u; ntl_ = (wq_ >> 1) + 1; }          \
        else { const int idx_ = (gv) * 32 + r32; const bool v_ = idx_ < n; e_ = (unsigned)list[v_ ? idx_ : n - 1] | (v_ ? 0x8000u : 0u); ntl_ = 4; } } while (0)
#define KV_QOFF(e_) ((unsigned)((int)((e_) & 4095u) * LDX + hi * 8) * 2u)
#define KV_LOADQ(e_, q_) do { const char* Qc_ = (const char*)Qh; const unsigned qoff_ = KV_QOFF(e_); \
        _Pragma("unroll") for (int d0 = 0; d0 < 8; ++d0) q_[d0] = *reinterpret_cast<const bf16x8*>(Qc_ + qoff_ + d0 * 32); } while (0)
    int g; KV_TICKET(g);
    bool own = false; int wq = 0, ntl = 0; unsigned ecur = 0; bf16x8 qr[8];
    if (g < ng) { KV_META(g, own, wq, ecur, ntl); KV_LOADQ(ecur, qr); }
    while (g < ng) {
        int gn; KV_TICKET(gn);
        bool ownn = false; int wqn = 0, ntln = 0; unsigned enext = 0;
        const bool hasn = gn < ng;
        if (hasn) { KV_META(gn, ownn, wqn, enext, ntln); }
        float m_reg = -1e30f, l_reg = 0; f32x16 o[4];
        if (!own) flash4(o, m_reg, l_reg, K_lds, vbase, qr, r32, hi, hasn, (const char*)Qh, enext);
        else {
#pragma unroll
            for (int d = 0; d < 4; ++d) o[d] = f32x16{};
#pragma unroll 1
            for (int t = 0; t < ntl - 1; ++t)
                tile_step(o, m_reg, l_reg, K_lds + t * 16384, vbase + t * 16384, qr, r32, hi, al_l, false, 0, false, nullptr, 0u);
            { const int t = ntl - 1;
              tile_step(o, m_reg, l_reg, K_lds + t * 16384, vbase + t * 16384, qr, r32, hi, al_l, true, 32 * wq + r32 - 64 * t - 4 * hi, hasn, (const char*)Qh, enext); }
        }
        const float rl = __builtin_amdgcn_rcpf(l_reg);
        const int qs = (int)(ecur & 4095u), slot = (int)((ecur >> 12) & 3u); const bool valid = (ecur & 0x8000u) != 0u;
        char* rowp;
        if (own) { rowp = (char*)Oown + (size_t)qs * LDX; if (hi == 0) { float* mp = mlown + (size_t)qs * 2; mp[0] = m_reg; mp[1] = l_reg; } }
        else { const int i = qs >> 8; const int ns = nsl_of(i); const int prow = rowoff_of(i) + (qs & 255) * ns + slot; rowp = (char*)P + (size_t)prow * HD;
               if (hi == 0 && valid) { float* mp = mlp + (size_t)prow * 2; mp[0] = m_reg; mp[1] = l_reg; } }
        if (valid) { const float rs = rl * P8S;
#pragma unroll
            for (int d0 = 0; d0 < 4; ++d0)
#pragma unroll
                for (int kp = 0; kp < 2; ++kp) {
                    const unsigned a = pk4_fp8(o[d0][8 * kp + 0] * rs, o[d0][8 * kp + 1] * rs, o[d0][8 * kp + 2] * rs, o[d0][8 * kp + 3] * rs);
                    const unsigned b = pk4_fp8(o[d0][8 * kp + 4] * rs, o[d0][8 * kp + 5] * rs, o[d0][8 * kp + 6] * rs, o[d0][8 * kp + 7] * rs);
                    auto r = __builtin_amdgcn_permlane32_swap(a, b, false, false);
                    const u32x2 w = {r[0], r[1]};
                    *(u32x2*)(rowp + d0 * 32 + kp * 16 + hi * 8) = w; }
        }
        g = gn; own = ownn; wq = wqn; ecur = enext; ntl = ntln;
    }
#undef KV_TICKET
#undef KV_META
#undef KV_QOFF
#undef KV_LOADQ
    __syncthreads();
}
}

#define XB_TMO      128
#define XB_XCNT(j)  (256  + 64 * (j))
#define XB_XSUB(j)  (1280 + 64 * (j))
#define XB_XGEN(j)  (2304 + 64 * (j))
#define XB_TOP      3328
#define XB_TOPGEN   3392
#define XCD_BAR_WORDS 3456
#define XB_SPIN_CAP (1u << 18)
__device__ __forceinline__ unsigned xb_ld(unsigned* p)              { return __hip_atomic_load(p, __ATOMIC_RELAXED, __HIP_MEMORY_SCOPE_AGENT); }
__device__ __forceinline__ unsigned xb_add(unsigned* p, unsigned v) { return __hip_atomic_fetch_add(p, v, __ATOMIC_RELAXED, __HIP_MEMORY_SCOPE_AGENT); }
__device__ __forceinline__ unsigned xb_xcc_id() { return (unsigned)__builtin_amdgcn_s_getreg((3 << 11) | 20) & 0xFu; }
#define XB_SPIN(cond, bar) do { unsigned _sp = 0; while (cond) { __builtin_amdgcn_s_sleep(1); \
    if ((++_sp & 255u) == 0u) { if (xb_ld(&(bar)[XB_TMO])) break; if (_sp > XB_SPIN_CAP) { atomicAdd(&(bar)[XB_TMO], 1u); break; } } } } while (0)
struct XcdBarrier { unsigned* bar; unsigned x; volatile LAS unsigned* st; };
__device__ __forceinline__ XcdBarrier xcd_barrier_post(unsigned* bar, volatile LAS unsigned* st) {
    XcdBarrier b; b.bar = bar; b.x = xb_xcc_id(); b.st = st;
    if (threadIdx.x == 0) (void)xb_add(&bar[XB_XCNT(b.x)], 1u);
    return b;
}
__device__ __forceinline__ void xcd_barrier_complete(unsigned* bar, unsigned x, unsigned& nloc, unsigned& nx) {
    const unsigned G = gridDim.x * gridDim.y * gridDim.z;
    unsigned sum, cnt, mine, sp = 0u;
    for (;;) {
        sum = 0u; cnt = 0u; mine = 0u;
#pragma unroll
        for (unsigned j = 0; j < 16; ++j) { const unsigned c = xb_ld(&bar[XB_XCNT(j)]); sum += c; cnt += (c > 0u) ? 1u : 0u; mine = (j == x) ? c : mine; }
        if (sum == G) break;
        __builtin_amdgcn_s_sleep(1);
        if ((++sp & 255u) == 0u) { if (xb_ld(&bar[XB_TMO])) break; if (sp > XB_SPIN_CAP) { atomicAdd(&bar[XB_TMO], 1u); break; } }
    }
    nloc = mine > 0u ? mine : 1u; nx = cnt > 0u ? cnt : 1u;
}
__device__ __forceinline__ void xcd_barrier(const XcdBarrier& b) {
    asm volatile("s_waitcnt vmcnt(0)" ::: "memory");
    __syncthreads();
    if (threadIdx.x == 0) {
        unsigned* bar = b.bar;
        __builtin_amdgcn_s_waitcnt(0);
        unsigned nloc = b.st[0], nx = b.st[1];
        if (nloc == 0u) { xcd_barrier_complete(bar, b.x, nloc, nx); b.st[0] = nloc; b.st[1] = nx; }
        const unsigned old = xb_add(&bar[XB_XSUB(b.x)], 1u);
        const unsigned gen = old / nloc;
        if (old + 1u == (gen + 1u) * nloc) {
            __builtin_amdgcn_fence(__ATOMIC_RELEASE, "agent");
            asm volatile("s_waitcnt vmcnt(0)" ::: "memory");
            const unsigned og = xb_add(&bar[XB_TOP], 1u);
            const unsigned tg = og / nx;
            if (og + 1u == (tg + 1u) * nx) xb_add(&bar[XB_TOPGEN], 1u);
            else XB_SPIN(xb_ld(&bar[XB_TOPGEN]) == tg, bar);
            __builtin_amdgcn_fence(__ATOMIC_ACQUIRE, "agent");
            xb_add(&bar[XB_XGEN(b.x)], 1u);
            asm volatile("s_waitcnt vmcnt(0)" ::: "memory");
        } else {
            XB_SPIN(xb_ld(&bar[XB_XGEN(b.x)]) == gen, bar);
            __builtin_amdgcn_fence(__ATOMIC_ACQUIRE, "agent");
            asm volatile("s_waitcnt vmcnt(0)" ::: "memory");
        }
    }
    __syncthreads();
}

__constant__ double ROPE_C1[16] = {
    0.5403023058681398, 0.9045954518793624, 0.9812558362840286, 0.996355883049411, 0.9992929765482185, 0.9998628790459692, 0.9999734086383661, 0.9999948433117433,
    0.9999990000001666, 0.9999998060772615, 0.9999999623939693, 0.9999999927073353, 0.9999999985857865, 0.9999999997257518, 0.999999999946817, 0.9999999999896866};
__constant__ double ROPE_S1[16] = {
    0.8414709848078965, 0.4262711208130009, 0.19270958398204202, 0.08529334272279625, 0.0375971677311151, 0.01655968314629382, 0.007292600096474083, 0.0032114404746087437,
    0.0014142130909686214, 0.0006227723816580176, 0.00027424817223841217, 0.00012076973711788731, 5.31829589443792e-05, 2.3419998959268378e-05, 1.0313385377029628e-05, 4.541670480592256e-06};

__device__ __forceinline__ int sig32(int p) { return (p & 4) ? 16 + 4 * (p >> 3) + (p & 3) : 4 * (p >> 3) + (p & 3); }
__device__ __forceinline__ void tr_item(const float* src, int ldw, int k0, bf16* out, int K, const float* gk, const float* gn, bool sigma, LAS float* scr, int lane) {
    const int lr = lane >> 3, lc = (lane & 7) * 4;
#pragma unroll
    for (int i = 0; i < 8; ++i) { const int kk = 8 * i + lr; f32x4 v = *(const f32x4*)(src + (size_t)(k0 + kk) * ldw + lc); if (gk) v *= gk[k0 + kk];
        LAS float* d = scr + kk * 33 + lc; d[0] = v[0]; d[1] = v[1]; d[2] = v[2]; d[3] = v[3]; }
    LDS_WAIT(); asm volatile("" ::: "memory");
    const int c = lane & 7;
#pragma unroll
    for (int j = 0; j < 4; ++j) { const int n = (lane >> 3) + 8 * j; const int ns = sigma ? sig32(n) : n; const LAS float* s = scr + (8 * c) * 33 + ns; const float sc = gn ? gn[n] : 1.0f;
        u32x4 o; o.x = pk2(s[0 * 33] * sc, s[1 * 33] * sc); o.y = pk2(s[2 * 33] * sc, s[3 * 33] * sc); o.z = pk2(s[4 * 33] * sc, s[5 * 33] * sc); o.w = pk2(s[6 * 33] * sc, s[7 * 33] * sc);
        *(GAS u32x4*)(out + (size_t)n * K + k0 + 8 * c) = o; }
    LDS_WAIT(); asm volatile("" ::: "memory");
}

__device__ __forceinline__ void tr_load(const float* src, int ldw, int k0, int lane, f32x4 (&v)[8]) {
    const int lr = lane >> 3, lc = (lane & 7) * 4;
#pragma unroll
    for (int i = 0; i < 8; ++i) v[i] = __builtin_nontemporal_load((const GAS f32x4*)(src + (size_t)(k0 + 8 * i + lr) * ldw + lc));
}
__device__ __forceinline__ void tr_finish(const f32x4 (&v)[8], int k0, bf16* out, int K, const LAS float* gk, LAS float* scr, int lane) {
    const int lr = lane >> 3, lc = (lane & 7) * 4;
#pragma unroll
    for (int i = 0; i < 8; ++i) { LAS float* d = scr + (8 * i + lr) * 33 + lc; d[0] = v[i][0]; d[1] = v[i][1]; d[2] = v[i][2]; d[3] = v[i][3]; }
    LDS_WAIT(); asm volatile("" ::: "memory");
    const int c = lane & 7;
    f32x4 g0 = (f32x4){1.f, 1.f, 1.f, 1.f}, g1 = g0;
    if (gk) { g0 = *(const LAS f32x4*)(gk + k0 + 8 * c); g1 = *(const LAS f32x4*)(gk + k0 + 8 * c + 4); }
    float tv[4][8];
#pragma unroll
    for (int j = 0; j < 4; ++j) { const LAS float* s = scr + (8 * c) * 33 + (lane >> 3) + 8 * j;
#pragma unroll
        for (int e = 0; e < 8; ++e) tv[j][e] = s[e * 33]; }
    LDS_WAIT(); asm volatile("" ::: "memory");
#pragma unroll
    for (int j = 0; j < 4; ++j) { const int n = (lane >> 3) + 8 * j;
        u32x4 o; o.x = cvt_pk_bf16(tv[j][0] * g0[0], tv[j][1] * g0[1]); o.y = cvt_pk_bf16(tv[j][2] * g0[2], tv[j][3] * g0[3]); o.z = cvt_pk_bf16(tv[j][4] * g1[0], tv[j][5] * g1[1]); o.w = cvt_pk_bf16(tv[j][6] * g1[2], tv[j][7] * g1[3]);
        *(GAS u32x4*)(out + (size_t)n * K + k0 + 8 * c) = o; }
}

__device__ __forceinline__ void tr_finish8(const f32x4 (&v)[8], int k0, unsigned char* out, int Kb, const LAS float* gk, float sc, LAS float* scr, int lane, bool sigma = false) {
    const int lr = lane >> 3, lc = (lane & 7) * 4;
#pragma unroll
    for (int i = 0; i < 8; ++i) { LAS float* d = scr + (8 * i + lr) * 33 + lc; d[0] = v[i][0]; d[1] = v[i][1]; d[2] = v[i][2]; d[3] = v[i][3]; }
    LDS_WAIT(); asm volatile("" ::: "memory");
    const int c = lane & 7;
    f32x4 g0 = (f32x4){1.f, 1.f, 1.f, 1.f}, g1 = g0;
    if (gk) { g0 = *(const LAS f32x4*)(gk + k0 + 8 * c); g1 = *(const LAS f32x4*)(gk + k0 + 8 * c + 4); }
    g0 *= sc; g1 *= sc;
    float tv[4][8];
#pragma unroll
    for (int j = 0; j < 4; ++j) { const int n_ = (lane >> 3) + 8 * j; const LAS float* s = scr + (8 * c) * 33 + (sigma ? sig32(n_) : n_);
#pragma unroll
        for (int e = 0; e < 8; ++e) tv[j][e] = s[e * 33]; }
    LDS_WAIT(); asm volatile("" ::: "memory");
#pragma unroll
    for (int j = 0; j < 4; ++j) { const int n = (lane >> 3) + 8 * j;
        u32x2 o; o.x = pk4_fp8(tv[j][0] * g0[0], tv[j][1] * g0[1], tv[j][2] * g0[2], tv[j][3] * g0[3]); o.y = pk4_fp8(tv[j][4] * g1[0], tv[j][5] * g1[1], tv[j][6] * g1[2], tv[j][7] * g1[3]);
        *(GAS u32x2*)(out + (size_t)n * Kb + k0 + 8 * c) = o; }
}

#define rope_c ((float*)(unsigned char*)(wsp + WS_ROPE_C))
#define rope_s ((float*)(unsigned char*)(wsp + WS_ROPE_S))
#define kmean ((float*)(unsigned char*)(wsp + WS_KMEAN))
#define ss1 ((float*)(unsigned char*)(wsp + WS_SS1))
#define ss2 ((float*)(unsigned char*)(wsp + WS_SS2))
#define ss3 ((float*)(unsigned char*)(wsp + WS_SS3))
#define rstd3 ((float*)(unsigned char*)(wsp + WS_RSTD3))
#define gatew ((float*)(unsigned char*)(wsp + WS_GATEW))
#define ent ((unsigned*)(unsigned char*)(wsp + WS_ENT))
#define bcnt ((int*)(unsigned char*)(wsp + WS_BCNT))
#define soff ((unsigned*)(unsigned char*)(wsp + WS_SOFF))
#define srstd ((float*)(unsigned char*)(wsp + WS_SRSTD))
#define sdst ((int*)(unsigned char*)(wsp + WS_SDST))
#define sgw ((float*)(unsigned char*)(wsp + WS_SGW))
#define texp ((int*)(unsigned char*)(wsp + WS_TEXP))
#define w_pool ((bf16*)(unsigned char*)(wsp + WS_W_POOL))
#define w_qkv ((bf16*)(unsigned char*)(wsp + WS_W_QKV))
#define w_wo ((bf16*)(unsigned char*)(wsp + WS_W_WO))
#define w_fgu ((bf16*)(unsigned char*)(wsp + WS_W_FGU))
#define w_fd ((bf16*)(unsigned char*)(wsp + WS_W_FD))
#define w_mgu ((bf16*)(unsigned char*)(wsp + WS_W_MGU))
#define w_md ((bf16*)(unsigned char*)(wsp + WS_W_MD))
#define w_mgu8 ((unsigned char*)(wsp + WS_W_MGU))
#define w_md8 ((unsigned char*)(wsp + WS_W_MD))
#define h8buf ((unsigned char*)(wsp + WS_H8))
#define o8buf ((unsigned char*)(wsp + WS_Q))
#define h8abuf ((unsigned char*)(wsp + WS_PART))
#define hbuf ((bf16*)(unsigned char*)(wsp + WS_H))
#define pooled ((bf16*)(unsigned char*)(wsp + WS_POOLED))
#define fact ((bf16*)(unsigned char*)(wsp + WS_FACT))
#define qbuf ((bf16*)(unsigned char*)(wsp + WS_Q))
#define kbuf ((bf16*)(unsigned char*)(wsp + WS_K))
#define vbuf ((bf16*)(unsigned char*)(wsp + WS_V))
struct Args { const float* in[18]; float* out; unsigned char* ws; int ph_lo, ph_hi; };
constexpr int PH_P0 = 0, PH_POOL = 1, PH_FFN1 = 2, PH_FFN2 = 3, PH_QKV = 4, PH_SEL = 5, PH_KV = 6, PH_COMB = 7, PH_WO = 8, PH_ROUTE = 9, PH_LIST = 10, PH_MOE0 = 11, PH_FINAL = PH_MOE0 + MOE_STEPS, PH_COUNT = PH_FINAL + 1;

__global__ void __launch_bounds__(NWAVES * 64, 2) yoco_fwd(Args args) {
    extern __shared__ __attribute__((aligned(16))) unsigned char lds_raw[];
    LAS unsigned char* lds = (LAS unsigned char*)lds_raw;
    volatile LAS unsigned* MISC = (volatile LAS unsigned*)(lds + MISC_OFF);
    const int tid = threadIdx.x, lane = tid & 63, wave = __builtin_amdgcn_readfirstlane(tid >> 6);
    const int G = gridDim.x; const int bx = blockIdx.x; const int vcu = (G % 8 == 0) ? (bx % 8) * (G / 8) + bx / 8 : bx;
    unsigned char* ws = args.ws;
    unsigned* ctl = (unsigned*)(ws + WS_CTL);
    typedef const __attribute__((address_space(4))) Args* KArgs;
    KArgs kap = (KArgs)__builtin_amdgcn_kernarg_segment_ptr();
#define PIN_ARGS() asm volatile("" : "+s"(kap))
    GAS unsigned char* wsp = (GAS unsigned char*)ws;
#define obuf ((unsigned char*)kap->out)
#define y8buf ((unsigned char*)(wsp + WS_Y8))
    for (int u = tid; u < (LDS_BYTES - LDSCTL_OFF) / 4; u += NWAVES * 64) ((LAS unsigned*)(lds + LDSCTL_OFF))[u] = 0u;
    __syncthreads();
    const bool one_launch = (args.ph_hi - args.ph_lo) > 1;
    XcdBarrier bar; bar.bar = ctl + CW_BAR; bar.x = 0; bar.st = nullptr;
    if (one_launch) bar = xcd_barrier_post(ctl + CW_BAR, MISC + 8);
    const int lo = args.ph_lo, hi = args.ph_hi;
#ifndef PHMASK
#define PHMASK 0xffffffffu
#endif
#define IN(k) (((PHMASK >> ((k) < 31 ? (k) : 31)) & 1u) && lo <= (k) && (k) < hi)
#define SEAM(k) do { if (IN(k) && IN((k) + 1)) xcd_barrier(bar); } while (0)
    const int gw = vcu * NWAVES + wave, NGW = G * NWAVES;

#ifndef REP_P0
#define REP_P0 1
#endif
    for (int rep = 0; rep < REP_P0; ++rep) { if (rep) xcd_barrier(bar);
    if (IN(PH_P0)) {
        wsp = (GAS unsigned char*)ws; asm volatile("" : "+s"(wsp)); PIN_ARGS(); const float* x = kap->in[0]; const float* attn_norm = kap->in[1]; const float* ffn_norm = kap->in[2]; const float* pool_w = kap->in[3]; const float* pool_scale = kap->in[4]; const float* wq = kap->in[5]; const float* wo = kap->in[6]; const float* kv_norm = kap->in[7]; const float* wk = kap->in[8]; const float* wv = kap->in[9]; const float* fwg = kap->in[10]; const float* fwu = kap->in[11]; const float* fwd = kap->in[12];
        for (int i = bx * 512 + tid; i < SEQ * 16; i += G * 512) { const int s = i >> 4, d = i & 15; double c = 1.0, sn = 0.0, bc = ROPE_C1[d], bs = ROPE_S1[d];
            for (int b = 0; b < 12; ++b) { if ((s >> b) & 1) { const double nc = c * bc - sn * bs, ns = sn * bc + c * bs; c = nc; sn = ns; } const double nbc = bc * bc - bs * bs, nbs = 2.0 * bc * bs; bc = nbc; bs = nbs; }
            rope_c[i] = (float)c; rope_s[i] = (float)sn; }
        for (int i = bx * 512 + tid; i < NBATCH * NH * NBLK * HD; i += G * 512) kmean[i] = 0.f;
        {
            LAS float* rsl = (LAS float*)(lds + XTRA_OFF);
            for (int chunk = vcu; chunk < T / 128; chunk += G) {
                const int t0 = chunk * 128, p0 = t0 & (SEQ - 1);
                for (int r0 = wave; r0 < 143; r0 += 6 * NWAVES) {
                    float s6[6];
#pragma unroll
                    for (int q = 0; q < 6; ++q) { const int rr = r0 + q * NWAVES; const int t = t0 - 15 + rr; float s = 0.f;
                        if (rr < 143 && p0 + rr - 15 >= 0) { const GAS f32x4* xr = (const GAS f32x4*)(x + (size_t)t * D) + lane;
#pragma unroll
                            for (int j = 0; j < 4; ++j) { const f32x4 v = xr[64 * j]; s += (v[0] * v[0] + v[1] * v[1]) + (v[2] * v[2] + v[3] * v[3]); } }
                        s6[q] = s; }
#pragma unroll
                    for (int q = 0; q < 6; ++q) { const int rr = r0 + q * NWAVES; const float s = wave_sum(s6[q]); if (lane == 0 && rr < 143) rsl[rr] = 1.0f / sqrtf(s * (1.0f / D) + EPS); }
                }
                __syncthreads();
                const int tb = t0 + wave * 16;
                const int pb = tb & (SEQ - 1);
#pragma unroll
                for (int jh = 0; jh < 8; ++jh) {
                    const int j = jh >> 1, hh = jh & 1; const int w = 2 << j; const int tq = tb + 8 * hh, pq = pb + 8 * hh;
                    const f32x4 g = *(const f32x4*)(attn_norm + 256 * j + 4 * lane);
                    f32x4 v[23];
                    const char* xb = (const char*)x + ((size_t)(tq - 15) * D + 256 * j) * 4; const unsigned lo = (unsigned)lane * 16u;
#pragma unroll
                    for (int r = 0; r < 23; ++r) { const bool need = (r >= 16 - w) && (pq - 15 + r >= 0);
                        if (need) { const float rs = __builtin_bit_cast(float, __builtin_amdgcn_readfirstlane(__builtin_bit_cast(int, rsl[wave * 16 + 8 * hh + r]))); v[r] = *(const f32x4*)(xb + (size_t)r * (D * 4) + lo) * (rs * g); }
                        else v[r] = (f32x4){0.f, 0.f, 0.f, 0.f}; }
#pragma unroll
                    for (int i = 0; i < 8; ++i) { const int pos = pq + i; f32x4 S = v[15 + i];
#pragma unroll
                        for (int d = 1; d < w; ++d) S += v[15 + i - d];
                        const float inv = 1.0f / (float)(pos + 1 < w ? pos + 1 : w); const f32x4 o = S * inv - v[15 + i];
                        u32x2 pk; pk.x = pk2(o[0], o[1]); pk.y = pk2(o[2], o[3]); *(u32x2*)(pooled + (size_t)(tq + i) * D + 256 * j + 4 * lane) = pk; }
                    asm volatile("" ::: "memory");
                }
                __syncthreads();
            }
        }
        {
            LAS float* scr = (LAS float*)(lds + RING_OFF + wave * 16384);
            for (int it = gw; it < 128; it += NGW) { const int g = it >> 5, r = it & 31, kb = r >> 3, nb = r & 7;
                tr_item(pool_w + (size_t)g * 65536 + nb * 32, 256, kb * 64, w_pool + (size_t)(g * 256 + nb * 32) * 256, 256, nullptr, pool_scale + g * 256 + nb * 32, false, scr, lane); }
#if QKV_FP8
            LAS float* gq = (LAS float*)(lds + XTRA_OFF + 12288); LAS float* gkv = gq + D;
            for (int i = tid; i < D; i += NWAVES * 64) { gq[i] = attn_norm[D + i]; gkv[i] = kv_norm[i]; }
            __syncthreads();
#endif
            for (int it = gw; it < 1536; it += NGW) { const int which = it >> 9, r = it & 511, kb = r >> 5, nb = r & 31;
                const float* W = which == 0 ? wq : (which == 1 ? wk : wv);
#if QKV_FP8
                f32x4 b8[8]; tr_load(W + nb * 32, D, kb * 64, lane, b8); tr_finish8(b8, kb * 64, (unsigned char*)w_qkv + (size_t)(which * 1024 + nb * 32) * D, D, which == 0 ? gq : gkv, W8S_GU, scr, lane, which < 2 && (nb & 3) == 0); LDS_WAIT();
#else
                const float* gk = which == 0 ? attn_norm + D : kv_norm;
                tr_item(W + nb * 32, D, kb * 64, w_qkv + (size_t)(which * 1024 + nb * 32) * D, D, gk, nullptr, which < 2 && (nb & 3) == 0, scr, lane);
#endif
            }
            for (int it = gw; it < 512; it += NGW) { const int kb = it >> 5, nb = it & 31;
#if WO_FP8
                f32x4 b8[8]; tr_load(wo + nb * 32, D, kb * 64, lane, b8); tr_finish8(b8, kb * 64, (unsigned char*)w_wo + (size_t)(nb * 32) * D, D, nullptr, W8S_GU, scr, lane); LDS_WAIT();
#else
                tr_item(wo + nb * 32, D, kb * 64, w_wo + (size_t)(nb * 32) * D, D, nullptr, nullptr, false, scr, lane);
#endif
            }
#if FFN1_FP8
            LAS float* gk0 = (LAS float*)(lds + XTRA_OFF + 8192);
            for (int i = tid; i < D; i += NWAVES * 64) gk0[i] = ffn_norm[i];
            __syncthreads();
#endif
            for (int it = gw; it < 16 * 176; it += NGW) { const int kb = it / 176, nb = it % 176, n0 = nb * 32, pn = n0 >> 8, r = n0 & 255;
                const float* W = (r < 128 ? fwg : fwu) + pn * 128 + (r & 127);
#if FFN1_FP8
                f32x4 b8[8]; tr_load(W, FF, kb * 64, lane, b8); tr_finish8(b8, kb * 64, (unsigned char*)w_fgu + (size_t)n0 * D, D, gk0, W8S_GU, scr, lane); LDS_WAIT();
#else
                tr_item(W, FF, kb * 64, w_fgu + (size_t)n0 * D, D, ffn_norm, nullptr, false, scr, lane);
#endif
            }
            for (int it = gw; it < 44 * 32; it += NGW) { const int kb = it >> 5, nb = it & 31;
#if FFN2_FP8
                f32x4 b8[8]; tr_load(fwd + nb * 32, D, kb * 64, lane, b8); tr_finish8(b8, kb * 64, (unsigned char*)w_fd + (size_t)(nb * 32) * FF, FF, nullptr, W8S_DN, scr, lane); LDS_WAIT();
#else
                tr_item(fwd + nb * 32, D, kb * 64, w_fd + (size_t)(nb * 32) * FF, FF, nullptr, nullptr, false, scr, lane);
#endif
            }
        }
    }
    }
    SEAM(PH_P0);

    if (IN(PH_POOL)) {
        wsp = (GAS unsigned char*)ws; asm volatile("" : "+s"(wsp)); PIN_ARGS(); const float* x = kap->in[0];
        ProbDense pr{(const char*)pooled, (const char*)w_pool, 256, D, 512};
        pg8::StaticOrder S; S.init(T / 256, 4, G, bx);
        EpiRes<true> E{x, hbuf, ss1, FFN1_FP8 ? h8abuf : nullptr, 1.0f};
        pg8::gemm_phase(lds + RING_OFF, pr, S, E);
    }
    SEAM(PH_POOL);

#ifndef REP_FFN1
#define REP_FFN1 1
#endif
    for (int rep = 0; rep < REP_FFN1; ++rep) { if (rep) xcd_barrier(bar);
    if (IN(PH_FFN1)) {
        wsp = (GAS unsigned char*)ws; asm volatile("" : "+s"(wsp)); PIN_ARGS();
        ProbDenseT<FFN1_FP8 != 0> pr{FFN1_FP8 ? (const char*)h8abuf : (const char*)hbuf, (const char*)w_fgu, FFN1_FP8 ? D / 2 : D, FFN1_FP8 ? D / 2 : D, 0};
        pg8::StaticOrder S; S.init(T / 256, 2 * FF / 256, G, bx);
        EpiSwiGLU<false, FF, FFN2_FP8 != 0, FFN1_FP8 != 0> E{fact, RstdTable{ss1, -1, 0}, nullptr, 0, 1 << 30, nullptr};
        pg8::gemm_phase(lds + RING_OFF, pr, S, E);
    }
    }
    SEAM(PH_FFN1);

    if (IN(PH_FFN2)) {
        wsp = (GAS unsigned char*)ws; asm volatile("" : "+s"(wsp)); PIN_ARGS();
        ProbDenseT<FFN2_FP8 != 0> pr{(const char*)fact, (const char*)w_fd, FFN2_FP8 ? FF / 2 : FF, FFN2_FP8 ? FF / 2 : FF, 0};
        pg8::StaticOrder S; S.init(T / 256, 4, G, bx);
        EpiRes<false> E{nullptr, hbuf, ss2, QKV_FP8 ? h8abuf : nullptr, FFN2_FP8 ? 1.0f / (W8S_DN * ACT8S) : 1.0f};
        pg8::gemm_phase(lds + RING_OFF, pr, S, E);
    }
    SEAM(PH_FFN2);

    if (IN(PH_QKV)) {
        wsp = (GAS unsigned char*)ws; asm volatile("" : "+s"(wsp)); PIN_ARGS();
        ProbDenseT<QKV_FP8 != 0> pr{QKV_FP8 ? (const char*)h8abuf : (const char*)hbuf, (const char*)w_qkv, QKV_FP8 ? D / 2 : D, QKV_FP8 ? D / 2 : D, 0};
        pg8::StaticOrder S; S.init(T / 256, 12, G, bx);
        EpiQKV E{qbuf, RstdTable{ss2, -1, 0}, rope_c, rope_s, kmean};
        pg8::gemm_phase(lds + RING_OFF, pr, S, E);
    }
    SEAM(PH_QKV);

#ifndef REP_SEL
#define REP_SEL 1
#endif
    for (int rep = 0; rep < REP_SEL; ++rep) { if (rep) xcd_barrier(bar);
    if (IN(PH_SEL)) {
        wsp = (GAS unsigned char*)ws; asm volatile("" : "+s"(wsp)); PIN_ARGS();
        unsigned short* selbuf = (unsigned short*)((unsigned char*)(wsp + WS_SEL));
        float* kmL = (float*)((char*)lds_raw + XTRA_OFF + 4096);
        for (int v2 = vcu; v2 < 256; v2 += G) {
            const int bh = v2 >> 2, s4 = v2 & 3, b = bh >> 3, h = bh & 7;
            bf16x8 q4[4][8];
#pragma unroll
            for (int k = 0; k < 4; ++k) att::sel_load(qbuf + ((size_t)(b * SEQ + (4 * s4 + k) * 256)) * D + h * HD, q4[k]);
            *(f32x4*)(kmL + tid * 4) = *(const f32x4*)((const char*)(kmean + (size_t)bh * NBLK * HD) + (unsigned)tid * 16u);
            __syncthreads();
#pragma unroll
            for (int k = 0; k < 4; ++k) att::sel_unit(q4[k], kmL, selbuf + (size_t)bh * SEQ + (4 * s4 + k) * 256, 4 * s4 + k);
            __syncthreads();
        }
    }
    }
    SEAM(PH_SEL);

#ifndef REP_KV
#define REP_KV 1
#endif
    for (int rep = 0; rep < REP_KV; ++rep) { if (rep) xcd_barrier(bar);
    if (IN(PH_KV)) {
        wsp = (GAS unsigned char*)ws; asm volatile("" : "+s"(wsp)); PIN_ARGS();
        const bool convfirst = (G == 256) && bx >= G - CONV_WGS;
        auto conv_pass = [&]() {
            wsp = (GAS unsigned char*)ws; asm volatile("" : "+s"(wsp)); PIN_ARGS();
            int tid_c = threadIdx.x; asm volatile("" : "+v"(tid_c)); const int tid = tid_c;
            const float* ffn_norm = kap->in[2]; const float* mwg = kap->in[14]; const float* mwu = kap->in[15]; const float* mwd = kap->in[16];
            constexpr int N_GU = NE * 16 * 224, N_DN = NE * 56 * 32, TK_ITEMS = 64;
            LAS float* scr = (LAS float*)(lds + RING_OFF + wave * 16384); int lane_c = threadIdx.x; asm volatile("" : "+v"(lane_c)); lane_c &= 63;
            LAS float* gkL = (LAS float*)(lds + XTRA_OFF + 16384);
            LAS int* tkL = (LAS int*)(lds + XTRA_OFF + 20480);
            for (int i = tid; i < D; i += NWAVES * 64) gkL[i] = ffn_norm[D + i];
#define MOE_ITEM(it_, S_, L_, K0_, O_, KK_, G_) do { if ((it_) < N_GU) { const int e_ = (it_) / (16 * 224), r2_ = (it_) % (16 * 224), kb_ = r2_ / 224, nb_ = r2_ % 224, n0_ = nb_ * 32, pn_ = n0_ >> 8, r_ = n0_ & 255; \
        S_ = (r_ < 128 ? mwg : mwu) + (size_t)e_ * D * FE + pn_ * 128 + (r_ & 127); L_ = FE; K0_ = kb_ * 64; O_ = w_mgu8 + ((size_t)e_ * 2 * FE + n0_) * D; KK_ = D; G_ = gkL; } \
    else { const int i2_ = (it_) - N_GU; const int e_ = i2_ / (56 * 32), r2_ = i2_ % (56 * 32), kb_ = r2_ >> 5, nb_ = r2_ & 31; \
        S_ = mwd + (size_t)e_ * FE * D + nb_ * 32; L_ = D; K0_ = kb_ * 64; O_ = w_md8 + ((size_t)e_ * D + nb_ * 32) * FE; KK_ = FE; G_ = nullptr; } } while (0)
            for (;;) {
                __syncthreads();
                if (tid == 0) tkL[0] = (int)__hip_atomic_fetch_add(ctl + CW_CONVQ, 1u, RLX_AGENT);
                __syncthreads();
                const int tk = tkL[0];
                if (tk * TK_ITEMS >= N_GU + N_DN) break;
                const int i0 = tk * TK_ITEMS + wave * 8;
                const float sc = (tk * TK_ITEMS < N_GU) ? W8S_GU : W8S_DN;
                f32x4 bA[8], bB[8], bC[8]; const float* sA; const float* sB; const float* sC; int lA, lB, lC, kA, kB, kC, KA, KB, KC; unsigned char* oA; unsigned char* oB; unsigned char* oC; const LAS float* gA; const LAS float* gB; const LAS float* gC;
                MOE_ITEM(i0, sA, lA, kA, oA, KA, gA); tr_load(sA, lA, kA, lane_c, bA);
                MOE_ITEM(i0 + 1, sB, lB, kB, oB, KB, gB); tr_load(sB, lB, kB, lane_c, bB);
                MOE_ITEM(i0 + 2, sC, lC, kC, oC, KC, gC); tr_load(sC, lC, kC, lane_c, bC);
                tr_finish8(bA, kA, oA, KA, gA, sc, scr, lane_c); MOE_ITEM(i0 + 3, sA, lA, kA, oA, KA, gA); tr_load(sA, lA, kA, lane_c, bA);
                tr_finish8(bB, kB, oB, KB, gB, sc, scr, lane_c); MOE_ITEM(i0 + 4, sB, lB, kB, oB, KB, gB); tr_load(sB, lB, kB, lane_c, bB);
                tr_finish8(bC, kC, oC, KC, gC, sc, scr, lane_c); MOE_ITEM(i0 + 5, sC, lC, kC, oC, KC, gC); tr_load(sC, lC, kC, lane_c, bC);
                tr_finish8(bA, kA, oA, KA, gA, sc, scr, lane_c); MOE_ITEM(i0 + 6, sA, lA, kA, oA, KA, gA); tr_load(sA, lA, kA, lane_c, bA);
                tr_finish8(bB, kB, oB, KB, gB, sc, scr, lane_c); MOE_ITEM(i0 + 7, sB, lB, kB, oB, KB, gB); tr_load(sB, lB, kB, lane_c, bB);
                tr_finish8(bC, kC, oC, KC, gC, sc, scr, lane_c);
                tr_finish8(bA, kA, oA, KA, gA, sc, scr, lane_c);
                tr_finish8(bB, kB, oB, KB, gB, sc, scr, lane_c);
            }
#undef MOE_ITEM
            __syncthreads();
        };
        if (convfirst) conv_pass();
        {
            wsp = (GAS unsigned char*)ws; asm volatile("" : "+s"(wsp)); PIN_ARGS();
            const unsigned short* selbuf = (const unsigned short*)((unsigned char*)(wsp + WS_SEL));
            unsigned char* part = (unsigned char*)(wsp + WS_PART); float* mlp = (float*)((unsigned char*)(wsp + WS_MLP)); float* mlown = (float*)((unsigned char*)(wsp + WS_MLOWN));
            const int xq = bx & 7; unsigned* kvq = ctl + CW_KVQ + (rep * 8 + xq) * 64;
            LAS int* tkq = (LAS int*)(lds + XTRA_OFF + 3088);
            for (;;) {
                if (tid == 0) tkq[0] = (int)__hip_atomic_fetch_add(kvq, 1u, RLX_AGENT);
                __syncthreads();
                const int tk = tkq[0];
                if (tk >= 128) break;
                const int jb = tk >> 3, bh = 8 * xq + (tk & 7), b = bh >> 3, h = bh & 7;
                const size_t hb = (size_t)b * SEQ * D + h * HD;
                att::kv_unit(qbuf + hb, kbuf + hb, vbuf + hb, selbuf + (size_t)bh * SEQ, obuf + hb, mlown + (size_t)bh * SEQ * 2, part + (size_t)bh * att::PROWS * HD, mlp + (size_t)bh * att::PROWS * 2, jb,
                             (char*)lds_raw + RING_OFF, lds + RING_OFF);
            }
            __syncthreads();
        }
        if (!convfirst) conv_pass();
    }
    }
    SEAM(PH_KV);

    if (IN(PH_COMB)) {
        wsp = (GAS unsigned char*)ws; asm volatile("" : "+s"(wsp)); PIN_ARGS();
        const unsigned char* part = (const unsigned char*)(wsp + WS_PART); const float* mlp = (const float*)((unsigned char*)(wsp + WS_MLP)); const float* mlown = (const float*)((unsigned char*)(wsp + WS_MLOWN));
        constexpr float C = att::SCALE * 1.4426950408889634f;
        constexpr int NIT = T * NH * 16;
        const int stride = G * 512;
#pragma unroll 1
        for (int base = vcu * 512 + tid; base < NIT; base += 4 * stride) {
            u32x2 ow[4]; u32x2 pw[4][3]; float m0[4], l0[4], mk[4][3], lk[4][3]; int nsv[4]; size_t opv[4];
#pragma unroll
            for (int u = 0; u < 4; ++u) {
                const int idx = base + u * stride; const int c8 = idx & 15; const int qh = idx >> 4; const int h = qh & 7, tq = qh >> 3, b = tq >> 12, s = tq & (SEQ - 1), i = s >> 8, ns = att::nsl_of(i), bh = b * NH + h;
                opv[u] = (size_t)tq * D + h * HD + c8 * 8; nsv[u] = ns;
                ow[u] = *(const u32x2*)(obuf + opv[u]);
                const f32x2 ml0 = *(const f32x2*)(mlown + ((size_t)bh * SEQ + s) * 2); m0[u] = ml0[0]; l0[u] = ml0[1];
                const size_t prow = (size_t)bh * att::PROWS + att::rowoff_of(i) + (s & 255) * ns;
#pragma unroll
                for (int k = 0; k < 3; ++k) { const size_t pr = prow + (k < ns ? k : 0);
                    const f32x2 mlk = *(const f32x2*)(mlp + pr * 2); mk[u][k] = mlk[0]; lk[u][k] = mlk[1]; pw[u][k] = *(const u32x2*)(part + pr * HD + c8 * 8); }
            }
#pragma unroll
            for (int u = 0; u < 4; ++u) {
                float M = m0[u];
#pragma unroll
                for (int k = 0; k < 3; ++k) if (k < nsv[u]) M = fmaxf(M, mk[u][k]);
                const float w0 = l0[u] * __builtin_amdgcn_exp2f((m0[u] - M) * C); float W = w0;
                float acc[8]; { float f0[4], f1[4]; up4_fp8(ow[u].x, f0); up4_fp8(ow[u].y, f1); const float ws0 = w0 * (1.0f / P8S);
                    acc[0] = f0[0] * ws0; acc[1] = f0[1] * ws0; acc[2] = f0[2] * ws0; acc[3] = f0[3] * ws0; acc[4] = f1[0] * ws0; acc[5] = f1[1] * ws0; acc[6] = f1[2] * ws0; acc[7] = f1[3] * ws0; }
#pragma unroll
                for (int k = 0; k < 3; ++k) { const float wk = (k < nsv[u]) ? lk[u][k] * __builtin_amdgcn_exp2f((mk[u][k] - M) * C) : 0.f; W += wk; const u32x2 p = pw[u][k];
                    float f0[4], f1[4]; up4_fp8(p.x, f0); up4_fp8(p.y, f1); const float ws = wk * (1.0f / P8S);
                    acc[0] += f0[0] * ws; acc[1] += f0[1] * ws; acc[2] += f0[2] * ws; acc[3] += f0[3] * ws; acc[4] += f1[0] * ws; acc[5] += f1[1] * ws; acc[6] += f1[2] * ws; acc[7] += f1[3] * ws; }
                const float iw = (WO_FP8 ? O8S : 1.0f) / W;
                u32x4 o; o.x = cvt_pk_bf16(acc[0] * iw, acc[1] * iw); o.y = cvt_pk_bf16(acc[2] * iw, acc[3] * iw); o.z = cvt_pk_bf16(acc[4] * iw, acc[5] * iw); o.w = cvt_pk_bf16(acc[6] * iw, acc[7] * iw);
#if WO_FP8
                { u32x2 o8; o8.x = pk4_fp8(acc[0] * iw, acc[1] * iw, acc[2] * iw, acc[3] * iw); o8.y = pk4_fp8(acc[4] * iw, acc[5] * iw, acc[6] * iw, acc[7] * iw); *(u32x2*)(o8buf + opv[u]) = o8; }
#else
                *(u32x4*)opv[u] = o;
#endif
            }
        }
    }
    SEAM(PH_COMB);

    if (IN(PH_WO)) {
        wsp = (GAS unsigned char*)ws; asm volatile("" : "+s"(wsp)); PIN_ARGS();
        ProbDenseT<WO_FP8 != 0> pr{WO_FP8 ? (const char*)o8buf : (const char*)obuf, (const char*)w_wo, WO_FP8 ? D / 2 : D, WO_FP8 ? D / 2 : D, 0};
        pg8::StaticOrder S; S.init(T / 256, 4, G, bx);
        EpiRes<false> E{nullptr, hbuf, ss3, h8buf, WO_FP8 ? 1.0f / (W8S_GU * O8S) : 1.0f};
        pg8::gemm_phase(lds + RING_OFF, pr, S, E);
    }
    SEAM(PH_WO);

    if (IN(PH_ROUTE)) {
        wsp = (GAS unsigned char*)ws; asm volatile("" : "+s"(wsp)); PIN_ARGS(); const float* ffn_norm = kap->in[2]; const float* router_w = kap->in[13];
        LAS unsigned* entL = (LAS unsigned*)(lds + XTRA_OFF);
        LAS unsigned* rankL = entL + 256;
        int lane_r = threadIdx.x; asm volatile("" : "+v"(lane_r) :: "memory"); lane_r &= 63;
        float wr_[16][8];
#pragma unroll
        for (int j = 0; j < 16; ++j) { const int k = (j < 8) ? 8 * lane_r + j : 512 + 8 * lane_r + (j - 8); const float gk = ffn_norm[D + k];
            const f32x4 a = *(const f32x4*)(router_w + (size_t)k * 8), b2 = *(const f32x4*)(router_w + (size_t)k * 8 + 4);
            wr_[j][0] = a[0] * gk; wr_[j][1] = a[1] * gk; wr_[j][2] = a[2] * gk; wr_[j][3] = a[3] * gk; wr_[j][4] = b2[0] * gk; wr_[j][5] = b2[1] * gk; wr_[j][6] = b2[2] * gk; wr_[j][7] = b2[3] * gk; }
        for (int chunk = vcu; chunk < T / 128; chunk += G) {
            const int t0 = chunk * 128;
            for (int i0 = 0; i0 < 16; i0 += 4) {
                float lg[4][8], sq4[4];
#pragma unroll
                for (int q = 0; q < 4; ++q) { const int t = t0 + wave * 16 + i0 + q;
                    const u32x4 h0 = *(const u32x4*)(hbuf + (size_t)t * D + 8 * lane_r), h1 = *(const u32x4*)(hbuf + (size_t)t * D + 512 + 8 * lane_r);
                    const float hv[16] = {bflo(h0.x), bfhi(h0.x), bflo(h0.y), bfhi(h0.y), bflo(h0.z), bfhi(h0.z), bflo(h0.w), bfhi(h0.w), bflo(h1.x), bfhi(h1.x), bflo(h1.y), bfhi(h1.y), bflo(h1.z), bfhi(h1.z), bflo(h1.w), bfhi(h1.w)};
#pragma unroll
                    for (int e = 0; e < 8; ++e) { float s = 0.f;
#pragma unroll
                        for (int j = 0; j < 16; ++j) s += hv[j] * wr_[j][e];
                        lg[q][e] = s; }
                    sq4[q] = (lane_r < 16) ? ss3[(size_t)t * 16 + lane_r] : 0.f; }
#pragma unroll
                for (int q = 0; q < 4; ++q) {
#pragma unroll
                    for (int e = 0; e < 8; ++e) lg[q][e] = wave_sum(lg[q][e]);
                    sq4[q] = wave_sum(sq4[q]); }
#pragma unroll
                for (int q = 0; q < 4; ++q) { const int tl = wave * 16 + i0 + q, t = t0 + tl;
                    const float rstd = 1.0f / sqrtf(sq4[q] * (1.0f / D) + EPS);
                    int i1 = 0; float v1 = lg[q][0];
#pragma unroll
                    for (int e = 1; e < 8; ++e) if (lg[q][e] > v1) { v1 = lg[q][e]; i1 = e; }
                    int i2 = -1; float v2 = -__builtin_inff();
#pragma unroll
                    for (int e = 0; e < 8; ++e) if (e != i1 && lg[q][e] > v2) { v2 = lg[q][e]; i2 = e; }
                    const float w1 = 1.0f / (1.0f + __expf((v2 - v1) * rstd));
                    if (lane_r == 0) { entL[tl * 2] = (unsigned)i1; entL[tl * 2 + 1] = (unsigned)i2; gatew[(size_t)t * 2] = w1; gatew[(size_t)t * 2 + 1] = 1.0f - w1; rstd3[t] = rstd; } }
            }
            __syncthreads();
            if (tid < 8) { unsigned c = 0; for (int j = 0; j < 256; ++j) if (entL[j] == (unsigned)tid) { rankL[j] = c; ++c; } bcnt[chunk * 8 + tid] = (int)c; }
            __syncthreads();
            if (tid < 256) ent[(size_t)t0 * 2 + tid] = entL[tid] | (rankL[tid] << 8);
            __syncthreads();
        }
    }
    SEAM(PH_ROUTE);

    if (IN(PH_LIST)) {
        wsp = (GAS unsigned char*)ws; asm volatile("" : "+s"(wsp)); PIN_ARGS();
        LAS int* cntL = (LAS int*)(lds + XTRA_OFF);
        LAS int* baseL = cntL + 2048;
        for (int chunk = vcu; chunk < T / 128; chunk += G) {
            for (int i = tid; i < 2048; i += 512) cntL[i] = bcnt[i];
            __syncthreads();
            if (tid < 8) { int tot = 0, pre = 0; for (int v2 = 0; v2 < 256; ++v2) { if (v2 == chunk) pre = tot; tot += cntL[v2 * 8 + tid]; } baseL[tid] = pre; baseL[16 + tid] = tot; }
            __syncthreads();
            if (tid == 0) { int seg = 0; for (int e = 0; e < 8; ++e) { baseL[8 + e] = seg; seg += (baseL[16 + e] + 255) & ~255; } baseL[24] = seg; }
            __syncthreads();
            if (tid < 256) { const unsigned en = ent[(size_t)chunk * 256 + tid]; const int e = en & 255, rk = en >> 8; const int t = chunk * 128 + (tid >> 1);
                const int pos = baseL[8 + e] + baseL[e] + rk;
                soff[pos] = (unsigned)t * D; srstd[pos] = rstd3[t]; sdst[pos] = t * 2 + (tid & 1); sgw[pos] = gatew[(size_t)t * 2 + (tid & 1)]; }
            if (chunk < 8) { const int e = chunk; const int tot = baseL[16 + e], seg = baseL[8 + e]; for (int p = tot + tid; p < ((tot + 255) & ~255); p += 512) { soff[seg + p] = 0u; srstd[seg + p] = 0.f; sdst[seg + p] = -1; sgw[seg + p] = 0.f; } }
            if (chunk == 0) { const int ntl = baseL[24] >> 8; for (int mt = tid; mt < ntl; mt += 512) { int e = 0; for (int q = 1; q < 8; ++q) if (mt * 256 >= baseL[8 + q]) e = q; texp[mt] = e; } if (tid == 0) ctl[CW_NTILES] = (unsigned)ntl; }
            __syncthreads();
        }
    }
    SEAM(PH_LIST);

#ifndef REP_G1
#define REP_G1 1
#endif
#ifndef REP_G2
#define REP_G2 1
#endif
#ifndef REP_MOE
#define REP_MOE 1
#endif
    for (int rep = 0; rep < REP_MOE; ++rep) { if (rep) xcd_barrier(bar);
#pragma unroll 1
    for (int st = 0; st < MOE_STEPS; ++st) {
        if (IN(PH_MOE0 + st)) {
            wsp = (GAS unsigned char*)ws; asm volatile("" : "+s"(wsp)); PIN_ARGS(); const float* mwd = kap->in[16];
            const int ntiles = (int)__hip_atomic_load(ctl + CW_NTILES, RLX_AGENT);
            const int nrem = ntiles > 256 ? ntiles - 256 : 0;
            bf16* act2 = (bf16*)(unsigned char*)(wsp + WS_ACT2);
            LAS int* texpL = (LAS int*)(lds + XTRA_OFF + 16384);
            { int tm_ = threadIdx.x; asm volatile("" : "+v"(tm_)); for (int i = tm_; i < MOE_TILES_MAX; i += NWAVES * 64) texpL[i] = texp[i]; }
            __syncthreads();
#ifndef MOE_NO_G2
            if (st >= 1) { const int c = st - 1; const int nM = CHUNK_TILES + (c == 0 ? nrem : 0);
                ProbMoeG2 pr{(const char*)(unsigned char*)(wsp + ((c & 1) ? WS_ACT1 : WS_ACT0)), (const char*)act2, (const char*)w_md8, FE / 2, FE / 2, texpL, c * CHUNK_TILES, CHUNK_TILES};
                pg8::StaticOrder S; S.init(nM, 4, G, bx);
                EpiMoeOut E{y8buf, sdst, sgw, c * CHUNK_TILES, CHUNK_TILES};
                for (int r2 = 0; r2 < REP_G2; ++r2) pg8::gemm_phase(lds + RING_OFF, pr, S, E); }
#endif
#ifndef MOE_NO_G1
            if (st < MOE_STEPS - 1) { const int c = st; const int nM = CHUNK_TILES + (c == 0 ? nrem : 0);
                ProbMoeG1 pr{(const char*)h8buf, (const char*)w_mgu8, D / 2, D / 2, soff, texpL, c * CHUNK_TILES, CHUNK_TILES};
                EpiSwiGLU<true, FE> E{(bf16*)(unsigned char*)(wsp + ((c & 1) ? WS_ACT1 : WS_ACT0)), RstdTable{nullptr, -1, 0}, srstd, c * CHUNK_TILES, CHUNK_TILES, act2};
                if (st == 1 && nrem > 0 && G == 256) { SkewOrder S; S.init(nM, 2 * FE / 256, G, bx); S.e = 4 * nrem; pg8::gemm_phase(lds + RING_OFF, pr, S, E); }
                else { pg8::StaticOrder S; S.init(nM, 2 * FE / 256, G, bx); for (int r1 = 0; r1 < REP_G1; ++r1) pg8::gemm_phase(lds + RING_OFF, pr, S, E); } }
#endif
        }
        SEAM(PH_MOE0 + st);
    }
    }

    if (IN(PH_FINAL)) {
        wsp = (GAS unsigned char*)ws; asm volatile("" : "+s"(wsp)); PIN_ARGS(); const float* final_norm = kap->in[17]; float* out_f = kap->out;
        int tf_ = threadIdx.x; asm volatile("" : "+v"(tf_)); const int lane_f = tf_ & 63;
        const unsigned tmo = __hip_atomic_load(ctl + CW_BAR + XB_TMO, RLX_AGENT);
        f32x4 gn[4];
#pragma unroll
        for (int j = 0; j < 4; ++j) gn[j] = *(const f32x4*)(final_norm + 16 * lane_f + 4 * j);
        for (int t0 = gw; t0 < T; t0 += 2 * NGW) {
            f32x4 v[2][4]; float s2[2];
#pragma unroll
            for (int q = 0; q < 2; ++q) { const int t = t0 + q * NGW;
                const u32x4 a0 = *(const u32x4*)(hbuf + (size_t)t * D + 16 * lane_f), a1 = *(const u32x4*)(hbuf + (size_t)t * D + 16 * lane_f + 8);
                const u32x4 y = *(const u32x4*)(y8buf + (size_t)t * 2 * D + 16 * lane_f), z = *(const u32x4*)(y8buf + (size_t)t * 2 * D + D + 16 * lane_f);
                float yf[4][4], zf[4][4]; up4_fp8(y.x, yf[0]); up4_fp8(y.y, yf[1]); up4_fp8(y.z, yf[2]); up4_fp8(y.w, yf[3]); up4_fp8(z.x, zf[0]); up4_fp8(z.y, zf[1]); up4_fp8(z.z, zf[2]); up4_fp8(z.w, zf[3]);
                constexpr float YI = 1.0f / Y8S;
                v[q][0] = (f32x4){bflo(a0.x) + (yf[0][0] + zf[0][0]) * YI, bfhi(a0.x) + (yf[0][1] + zf[0][1]) * YI, bflo(a0.y) + (yf[0][2] + zf[0][2]) * YI, bfhi(a0.y) + (yf[0][3] + zf[0][3]) * YI};
                v[q][1] = (f32x4){bflo(a0.z) + (yf[1][0] + zf[1][0]) * YI, bfhi(a0.z) + (yf[1][1] + zf[1][1]) * YI, bflo(a0.w) + (yf[1][2] + zf[1][2]) * YI, bfhi(a0.w) + (yf[1][3] + zf[1][3]) * YI};
                v[q][2] = (f32x4){bflo(a1.x) + (yf[2][0] + zf[2][0]) * YI, bfhi(a1.x) + (yf[2][1] + zf[2][1]) * YI, bflo(a1.y) + (yf[2][2] + zf[2][2]) * YI, bfhi(a1.y) + (yf[2][3] + zf[2][3]) * YI};
                v[q][3] = (f32x4){bflo(a1.z) + (yf[3][0] + zf[3][0]) * YI, bfhi(a1.z) + (yf[3][1] + zf[3][1]) * YI, bflo(a1.w) + (yf[3][2] + zf[3][2]) * YI, bfhi(a1.w) + (yf[3][3] + zf[3][3]) * YI};
                float s = 0.f;
#pragma unroll
                for (int j = 0; j < 4; ++j) s += (v[q][j][0] * v[q][j][0] + v[q][j][1] * v[q][j][1]) + (v[q][j][2] * v[q][j][2] + v[q][j][3] * v[q][j][3]);
                s2[q] = s; }
            s2[0] = wave_sum(s2[0]); s2[1] = wave_sum(s2[1]);
            asm volatile("s_waitcnt vmcnt(0)" ::: "memory");
#pragma unroll
            for (int q = 0; q < 2; ++q) { const int t = t0 + q * NGW;
                float rstd = 1.0f / sqrtf(s2[q] * (1.0f / D) + EPS);
                if (tmo) rstd = __builtin_nanf("");
#pragma unroll
                for (int j = 0; j < 4; ++j) *(f32x4*)(out_f + (size_t)t * D + 16 * lane_f + 4 * j) = v[q][j] * rstd * gn[j]; }
        }
    }
#undef IN
#undef SEAM
}

#ifndef MK_ONE_LAUNCH
#define MK_ONE_LAUNCH 1
#endif
extern "C" void kernel_launch(void* const* d_in, const int* in_sizes, int n_in, void* d_out, int out_size, void* d_ws, size_t ws_size, hipStream_t stream) {
    static int grid = 0;
    if (grid == 0) {
        if (n_in != 18 || in_sizes[0] != T * D || out_size != T * D || ws_size < WS_END) { fprintf(stderr, "kernel_launch: shape mismatch n_in %d in0 %d out %d ws %zu (need %zu)\n", n_in, n_in > 0 ? in_sizes[0] : -1, out_size, ws_size, (size_t)WS_END); grid = -1; return; }
        int dev = 0, cus = 0, per_cu = 0;
        if (hipGetDevice(&dev) != hipSuccess || hipDeviceGetAttribute(&cus, hipDeviceAttributeMultiprocessorCount, dev) != hipSuccess) { grid = -1; return; }
        if (hipFuncSetAttribute((const void*)yoco_fwd, hipFuncAttributeMaxDynamicSharedMemorySize, LDS_BYTES) != hipSuccess) { fprintf(stderr, "kernel_launch: hipFuncSetAttribute failed\n"); grid = -1; return; }
        if (hipOccupancyMaxActiveBlocksPerMultiprocessor(&per_cu, (const void*)yoco_fwd, NWAVES * 64, LDS_BYTES) != hipSuccess || per_cu < 1) fprintf(stderr, "kernel_launch: occupancy query says %d\n", per_cu);
        (void)hipGetLastError();
        grid = cus;
    }
    if (grid < 0) return;
    (void)hipMemsetAsync((char*)d_ws + WS_CTL, 0, CTL_ZERO_BYTES, stream);
    Args a{};
    for (int i = 0; i < 18; ++i) a.in[i] = (const float*)d_in[i];
    a.out = (float*)d_out; a.ws = (unsigned char*)d_ws;
#if MK_ONE_LAUNCH
    a.ph_lo = 0; a.ph_hi = PH_COUNT;
    hipLaunchKernelGGL(yoco_fwd, dim3(grid), dim3(NWAVES * 64), LDS_BYTES, stream, a);
#else
    for (int p = 0; p < PH_COUNT; ++p) { a.ph_lo = p; a.ph_hi = p + 1; hipLaunchKernelGGL(yoco_fwd, dim3(grid), dim3(NWAVES * 64), LDS_BYTES, stream, a); }
#endif
}
```

```cpp
#include <hip/hip_runtime.h>
#include <cstdio>
#include <cstdint>

#define LAS __attribute__((address_space(3)))
#define GAS __attribute__((address_space(1)))
typedef unsigned short bf16;
typedef short bf16x8 __attribute__((ext_vector_type(8)));
typedef short s16x4 __attribute__((ext_vector_type(4)));
typedef float f32x4 __attribute__((ext_vector_type(4)));
typedef float f32x16 __attribute__((ext_vector_type(16)));
typedef unsigned u32x4 __attribute__((ext_vector_type(4)));
typedef unsigned u32x2 __attribute__((ext_vector_type(2)));
typedef float f32x2 __attribute__((ext_vector_type(2)));
typedef long l64x2 __attribute__((ext_vector_type(2)));
typedef int i32x4 __attribute__((ext_vector_type(4)));
typedef int i32x8 __attribute__((ext_vector_type(8)));

constexpr int T = 32768, D = 1024, SEQ = 4096, NBATCH = 8, NH = 8, HD = 128, FF = 2816, FE = 3584, NE = 8, NBLK = 16;
constexpr float EPS = 1e-6f;
constexpr int NWAVES = 8;
constexpr int MOE_ROWS_MAX = 2 * T + NE * 256;
constexpr int MOE_TILES_MAX = MOE_ROWS_MAX / 256;
constexpr int CHUNK_TILES = 64;
constexpr int CONV_WGS = 64;
constexpr int MOE_STEPS = 5;

constexpr size_t MiB = 1u << 20, KiB = 1u << 10;
constexpr size_t WS_CTL = 0, CTL_ZERO_BYTES = 64 * KiB;
constexpr size_t WS_ROPE_C = 1 * MiB, WS_ROPE_S = 1 * MiB + 256 * KiB;
constexpr size_t WS_KMEAN = 1 * MiB + 512 * KiB;
constexpr size_t WS_SS1 = 2 * MiB, WS_SS2 = 4 * MiB, WS_SS3 = 6 * MiB;
constexpr size_t WS_RSTD3 = 8 * MiB;
constexpr size_t WS_GATEW = 8 * MiB + 128 * KiB;
constexpr size_t WS_ENT = 8 * MiB + 384 * KiB;
constexpr size_t WS_BCNT = 8 * MiB + 640 * KiB;
constexpr size_t WS_SOFF = 9 * MiB, WS_SRSTD = 9 * MiB + 512 * KiB, WS_SDST = 10 * MiB, WS_SGW = 10 * MiB + 512 * KiB;
constexpr size_t WS_TEXP = 11 * MiB;
constexpr size_t WS_W_POOL = 12 * MiB;
constexpr size_t WS_W_QKV = WS_W_POOL + 512 * KiB;
constexpr size_t WS_W_WO = WS_W_QKV + 6 * MiB;
constexpr size_t WS_W_FGU = WS_W_WO + 2 * MiB;
constexpr size_t WS_W_FD = WS_W_FGU + 11 * MiB;
constexpr size_t WS_PART = WS_W_FD + 5 * MiB + 512 * KiB;
constexpr size_t WS_W_MGU = WS_PART + 84 * MiB;
constexpr size_t WS_W_MD = WS_W_MGU + 56 * MiB;
constexpr size_t WS_H = WS_W_MD + 28 * MiB;
constexpr size_t WS_R = WS_H + 64 * MiB;
constexpr size_t WS_POOLED = WS_R;
constexpr size_t WS_FACT = WS_R;
constexpr size_t WS_Q = WS_R, WS_K = WS_R + 64 * MiB, WS_V = WS_R + 128 * MiB;
constexpr size_t WS_MLP = WS_R + 192 * MiB;
constexpr size_t WS_MLOWN = WS_R + 198 * MiB;
constexpr size_t WS_SEL = WS_SS1;
constexpr size_t WS_ACT0 = WS_R, WS_ACT1 = WS_R + 56 * MiB;
constexpr size_t WS_ACT2 = WS_R + 112 * MiB;
constexpr size_t WS_H8 = WS_R + 120 * MiB;
constexpr size_t WS_Y8 = WS_R + 152 * MiB;
constexpr size_t WS_END = WS_R + 239 * MiB;
constexpr float W8S_GU = 32.f, W8S_DN = 64.f, ACT8S = 4.f;
static_assert(WS_H == 205 * MiB && WS_END == 508 * MiB && WS_PART + (size_t)64 * 10752 * 128 == WS_W_MGU, "ws map");
constexpr int CW_TMO = 0, CW_CODE = 1, CW_BAR = 4096, CW_NTILES = 8192, CW_CONVQ = 8256, CW_KVQ = 8448;

constexpr int RING_OFF = 0, RING_BYTES = 131072;
constexpr int LDSCTL_OFF = RING_BYTES, MISC_OFF = LDSCTL_OFF + 320, XTRA_OFF = LDSCTL_OFF + 1024;
constexpr int LDS_BYTES = 155648;

#define RLX_AGENT __ATOMIC_RELAXED, __HIP_MEMORY_SCOPE_AGENT
#define LDS_WAIT() asm volatile("s_waitcnt lgkmcnt(0)" ::: "memory")
#define VM_WAIT() asm volatile("s_waitcnt vmcnt(0)" ::: "memory")
__device__ __forceinline__ unsigned f2bf(float f) { unsigned u = __builtin_bit_cast(unsigned, f); return (u + 0x7fffu + ((u >> 16) & 1u)) >> 16; }
__device__ __forceinline__ unsigned pk2(float lo, float hi) { return f2bf(lo) | (f2bf(hi) << 16); }
__device__ __forceinline__ unsigned cvt_pk_bf16(float lo, float hi) { unsigned r; asm volatile("v_cvt_pk_bf16_f32 %0, %1, %2" : "=v"(r) : "v"(lo), "v"(hi)); return r; }
typedef float f32x2v __attribute__((ext_vector_type(2)));
__device__ __forceinline__ void up4_fp8(unsigned w, float (&f)[4]) { const f32x2v lo = __builtin_amdgcn_cvt_pk_f32_fp8((int)w, false), hi = __builtin_amdgcn_cvt_pk_f32_fp8((int)w, true); f[0] = lo[0]; f[1] = lo[1]; f[2] = hi[0]; f[3] = hi[1]; }
__device__ __forceinline__ unsigned pk4_fp8(float a, float b, float c, float d) { int w = 0; w = __builtin_amdgcn_cvt_pk_fp8_f32(a, b, w, false); w = __builtin_amdgcn_cvt_pk_fp8_f32(c, d, w, true); return (unsigned)w; }
__device__ __forceinline__ float bflo(unsigned w) { return __builtin_bit_cast(float, w << 16); }
__device__ __forceinline__ float bfhi(unsigned w) { return __builtin_bit_cast(float, w & 0xffff0000u); }
__device__ __forceinline__ float wave_sum(float v) {
#pragma unroll
    for (int o = 1; o < 64; o <<= 1) v += __shfl_xor(v, o);
    return v;
}

namespace pg8 {
constexpr int BM = 256, BK = 64, HALF = 128, HTB = HALF * BK * 2, STAGE_BYTES = 8 * HTB, NXCD = 8, WGM = 8;
constexpr int GSLOT_OFF = 132096, RSLOT_OFF = 132096 + 8192;
__host__ __device__ __forceinline__ int lds_byte(int r, int c) { return (r >> 3) * 1024 + (r & 7) * 128 + ((((c >> 3) ^ (r >> 1)) & 7) << 4) + (c & 7) * 2; }
__host__ __device__ __forceinline__ void stage_rc(int b, int& R, int& C) { const int q = b / 1024, p = b % 1024, rr = p / 128, cq = (p % 128) / 16; R = q * 8 + rr; C = ((cq ^ (R >> 1)) & 7) * 8; }
__host__ __device__ __forceinline__ int perm32(int rho) { const int n = rho >> 4, i = rho & 15; return 8 * (i >> 2) + 4 * n + (i & 3); }
struct Unit { int pm, pn; };
struct StaticOrder {
    int nM, nN, nwg, G, c;
    __device__ void init(int nM_, int nN_, int G_, int c_) { nM = nM_; nN = nN_; nwg = nM * nN; G = G_; c = c_; }
    __device__ bool next(int i, Unit& u) const {
        const long L = (long)i * G + c; if (L >= nwg) return false;
        int wgid = (int)L; { const int q = nwg / NXCD, r = nwg % NXCD, xcd = wgid % NXCD, off = wgid / NXCD; wgid = (xcd < r ? xcd * (q + 1) : r * (q + 1) + (xcd - r) * q) + off; }
        const int nig = WGM * nN, gid = wgid / nig, fm = gid * WGM, gsz = (nM - fm) < WGM ? (nM - fm) : WGM;
        u.pm = fm + ((wgid % nig) % gsz); u.pn = (wgid % nig) / gsz; return true;
    }
};
template <class P, class Epi, class Sched>
__device__ __forceinline__ void gemm_phase(LAS unsigned char* lds, const P& pr, const Sched& S, const Epi& E) {
    int tid_ = threadIdx.x; asm volatile("" : "+v"(tid_));
    const int tid = tid_, wid = __builtin_amdgcn_readfirstlane(tid >> 6), lane = tid & 63, wr = wid >> 2, wc = wid & 3, fr = lane & 15, fq = lane >> 4;
    const int K = pr.K, nt = K / BK;
    unsigned voffB[2], vcA[2][2]; int Rr[2]; unsigned Cc[2];
#pragma unroll
    for (int i = 0; i < 2; ++i) { int R, C; stage_rc(tid * 16 + i * 8192, R, C); const int Rb = (R & ~31) + perm32(R & 31);
        voffB[i] = (unsigned)(Rb * K + C) * 2u; Rr[i] = R; Cc[i] = (unsigned)C * 2u; }
    const size_t kstep = (size_t)(BK * 2);
    const size_t hstepB = (size_t)HALF * K * 2;
    const unsigned ldsw = (unsigned)wid * 1024u;
    const int aoff0 = lds_byte(wr * 64 + fr, fq * 8), boff0 = lds_byte(wc * 32 + fr, fq * 8);
#define PG8_SA(b, h) (((b) * 2 + (h)) * HTB)
#define PG8_SB(b, h) ((4 + (b) * 2 + (h)) * HTB)
#define PG8_STAGE(bufoff, gbase, voff) do { _Pragma("unroll") for (int _i = 0; _i < 2; ++_i) { unsigned vo_ = (voff)[_i]; asm volatile("" : "+v"(vo_));     \
        __builtin_amdgcn_global_load_lds((const unsigned*)((const char*)(gbase) + vo_), (LAS unsigned*)(lds + (bufoff) + ldsw + _i * 8192), 16, 0, 0); } } while (0)
#define PG8_X64(o1, o0) int o1; asm volatile("v_xor_b32 %0, 64, %1" : "=v"(o1) : "v"(o0))
#define PG8_LDA(dst, b, h) do { PG8_X64(aoff1, aoff0); _Pragma("unroll") for (int m = 0; m < 4; ++m) { dst[m][0] = *(const LAS bf16x8*)(lds + PG8_SA(b, h) + aoff0 + m * 2048); dst[m][1] = *(const LAS bf16x8*)(lds + PG8_SA(b, h) + aoff1 + m * 2048); } } while (0)
#define PG8_LDB(dst, b, h) do { PG8_X64(boff1, boff0); _Pragma("unroll") for (int n = 0; n < 2; ++n) { dst[n][0] = *(const LAS bf16x8*)(lds + PG8_SB(b, h) + boff0 + n * 2048); dst[n][1] = *(const LAS bf16x8*)(lds + PG8_SB(b, h) + boff1 + n * 2048); } } while (0)
#define PG8_MMA(ai, bj, At, Bt) do { __builtin_amdgcn_s_setprio(1); \
        if constexpr (P::FP8) { _Pragma("unroll") for (int m = 0; m < 4; ++m) _Pragma("unroll") for (int n = 0; n < 2; ++n) { \
            const i32x8 a8_ = __builtin_shufflevector(__builtin_bit_cast(i32x4, At[m][0]), __builtin_bit_cast(i32x4, At[m][1]), 0, 1, 2, 3, 4, 5, 6, 7); \
            const i32x8 b8_ = __builtin_shufflevector(__builtin_bit_cast(i32x4, Bt[n][0]), __builtin_bit_cast(i32x4, Bt[n][1]), 0, 1, 2, 3, 4, 5, 6, 7); \
            asm volatile("v_mfma_scale_f32_16x16x128_f8f6f4 %0, %1, %2, %0, %3, %3 op_sel_hi:[0,0,0]" : "+v"(acc[ai][bj][m][n]) : "v"(b8_), "v"(a8_), "v"(sc1_)); } }     \
        else { _Pragma("unroll") for (int m = 0; m < 4; ++m) _Pragma("unroll") for (int n = 0; n < 2; ++n) _Pragma("unroll") for (int k = 0; k < 2; ++k) \
            acc[ai][bj][m][n] = __builtin_amdgcn_mfma_f32_16x16x32_bf16(Bt[n][k], At[m][k], acc[ai][bj][m][n], 0, 0, 0); } \
        __builtin_amdgcn_s_setprio(0); } while (0)
#define PG8_MMA0(ai, bj, At, Bt) do { __builtin_amdgcn_s_setprio(1);        \
        if constexpr (P::FP8) { _Pragma("unroll") for (int m = 0; m < 4; ++m) _Pragma("unroll") for (int n = 0; n < 2; ++n) { \
            const i32x8 a8_ = __builtin_shufflevector(__builtin_bit_cast(i32x4, At[m][0]), __builtin_bit_cast(i32x4, At[m][1]), 0, 1, 2, 3, 4, 5, 6, 7); \
            const i32x8 b8_ = __builtin_shufflevector(__builtin_bit_cast(i32x4, Bt[n][0]), __builtin_bit_cast(i32x4, Bt[n][1]), 0, 1, 2, 3, 4, 5, 6, 7); \
            asm volatile("v_mfma_scale_f32_16x16x128_f8f6f4 %0, %1, %2, 0, %3, %3 op_sel_hi:[0,0,0]" : "=v"(acc[ai][bj][m][n]) : "v"(b8_), "v"(a8_), "v"(sc1_)); } } \
        else { _Pragma("unroll") for (int m = 0; m < 4; ++m) _Pragma("unroll") for (int n = 0; n < 2; ++n) { \
            acc[ai][bj][m][n] = __builtin_amdgcn_mfma_f32_16x16x32_bf16(Bt[n][0], At[m][0], (f32x4){0.f, 0.f, 0.f, 0.f}, 0, 0, 0); \
            acc[ai][bj][m][n] = __builtin_amdgcn_mfma_f32_16x16x32_bf16(Bt[n][1], At[m][1], acc[ai][bj][m][n], 0, 0, 0); } } \
        __builtin_amdgcn_s_setprio(0); } while (0)
#define PG8_WAIT_V(n) asm volatile("s_waitcnt vmcnt(" #n ")" ::: "memory")
#define PG8_WAIT_L(n) asm volatile("s_waitcnt lgkmcnt(" #n ")" ::: "memory")
#define PG8_BAR __builtin_amdgcn_s_barrier()
#define PG8_SCHED __builtin_amdgcn_sched_barrier(0)
    Unit cur, nxt; int ui = 0;
    if (!S.next(0, cur)) return;
    int sc1_ = 0x7f7f7f7f; asm volatile("" : "+v"(sc1_));
    f32x4 acc[2][2][4][2];
    bf16x8 At[4][2], B0[2][2], B1[2][2];
    const char* cA = pr.a_base(cur); const char* cB = pr.b_base(cur);
    if constexpr (Epi::PREFETCH) E.prefetch(lds, cur, ldsw, lane);
    if constexpr (P::GATHER) {
        const unsigned* rl = pr.rows(cur);
#pragma unroll
        for (int h = 0; h < 2; ++h)
#pragma unroll
            for (int i = 0; i < 2; ++i) vcA[h][i] = rl[h * HALF + Rr[i]] + Cc[i];
    } else {
#pragma unroll
        for (int h = 0; h < 2; ++h)
#pragma unroll
            for (int i = 0; i < 2; ++i) vcA[h][i] = (unsigned)((h * HALF + Rr[i]) * pr.lda) * 2u + Cc[i];
    }
    PG8_STAGE(PG8_SB(0, 0), cB, voffB); PG8_STAGE(PG8_SB(0, 1), cB + hstepB, voffB); PG8_STAGE(PG8_SA(0, 0), cA, vcA[0]); PG8_STAGE(PG8_SA(0, 1), cA, vcA[1]);
    if (wr == 1) PG8_BAR;
    PG8_WAIT_V(2); PG8_BAR;
    PG8_STAGE(PG8_SB(1, 0), cB + kstep, voffB); PG8_STAGE(PG8_SA(1, 0), cA + kstep, vcA[0]); PG8_STAGE(PG8_SB(1, 1), cB + hstepB + kstep, voffB);
    PG8_WAIT_V(6); PG8_BAR;
    for (;;) {
        const bool has_next = S.next(ui + 1, nxt);
        const char* nA = has_next ? pr.a_base(nxt) : cA; const char* nB = has_next ? pr.b_base(nxt) : cB;
        if constexpr (P::GATHER) {
            if (has_next) { const unsigned* rn = pr.rows(nxt);
#pragma unroll
                for (int h = 0; h < 2; ++h)
#pragma unroll
                    for (int i = 0; i < 2; ++i) { int t2 = threadIdx.x; asm volatile("" : "+v"(t2)); int R2, C2; stage_rc(t2 * 16 + i * 8192, R2, C2);
                        __builtin_amdgcn_global_load_lds(rn + h * HALF + R2, (LAS unsigned*)(lds + GSLOT_OFF + ldsw + (h * 2 + i) * 256), 4, 0, 0); } }
        }
        for (int t = 0; t < nt; t += 2) {
            const bool last = (t == nt - 2);
            const char* a1 = cA + (size_t)(t + 1) * kstep;
            const char* a2 = last ? nA : cA + (size_t)(t + 2) * kstep; const char* b2 = last ? nB : cB + (size_t)(t + 2) * kstep;
            const char* a3 = a2 + kstep; const char* b3 = b2 + kstep;
            PG8_LDB(B0, 0, 0); PG8_LDB(B1, 0, 1); PG8_SCHED; PG8_LDA(At, 0, 0); PG8_STAGE(PG8_SA(1, 1), a1, vcA[1]);
            if constexpr (P::GATHER) { if (last && has_next) {
#pragma unroll
                for (int h = 0; h < 2; ++h)
#pragma unroll
                    for (int i = 0; i < 2; ++i) { int t3 = threadIdx.x; asm volatile("" : "+v"(t3)); int R3, C3; stage_rc(t3 * 16 + i * 8192, R3, C3);
                        vcA[h][i] = *(const LAS unsigned*)(lds + GSLOT_OFF + ldsw + (h * 2 + i) * 256 + (t3 & 63) * 4) + (unsigned)C3 * 2u; } } }
            PG8_WAIT_V(8); PG8_WAIT_L(0); PG8_BAR; if (t == 0) { PG8_MMA0(0, 0, At, B0); PG8_MMA0(0, 1, At, B1); } else { PG8_MMA(0, 0, At, B0); PG8_MMA(0, 1, At, B1); } PG8_BAR; PG8_SCHED;
            PG8_LDA(At, 0, 1); PG8_STAGE(PG8_SB(0, 0), b2, voffB); PG8_STAGE(PG8_SB(0, 1), b2 + hstepB, voffB); PG8_STAGE(PG8_SA(0, 0), a2, vcA[0]);
            PG8_WAIT_V(8); PG8_WAIT_L(0); PG8_BAR; if (t == 0) { PG8_MMA0(1, 0, At, B0); PG8_MMA0(1, 1, At, B1); } else { PG8_MMA(1, 0, At, B0); PG8_MMA(1, 1, At, B1); } PG8_BAR; PG8_SCHED;
            PG8_LDB(B0, 1, 0); PG8_LDB(B1, 1, 1); PG8_SCHED; PG8_LDA(At, 1, 0); PG8_STAGE(PG8_SA(0, 1), a2, vcA[1]);
            PG8_WAIT_V(8); PG8_WAIT_L(0); PG8_BAR; PG8_MMA(0, 0, At, B0); PG8_MMA(0, 1, At, B1); PG8_BAR; PG8_SCHED;
            PG8_LDA(At, 1, 1); PG8_STAGE(PG8_SB(1, 0), b3, voffB); PG8_STAGE(PG8_SB(1, 1), b3 + hstepB, voffB); PG8_STAGE(PG8_SA(1, 0), a3, vcA[0]);
            PG8_WAIT_V(8); PG8_WAIT_L(0); PG8_BAR; PG8_MMA(1, 0, At, B0); PG8_MMA(1, 1, At, B1); PG8_BAR; PG8_SCHED;
        }
        if (wr == 0) PG8_BAR;
        if constexpr (P::FP8) asm volatile("s_nop 15\n\ts_nop 15" ::: "memory");
        { int te_ = threadIdx.x; asm volatile("" : "+v"(te_)); const int fr_e = te_ & 15, fq_e = (te_ >> 4) & 3;
          if constexpr (Epi::PREFETCH) E.run(acc, cur, wr, wc, fr_e, fq_e, lds, ldsw); else E(acc, cur, wr, wc, fr_e, fq_e); }
        if (!has_next) break;
        cur = nxt; cA = nA; cB = nB; ++ui;
        if constexpr (Epi::PREFETCH) { int tp_ = threadIdx.x; asm volatile("" : "+v"(tp_)); E.prefetch(lds, cur, ldsw, tp_ & 63); }
        if (wr == 1) PG8_BAR;
    }
    PG8_WAIT_V(0);
    PG8_BAR;
#undef PG8_SA
#undef PG8_SB
#undef PG8_STAGE
#undef PG8_LDA
#undef PG8_X64
#undef PG8_LDB
#undef PG8_MMA
#undef PG8_MMA0
#undef PG8_WAIT_V
#undef PG8_WAIT_L
#undef PG8_BAR
#undef PG8_SCHED
}
}

#ifndef FFN1_FP8
#define FFN1_FP8 0
#endif
#ifndef FFN2_FP8
#define FFN2_FP8 1
#endif
#ifndef WO_FP8
#define WO_FP8 1
#endif
constexpr float O8S = 16.f;
constexpr float P8S = 16.f, Y8S = 16.f;
#ifndef QKV_FP8
#define QKV_FP8 1
#endif
template <bool F8> struct ProbDenseT {
    static constexpr bool GATHER = false, FP8 = F8;
    const char* A; const char* B; int K, lda; int a_pn_step;
    __device__ __forceinline__ const char* a_base(const pg8::Unit& u) const { return A + (size_t)u.pm * 256 * lda * 2 + (size_t)u.pn * a_pn_step; }
    __device__ __forceinline__ const char* b_base(const pg8::Unit& u) const { return B + (size_t)u.pn * 256 * K * 2; }
    __device__ __forceinline__ const unsigned* rows(const pg8::Unit&) const { return nullptr; }
};
typedef ProbDenseT<false> ProbDense;
__device__ __forceinline__ int moe_tile(int pm, int mt0, int nmain) { return pm < nmain ? mt0 + pm : 256 + pm - nmain; }
struct ProbMoeG1 {
    static constexpr bool GATHER = true, FP8 = true;
    const char* A; const char* B; int K, lda; const unsigned* soff; const LAS int* texp; int mt0, nmain;
    __device__ __forceinline__ const char* a_base(const pg8::Unit&) const { return A; }
    __device__ __forceinline__ const char* b_base(const pg8::Unit& u) const { const int e = texp[moe_tile(u.pm, mt0, nmain)]; return B + ((size_t)e * (2 * FE) + (size_t)u.pn * 256) * D; }
    __device__ __forceinline__ const unsigned* rows(const pg8::Unit& u) const { return soff + (size_t)moe_tile(u.pm, mt0, nmain) * 256; }
};
struct ProbMoeG2 {
    static constexpr bool GATHER = false, FP8 = true;
    const char* A; const char* A2; const char* B; int K, lda; const LAS int* texp; int mt0, nmain;
    __device__ __forceinline__ const char* a_base(const pg8::Unit& u) const { return u.pm < nmain ? A + (size_t)u.pm * 256 * FE : A2 + (size_t)(u.pm - nmain) * 256 * FE; }
    __device__ __forceinline__ const char* b_base(const pg8::Unit& u) const { const int e = texp[moe_tile(u.pm, mt0, nmain)]; return B + ((size_t)e * D + (size_t)u.pn * 256) * FE; }
    __device__ __forceinline__ const unsigned* rows(const pg8::Unit&) const { return nullptr; }
};
struct SkewOrder : pg8::StaticOrder {
    int e;
    __device__ bool next(int i, pg8::Unit& u) const {
        long L;
        if (c < e) { if (i >= 3) return false; L = (long)i * G + c; }
        else if (i < 7) L = (long)i * G + c;
        else { const int rho = c - e; if (i > 7 || rho >= 4 * e) return false; L = (long)(3 + rho / e) * G + (rho % e); }
        if (L >= nwg) return false;
        int wgid = (int)L; { const int q = nwg / pg8::NXCD, r = nwg % pg8::NXCD, xcd = wgid % pg8::NXCD, off = wgid / pg8::NXCD; wgid = (xcd < r ? xcd * (q + 1) : r * (q + 1) + (xcd - r) * q) + off; }
        const int nig = pg8::WGM * nN, gid = wgid / nig, fm = gid * pg8::WGM, gsz = (nM - fm) < pg8::WGM ? (nM - fm) : pg8::WGM;
        u.pm = fm + ((wgid % nig) % gsz); u.pn = (wgid % nig) / gsz; return true;
    }
};

__device__ __forceinline__ void rstd_rows(const float* ss, int row0  , int fq, float (&rs)[2][4]) {
#pragma unroll
    for (int ai = 0; ai < 2; ++ai)
#pragma unroll
        for (int m = 0; m < 4; ++m) {
            const f32x4 p = *(const f32x4*)(ss + (size_t)(row0 + ai * 128 + m * 16) * 16 + 4 * fq);
            float s = (p[0] + p[1]) + (p[2] + p[3]);
            s += __shfl_xor(s, 16); s += __shfl_xor(s, 32);
            rs[ai][m] = __builtin_amdgcn_rsqf(s * (1.0f / D) + EPS);
        }
}
struct RstdTable {
    const float* ss; mutable int prev_pm; mutable int par;
    __device__ __forceinline__ void update(LAS unsigned char* lds, const pg8::Unit& u) const {
        if (u.pm != prev_pm) { prev_pm = u.pm; par ^= 1;
            int t_ = threadIdx.x; asm volatile("" : "+v"(t_)); const int t = t_, row = t >> 1, hf = t & 1;
            const float* p = ss + ((size_t)u.pm * 256 + row) * 16 + hf * 8;
            const f32x4 a = *(const f32x4*)p, b = *(const f32x4*)(p + 4);
            float s = ((a[0] + a[1]) + (a[2] + a[3])) + ((b[0] + b[1]) + (b[2] + b[3]));
            s += __shfl_xor(s, 1);
            if (hf == 0) *(LAS float*)(lds + pg8::RSLOT_OFF + par * 1024 + row * 4) = __builtin_amdgcn_rsqf(s * (1.0f / D) + EPS); }
    }
    __device__ __forceinline__ void rows(LAS unsigned char* lds, int wr, int fr, float (&rs)[2][4]) const {
#pragma unroll
        for (int ai = 0; ai < 2; ++ai)
#pragma unroll
            for (int m = 0; m < 4; ++m) rs[ai][m] = *(const LAS float*)(lds + pg8::RSLOT_OFF + par * 1024 + (ai * 128 + wr * 64 + m * 16 + fr) * 4);
    }
};
__device__ __forceinline__ float silu_mul(float g, float u) { return g * u * __builtin_amdgcn_rcpf(1.0f + __builtin_amdgcn_exp2f(-1.4426950408889634f * g)); }
__device__ __forceinline__ f32x4 silu4(f32x4 gp, f32x4 up) {
    f32x4 e; e[0] = __builtin_amdgcn_exp2f(gp[0]); e[1] = __builtin_amdgcn_exp2f(gp[1]); e[2] = __builtin_amdgcn_exp2f(gp[2]); e[3] = __builtin_amdgcn_exp2f(gp[3]);
    const f32x4 d = e + 1.0f; f32x4 q; q[0] = __builtin_amdgcn_rcpf(d[0]); q[1] = __builtin_amdgcn_rcpf(d[1]); q[2] = __builtin_amdgcn_rcpf(d[2]); q[3] = __builtin_amdgcn_rcpf(d[3]);
    return (gp * up) * q;
}

template <bool BASE_F32> struct EpiRes {
    static constexpr bool PREFETCH = false;
    const float* x; bf16* h; float* ss; unsigned char* h8; float sc;
    __device__ __forceinline__ void operator()(const f32x4 (&acc)[2][2][4][2], const pg8::Unit& u, int wr, int wc, int fr, int fq) const {
        const int row0 = u.pm * 256 + wr * 64 + fr, col0 = u.pn * 256 + wc * 32 + 8 * fq;
#pragma unroll
        for (int ai = 0; ai < 2; ++ai) {
            f32x4 b0[4][2], b1[4][2]; u32x4 bw[4][2];
#pragma unroll
            for (int m = 0; m < 4; ++m)
#pragma unroll
                for (int bj = 0; bj < 2; ++bj) { const size_t off = (size_t)(row0 + ai * 128 + m * 16) * D + col0 + bj * 128;
                    if constexpr (BASE_F32) { b0[m][bj] = *(const f32x4*)(x + off); b1[m][bj] = *(const f32x4*)(x + off + 4); }
                    else bw[m][bj] = *(const u32x4*)(h + off); }
#pragma unroll
            for (int m = 0; m < 4; ++m) {
                const int row = row0 + ai * 128 + m * 16; float q = 0.f;
#pragma unroll
                for (int bj = 0; bj < 2; ++bj) {
                    f32x4 v0, v1; const size_t off = (size_t)row * D + col0 + bj * 128;
                    if constexpr (BASE_F32) { v0 = b0[m][bj]; v1 = b1[m][bj]; }
                    else { const u32x4 w = bw[m][bj]; v0 = (f32x4){bflo(w.x), bfhi(w.x), bflo(w.y), bfhi(w.y)}; v1 = (f32x4){bflo(w.z), bfhi(w.z), bflo(w.w), bfhi(w.w)}; }
                    v0 += acc[ai][bj][m][0] * sc; v1 += acc[ai][bj][m][1] * sc;
                    q += (v0[0] * v0[0] + v0[1] * v0[1]) + (v0[2] * v0[2] + v0[3] * v0[3]) + (v1[0] * v1[0] + v1[1] * v1[1]) + (v1[2] * v1[2] + v1[3] * v1[3]);
                    u32x4 o; o.x = cvt_pk_bf16(v0[0], v0[1]); o.y = cvt_pk_bf16(v0[2], v0[3]); o.z = cvt_pk_bf16(v1[0], v1[1]); o.w = cvt_pk_bf16(v1[2], v1[3]);
                    *(u32x4*)(h + off) = o;
                    if (h8) { u32x2 o8; o8.x = pk4_fp8(v0[0], v0[1], v0[2], v0[3]); o8.y = pk4_fp8(v1[0], v1[1], v1[2], v1[3]); *(u32x2*)(h8 + off) = o8; }
                }
                q += __shfl_xor(q, 16); q += __shfl_xor(q, 32);
                if (fq == 0) ss[(size_t)row * 16 + u.pn * 4 + wc] = q;
            }
        }
    }
};
template <bool MOE, int LDO, bool O8 = MOE, bool W8 = MOE> struct EpiSwiGLU {
    static constexpr bool PREFETCH = true;
    bf16* act; RstdTable tab; const float* srstd; int mt0; int nmain; bf16* act2;
    __device__ __forceinline__ void prefetch(LAS unsigned char* lds, const pg8::Unit& u, unsigned ldsw, int lane) const {
        if constexpr (!MOE) { tab.update(lds, u); return; }
        const float* sp = srstd + (size_t)moe_tile(u.pm, mt0, nmain) * 256 + lane;
#pragma unroll
        for (int k = 0; k < 4; ++k) __builtin_amdgcn_global_load_lds((const unsigned*)(sp + k * 64), (LAS unsigned*)(lds + pg8::RSLOT_OFF + ldsw + k * 256), 4, 0, 0);
    }
    __device__ __forceinline__ void run(const f32x4 (&acc)[2][2][4][2], const pg8::Unit& u, int wr, int wc, int fr, int fq, LAS unsigned char* lds, unsigned ldsw) const {
        float rs[2][4];
        if constexpr (MOE) {
#pragma unroll
            for (int ai = 0; ai < 2; ++ai)
#pragma unroll
                for (int m = 0; m < 4; ++m) rs[ai][m] = *(const LAS float*)(lds + pg8::RSLOT_OFF + ldsw + (ai * 128 + wr * 64 + m * 16 + fr) * 4);
        } else tab.rows(lds, wr, fr, rs);
        body(acc, u, wr, wc, fr, fq, rs);
    }
    __device__ __forceinline__ void body(const f32x4 (&acc)[2][2][4][2], const pg8::Unit& u, int wr, int wc, int fr, int fq, const float (&rs)[2][4]) const {
        constexpr int ES = O8 ? 1 : 2;
        char* ob = (MOE && u.pm >= nmain) ? (char*)act2 + ((size_t)(u.pm - nmain) * 256 * LDO + (size_t)u.pn * 128) * ES : (char*)act + ((size_t)u.pm * 256 * LDO + (size_t)u.pn * 128) * ES;
        const unsigned vo = (unsigned)((wr * 64 + fr) * LDO + wc * 32 + 8 * fq) * (unsigned)ES;
#pragma unroll
        for (int ai = 0; ai < 2; ++ai)
#pragma unroll
            for (int m = 0; m < 4; ++m) {
                const float r = W8 ? rs[ai][m] * (1.0f / W8S_GU) : rs[ai][m];
                const float rg = r * -1.4426950408889634f, ru = r * (O8 ? -0.6931471805599453f * ACT8S : -0.6931471805599453f);
                const f32x4 s0 = silu4(acc[ai][0][m][0] * rg, acc[ai][1][m][0] * ru), s1 = silu4(acc[ai][0][m][1] * rg, acc[ai][1][m][1] * ru);
                if constexpr (O8) { u32x2 o; o.x = pk4_fp8(s0[0], s0[1], s0[2], s0[3]); o.y = pk4_fp8(s1[0], s1[1], s1[2], s1[3]);
                    *(u32x2*)(ob + (size_t)((ai * 128 + m * 16) * LDO) + vo) = o; }
                else {
                u32x4 o; o.x = cvt_pk_bf16(s0[0], s0[1]); o.y = cvt_pk_bf16(s0[2], s0[3]); o.z = cvt_pk_bf16(s1[0], s1[1]); o.w = cvt_pk_bf16(s1[2], s1[3]);
                *(u32x4*)(ob + (size_t)((ai * 128 + m * 16) * LDO * 2) + vo) = o; }
            }
    }
};
struct EpiQKV {
    static constexpr bool PREFETCH = true;
    bf16* Q; RstdTable tab; const float* rc; const float* rsn; float* kmean;
    __device__ __forceinline__ void prefetch(LAS unsigned char* lds, const pg8::Unit& u, unsigned ldsw, int lane) const { tab.update(lds, u); }
    __device__ __forceinline__ void run(const f32x4 (&acc)[2][2][4][2], const pg8::Unit& u, int wr, int wc, int fr, int fq, LAS unsigned char* lds, unsigned ldsw) const {
        const int row0 = u.pm * 256 + wr * 64 + fr; const int which = u.pn >> 2;
        bf16* O = Q + (size_t)which * ((WS_K - WS_Q) / 2);
        const int col0 = (u.pn & 3) * 256 + wc * 32 + 8 * fq;
        float rs[2][4]; tab.rows(lds, wr, fr, rs);
        f32x4 ks[2][2];
#pragma unroll
        for (int bj = 0; bj < 2; ++bj) { ks[bj][0] = (f32x4){0.f, 0.f, 0.f, 0.f}; ks[bj][1] = (f32x4){0.f, 0.f, 0.f, 0.f}; }
#pragma unroll
        for (int ai = 0; ai < 2; ++ai)
#pragma unroll
            for (int m = 0; m < 4; ++m) {
                const int row = row0 + ai * 128 + m * 16; const float r = QKV_FP8 ? rs[ai][m] * (1.0f / W8S_GU) : rs[ai][m];
                f32x4 cs = (f32x4){1.f, 1.f, 1.f, 1.f}, sn = (f32x4){0.f, 0.f, 0.f, 0.f};
                if (which < 2 && wc == 0) { const int pos = row & (SEQ - 1); cs = *(const f32x4*)(rc + pos * 16 + 4 * fq); sn = *(const f32x4*)(rsn + pos * 16 + 4 * fq); }
#pragma unroll
                for (int bj = 0; bj < 2; ++bj) {
                    f32x4 v0 = acc[ai][bj][m][0] * r, v1 = acc[ai][bj][m][1] * r;
                    if (which < 2 && wc == 0) { const f32x4 a = v0 * cs - v1 * sn, b = v1 * cs + v0 * sn; v0 = a; v1 = b; }
                    if (which == 1) { ks[bj][0] += v0; ks[bj][1] += v1; }
                    u32x4 o; o.x = cvt_pk_bf16(v0[0], v0[1]); o.y = cvt_pk_bf16(v0[2], v0[3]); o.z = cvt_pk_bf16(v1[0], v1[1]); o.w = cvt_pk_bf16(v1[2], v1[3]);
                    *(u32x4*)(O + (size_t)row * D + col0 + bj * 128) = o;
                }
            }
        if (which == 1) {
            const int b = u.pm >> 4, blk = u.pm & 15;
#pragma unroll
            for (int bj = 0; bj < 2; ++bj)
#pragma unroll
                for (int n = 0; n < 2; ++n) { f32x4 s = ks[bj][n];
#pragma unroll
                    for (int o = 1; o < 16; o <<= 1) { s[0] += __shfl_xor(s[0], o); s[1] += __shfl_xor(s[1], o); s[2] += __shfl_xor(s[2], o); s[3] += __shfl_xor(s[3], o); }
                    if (fr == 0) { const int head = (u.pn & 3) * 2 + bj; float* kp = kmean + ((size_t)(b * NH + head) * NBLK + blk) * HD + wc * 32 + 8 * fq + 4 * n;
                        atomicAdd(kp + 0, s[0]); atomicAdd(kp + 1, s[1]); atomicAdd(kp + 2, s[2]); atomicAdd(kp + 3, s[3]); } }
        }
    }
};
struct EpiMoeOut {
    static constexpr bool PREFETCH = true;
    unsigned char* Y; const int* sdst; const float* sgw; int mt0, nmain;
    __device__ __forceinline__ void prefetch(LAS unsigned char* lds, const pg8::Unit& u, unsigned ldsw, int lane) const {
        const size_t r0 = (size_t)moe_tile(u.pm, mt0, nmain) * 256 + lane;
#pragma unroll
        for (int k = 0; k < 4; ++k) { __builtin_amdgcn_global_load_lds((const unsigned*)(sdst + r0 + k * 64), (LAS unsigned*)(lds + pg8::GSLOT_OFF + ldsw + k * 256), 4, 0, 0);
            __builtin_amdgcn_global_load_lds((const unsigned*)(sgw + r0 + k * 64), (LAS unsigned*)(lds + pg8::RSLOT_OFF + ldsw + k * 256), 4, 0, 0); }
    }
    __device__ __forceinline__ void run(const f32x4 (&acc)[2][2][4][2], const pg8::Unit& u, int wr, int wc, int fr, int fq, LAS unsigned char* lds, unsigned ldsw) const {
        const int col0 = u.pn * 256 + wc * 32 + 8 * fq;
#pragma unroll
        for (int ai = 0; ai < 2; ++ai)
#pragma unroll
            for (int m = 0; m < 4; ++m) {
                const int rl = ai * 128 + wr * 64 + m * 16 + fr;
                const int dst = *(const LAS int*)(lds + pg8::GSLOT_OFF + ldsw + rl * 4); const float g = *(const LAS float*)(lds + pg8::RSLOT_OFF + ldsw + rl * 4) * (Y8S / (W8S_DN * ACT8S));
                if (dst >= 0) {
#pragma unroll
                    for (int bj = 0; bj < 2; ++bj) { const f32x4 v0 = acc[ai][bj][m][0] * g, v1 = acc[ai][bj][m][1] * g;
                        u32x2 o; o.x = pk4_fp8(v0[0], v0[1], v0[2], v0[3]); o.y = pk4_fp8(v1[0], v1[1], v1[2], v1[3]);
                        *(u32x2*)(Y + (size_t)dst * D + col0 + bj * 128) = o; }
                }
            }
    }
};

namespace att {
constexpr int KVBLK = 64, LDX = D;
constexpr float SCALE = 0.088388347648318440f, THR = 8.f;
constexpr size_t SHM_V = KVBLK * HD * 2, SHM_K = KVBLK * HD * 2, SHM_ATTN = 2 * SHM_V + 2 * SHM_K + NWAVES * 64 * 4;
#define KSWZ(row, colB) ((row) * 256 + ((colB) ^ (((row) & 7) << 4)))
#define SBAR() __builtin_amdgcn_sched_barrier(0)
__device__ __forceinline__ int crow(int r, int hi) { return (r & 3) + 8 * (r >> 2) + 4 * hi; }
__device__ __forceinline__ void partialSM(f32x16& p0, f32x16& p1, float& m_reg, float& mn, float& alpha) {
    constexpr float C = SCALE * 1.4426950408889634f;
    float pmax = p0[0];
#pragma unroll
    for (int r = 1; r < 16; ++r) pmax = fmaxf(pmax, p0[r]);
#pragma unroll
    for (int r = 0; r < 16; ++r) pmax = fmaxf(pmax, p1[r]);
    { auto rr = __builtin_amdgcn_permlane32_swap(__float_as_uint(pmax), __float_as_uint(pmax), false, false);
      pmax = fmaxf(__uint_as_float(rr[0]), __uint_as_float(rr[1])); }
    if (__builtin_expect(__all(pmax - m_reg <= THR / SCALE), 1)) { mn = m_reg; alpha = 1.f; }
    else { mn = fmaxf(m_reg, pmax); alpha = __builtin_amdgcn_exp2f((m_reg - mn) * C); m_reg = mn; }
    const float mnC = -mn * C;
#pragma unroll
    for (int r = 0; r < 16; ++r) p0[r] = fmaf(p0[r], C, mnC);
#pragma unroll
    for (int r = 0; r < 16; ++r) p1[r] = fmaf(p1[r], C, mnC);
#pragma unroll
    for (int r = 0; r < 16; ++r) p0[r] = __builtin_amdgcn_exp2f(p0[r]);
}
__device__ __forceinline__ void finishSM(f32x16& p0, f32x16& p1, float alpha, float& l_reg, bf16x8& pa0, bf16x8& pa1, bf16x8& pa2, bf16x8& pa3) {
#pragma unroll
    for (int r = 0; r < 16; ++r) p1[r] = __builtin_amdgcn_exp2f(p1[r]);
    float ps = 0;
#pragma unroll
    for (int r = 0; r < 16; ++r) ps += p0[r];
#pragma unroll
    for (int r = 0; r < 16; ++r) ps += p1[r];
    { auto rr = __builtin_amdgcn_permlane32_swap(__float_as_uint(ps), __float_as_uint(ps), false, false);
      ps = __uint_as_float(rr[0]) + __uint_as_float(rr[1]); }
    l_reg = l_reg * alpha + ps;
#define PK4(P, BASE, OUT) do { unsigned a0 = cvt_pk_bf16(P[BASE + 0], P[BASE + 1]), a1 = cvt_pk_bf16(P[BASE + 2], P[BASE + 3]);   \
    unsigned b0 = cvt_pk_bf16(P[BASE + 4], P[BASE + 5]), b1 = cvt_pk_bf16(P[BASE + 6], P[BASE + 7]);                              \
    auto r0 = __builtin_amdgcn_permlane32_swap(a0, b0, false, false); auto r1 = __builtin_amdgcn_permlane32_swap(a1, b1, false, false); \
    u32x4 w = {r0[0], r1[0], r0[1], r1[1]}; OUT = *reinterpret_cast<bf16x8*>(&w); } while (0)
    PK4(p0, 0, pa0); PK4(p0, 8, pa1); PK4(p1, 0, pa2); PK4(p1, 8, pa3);
#undef PK4
}
__device__ __forceinline__ void qkt(f32x16& p0, f32x16& p1, const char* Ks, const bf16x8* qr, int r32, int hi) {
    p0 = f32x16{}; p1 = f32x16{};
#pragma unroll
    for (int d0 = 0; d0 < 8; ++d0) { const int cb = (d0 * 16 + hi * 8) * 2;
        const bf16x8 b0 = *reinterpret_cast<const bf16x8*>(Ks + KSWZ(r32, cb));
        const bf16x8 b1 = *reinterpret_cast<const bf16x8*>(Ks + KSWZ(32 + r32, cb));
        p0 = __builtin_amdgcn_mfma_f32_32x32x16_bf16(b0, qr[d0], p0, 0, 0, 0);
        p1 = __builtin_amdgcn_mfma_f32_32x32x16_bf16(b1, qr[d0], p1, 0, 0, 0); }
}
__device__ __forceinline__ int v_st(int k, int c) { const int kk = (k & ~0xC) | ((k & 4) << 1) | ((k & 8) >> 1); return ((kk >> 3) * 4 + (c >> 5)) * 512 + ((kk & 7) * 32 + (c & 31)) * 2; }
__device__ __forceinline__ int v_rd_base(int lane) { return ((lane & 3) << 3) | (((lane >> 2) & 3) << 6) | (((lane >> 4) & 1) << 5) | (((lane >> 5) & 1) << 8); }
constexpr int v_rd_off(int d0, int ks, int half) { return d0 * 512 + ks * 4096 + half * 2048; }
template <int OFF> __device__ __forceinline__ s16x4 tr_read(int vb) {
    s16x4 r; asm volatile("ds_read_b64_tr_b16 %0, %1 offset:%2" : "=&v"(r) : "v"(vb), "i"(OFF) : "memory"); return r;
}
template <int D0, bool FIRST = false> __device__ __forceinline__ void pv_one(f32x16& od, int vb, bf16x8 pa0, bf16x8 pa1, bf16x8 pa2, bf16x8 pa3) {
    const s16x4 l0 = tr_read<v_rd_off(D0, 0, 0)>(vb), h0 = tr_read<v_rd_off(D0, 0, 1)>(vb), l1 = tr_read<v_rd_off(D0, 1, 0)>(vb), h1 = tr_read<v_rd_off(D0, 1, 1)>(vb);
    const s16x4 l2 = tr_read<v_rd_off(D0, 2, 0)>(vb), h2 = tr_read<v_rd_off(D0, 2, 1)>(vb), l3 = tr_read<v_rd_off(D0, 3, 0)>(vb), h3 = tr_read<v_rd_off(D0, 3, 1)>(vb);
    asm volatile("s_waitcnt lgkmcnt(0)" ::: "memory"); SBAR();
#define PK(L, H) (bf16x8){L[0], L[1], L[2], L[3], H[0], H[1], H[2], H[3]}
    if constexpr (FIRST) od = __builtin_amdgcn_mfma_f32_32x32x16_bf16(PK(l0, h0), pa0, f32x16{}, 0, 0, 0);
    else od = __builtin_amdgcn_mfma_f32_32x32x16_bf16(PK(l0, h0), pa0, od, 0, 0, 0);
    od = __builtin_amdgcn_mfma_f32_32x32x16_bf16(PK(l1, h1), pa1, od, 0, 0, 0);
    od = __builtin_amdgcn_mfma_f32_32x32x16_bf16(PK(l2, h2), pa2, od, 0, 0, 0);
    od = __builtin_amdgcn_mfma_f32_32x32x16_bf16(PK(l3, h3), pa3, od, 0, 0, 0);
#undef PK
}
template <bool FIRST = false> __device__ __forceinline__ void pv_d0(f32x16* o, int vb, bf16x8 pa0, bf16x8 pa1, bf16x8 pa2, bf16x8 pa3) {
    pv_one<0, FIRST>(o[0], vb, pa0, pa1, pa2, pa3); pv_one<1, FIRST>(o[1], vb, pa0, pa1, pa2, pa3); pv_one<2, FIRST>(o[2], vb, pa0, pa1, pa2, pa3); pv_one<3, FIRST>(o[3], vb, pa0, pa1, pa2, pa3);
}
constexpr int PROWS = 10752;
__device__ __forceinline__ int nsl_of(int i) { return i < 3 ? i : 3; }
__device__ __forceinline__ int rowoff_of(int i) { return 256 * (i <= 1 ? 0 : (i == 2 ? 1 : 3 * i - 6)); }

__device__ __forceinline__ void sel_load(const bf16* Qb, bf16x8 (&qr)[8]) {
    const int tid = threadIdx.x, wid = __builtin_amdgcn_readfirstlane(tid >> 6), lane = tid & 63, r32 = lane & 31, hi = lane >> 5;
    const char* Qc = (const char*)Qb; const unsigned qoff = (unsigned)((wid * 32 + r32) * LDX + hi * 8) * 2u;
#pragma unroll
    for (int d0 = 0; d0 < 8; ++d0) qr[d0] = *reinterpret_cast<const bf16x8*>(Qc + qoff + d0 * 32);
}
__device__ __forceinline__ void sel_tile_fill(char* kmT, const float* km  ) {
    int t_ = threadIdx.x; asm volatile("" : "+v"(t_)); const int t = t_, blk = t >> 5, cB = (t & 31) * 8, rho = (blk & 7) + 16 * (blk >> 3);
    const f32x4 v = *(const f32x4*)(km + t * 4);
    u32x2 hw; hw.x = cvt_pk_bf16(v[0], v[1]); hw.y = cvt_pk_bf16(v[2], v[3]);
    const f32x4 r = v - (f32x4){bflo(hw.x), bfhi(hw.x), bflo(hw.y), bfhi(hw.y)};
    u32x2 lw; lw.x = cvt_pk_bf16(r[0], r[1]); lw.y = cvt_pk_bf16(r[2], r[3]);
    *(u32x2*)(kmT + KSWZ(rho, cB)) = hw; *(u32x2*)(kmT + KSWZ(rho + 8, cB)) = lw;
}
__device__ __forceinline__ void sel_unit(const bf16x8 (&qr)[8], const char* kmT  , unsigned short* selo  , int iblk) {
    int tid_o = threadIdx.x; asm volatile("" : "+v"(tid_o));
    const int tid = tid_o, wid = __builtin_amdgcn_readfirstlane(tid >> 6), lane = tid & 63, r32 = lane & 31, hi = lane >> 5;
    f32x16 p = f32x16{};
#pragma unroll
    for (int d0 = 0; d0 < 8; ++d0) { const int cb = (d0 * 16 + hi * 8) * 2;
        const bf16x8 a = *reinterpret_cast<const bf16x8*>(kmT + KSWZ(r32, cb));
        p = __builtin_amdgcn_mfma_f32_32x32x16_bf16(a, qr[d0], p, 0, 0, 0); }
    float own[8], oth[8];
#pragma unroll
    for (int g = 0; g < 2; ++g)
#pragma unroll
        for (int j = 0; j < 4; ++j) own[4 * g + j] = p[8 * g + j] + p[8 * g + 4 + j];
#pragma unroll
    for (int i = 0; i < 8; ++i) { auto rr = __builtin_amdgcn_permlane32_swap(__builtin_bit_cast(unsigned, own[i]), __builtin_bit_cast(unsigned, own[i]), false, false);
        oth[i] = __builtin_bit_cast(float, hi ? rr[0] : rr[1]); }
    unsigned sel = 0;
    float v1 = -__builtin_inff(), v2 = v1, v3 = v1; int i1 = -1, i2 = -1, i3 = -1;
#pragma unroll
    for (int n = 0; n < 16; ++n) if (n < iblk) {
        const int idx = 4 * (n >> 3) + (n & 3); const float s = (((n >> 2) & 1) == hi) ? own[idx] : oth[idx];
        if (s > v1) { v3 = v2; i3 = i2; v2 = v1; i2 = i1; v1 = s; i1 = n; }
        else if (s > v2) { v3 = v2; i3 = i2; v2 = s; i2 = n; }
        else if (s > v3) { v3 = s; i3 = n; }
    }
    if (i1 >= 0) sel |= 1u << i1; if (i2 >= 0) sel |= 1u << i2; if (i3 >= 0) sel |= 1u << i3;
    if (hi == 0) selo[wid * 32 + r32] = (unsigned short)sel;
}

__device__ __forceinline__ void tile_step(f32x16 (&o)[4], float& m_reg, float& l_reg, const char* Kt, int vb, bf16x8 (&qr)[8], int r32, int hi, float* al_l, bool do_mask, int thr, bool hasn, const char* Qbase, unsigned enext) {
    f32x16 p0, p1; qkt(p0, p1, Kt, qr, r32, hi); SBAR();
    if (do_mask && hasn) { const char* qnext = Qbase + (unsigned)((int)(enext & 4095u) * LDX + hi * 8) * 2u;
#pragma unroll
        for (int d0 = 0; d0 < 8; ++d0) qr[d0] = *reinterpret_cast<const bf16x8*>(qnext + d0 * 32); }
    if (do_mask) { const float ninf = -__builtin_inff(); asm volatile("" : "+v"(thr));
#pragma unroll
        for (int r = 0; r < 16; ++r) { const int c = (r & 3) + 8 * (r >> 2); p0[r] = (c <= thr) ? p0[r] : ninf; p1[r] = (c + 32 <= thr) ? p1[r] : ninf; } }
    float mn, alpha; partialSM(p0, p1, m_reg, mn, alpha);
    if (__any(alpha < 1.f)) {
#pragma unroll
        for (int d = 0; d < 4; ++d)
#pragma unroll
            for (int r = 0; r < 16; ++r) o[d][r] *= alpha; }
    bf16x8 pa0, pa1, pa2, pa3; finishSM(p0, p1, alpha, l_reg, pa0, pa1, pa2, pa3); SBAR();
    pv_d0(o, vb, pa0, pa1, pa2, pa3);
}

__device__ __forceinline__ void flash4(f32x16 (&o)[4], float& m_reg, float& l_reg, const char* K_lds, int vbase, bf16x8 (&qr)[8], int r32, int hi, bool hasn, const char* Qbase, unsigned enext) {
    f32x16 pA0, pA1, pB0, pB1; float mnA, mnB, alA, alB; bf16x8 pa0, pa1, pa2, pa3;
#define RESC1(a) do { if (__any((a) < 1.f)) { _Pragma("unroll") for (int d = 0; d < 4; ++d) _Pragma("unroll") for (int r = 0; r < 16; ++r) o[d][r] *= (a); } } while (0)
    qkt(pA0, pA1, K_lds, qr, r32, hi); partialSM(pA0, pA1, m_reg, mnA, alA);
    SBAR(); qkt(pB0, pB1, K_lds + 16384, qr, r32, hi); finishSM(pA0, pA1, alA, l_reg, pa0, pa1, pa2, pa3); SBAR();
    pv_d0<true>(o, vbase, pa0, pa1, pa2, pa3); partialSM(pB0, pB1, m_reg, mnB, alB); RESC1(alB);
    SBAR(); qkt(pA0, pA1, K_lds + 2 * 16384, qr, r32, hi); finishSM(pB0, pB1, alB, l_reg, pa0, pa1, pa2, pa3); SBAR();
    pv_d0(o, vbase + 16384, pa0, pa1, pa2, pa3); partialSM(pA0, pA1, m_reg, mnA, alA); RESC1(alA);
    SBAR(); qkt(pB0, pB1, K_lds + 3 * 16384, qr, r32, hi); SBAR();
    if (hasn) { const char* qnext = Qbase + (unsigned)((int)(enext & 4095u) * LDX + hi * 8) * 2u;
#pragma unroll
        for (int d0 = 0; d0 < 8; ++d0) qr[d0] = *reinterpret_cast<const bf16x8*>(qnext + d0 * 32); }
    finishSM(pA0, pA1, alA, l_reg, pa0, pa1, pa2, pa3); SBAR();
    pv_d0(o, vbase + 2 * 16384, pa0, pa1, pa2, pa3); partialSM(pB0, pB1, m_reg, mnB, alB); RESC1(alB);
    finishSM(pB0, pB1, alB, l_reg, pa0, pa1, pa2, pa3); SBAR();
    pv_d0(o, vbase + 3 * 16384, pa0, pa1, pa2, pa3);
#undef RESC1
}

__device__ __forceinline__ void kv_unit(const bf16* Qh, const bf16* Kh, const bf16* Vh, const unsigned short* selb, unsigned char* Oown, float* mlown, unsigned char* P, float* mlp, int j, char* lds, LAS unsigned char* ldsq) {
    const int tid = threadIdx.x, wid = __builtin_amdgcn_readfirstlane(tid >> 6), lane = tid & 63, r32 = lane & 31, hi = lane >> 5;
    char* K_lds = lds; char* V_lds = lds + 65536; char* xt = lds + XTRA_OFF;
    float* wsf = (float*)xt + wid * 64; float* li_l = wsf; float* al_l = wsf + 32;
    int* drow = (int*)(xt + 2048) + wid * 32;
    LAS int* cnt = (LAS int*)(ldsq + XTRA_OFF + 3072);
    LAS unsigned short* list = (LAS unsigned short*)(ldsq + XTRA_OFF + 3200);
    if (tid == 0) { int z_ = 0; asm volatile("" : "+v"(z_)); cnt[0] = z_; cnt[1] = z_; }
    int tid_s = threadIdx.x; asm volatile("" : "+v"(tid_s));
    const int sr = tid_s >> 4, sc = (tid_s & 15) * 8, vst0 = v_st(sr, sc), vst1 = v_st(32 + sr, sc);
    const unsigned ldoff0 = (unsigned)(sr * LDX + sc) * 2u, ldoff1 = ldoff0 + 32u * LDX * 2u;
    const char* kb = (const char*)Kh + (size_t)(j * 256) * (LDX * 2); const char* vbp = (const char*)Vh + (size_t)(j * 256) * (LDX * 2);
    bf16x8 kk[4][2], vv[4][2];
#pragma unroll
    for (int t = 0; t < 4; ++t) { const size_t to = (size_t)(t * 64) * (LDX * 2);
        kk[t][0] = *reinterpret_cast<const bf16x8*>(kb + to + ldoff0); kk[t][1] = *reinterpret_cast<const bf16x8*>(kb + to + ldoff1);
        vv[t][0] = *reinterpret_cast<const bf16x8*>(vbp + to + ldoff0); vv[t][1] = *reinterpret_cast<const bf16x8*>(vbp + to + ldoff1); }
    __syncthreads();
    {   unsigned sv[8];
#pragma unroll
        for (int k = 0; k < 8; ++k) { const int s = 256 * (j + 1) + k * 512 + tid_s; sv[k] = (s < SEQ) ? (unsigned)selb[s] : 0u; }
#pragma unroll
        for (int k = 0; k < 8; ++k) { const int s0 = 256 * (j + 1) + wid * 64 + k * 512;
            if (s0 < SEQ) { const int s = 256 * (j + 1) + k * 512 + tid_s; const unsigned v = sv[k];
                const bool hit = (v >> j) & 1u; const unsigned long long mk = __ballot(hit); const int nw = __builtin_popcountll(mk);
                int base = 0; if (lane == 0 && nw) base = __hip_atomic_fetch_add(&cnt[0], nw, __ATOMIC_RELAXED, __HIP_MEMORY_SCOPE_WORKGROUP);
                base = __builtin_amdgcn_readfirstlane(base);
                if (hit) list[base + __builtin_popcountll(mk & ((1ull << lane) - 1ull))] = (unsigned short)(s | (__builtin_popcount(v & ((1u << j) - 1u)) << 12)); } } }
#pragma unroll
    for (int t = 0; t < 4; ++t) { const int kc = sc * 2;
        *(bf16x8*)(K_lds + t * 16384 + KSWZ(sr, kc)) = kk[t][0]; *(bf16x8*)(K_lds + t * 16384 + KSWZ(32 + sr, kc)) = kk[t][1];
        *(bf16x8*)(V_lds + t * 16384 + vst0) = vv[t][0]; *(bf16x8*)(V_lds + t * 16384 + vst1) = vv[t][1]; }
    __syncthreads();
    const int n = cnt[0]; const int ngath = (n + 31) >> 5; const int ng = ngath + 8;
    const int vbase = (int)(uintptr_t)V_lds + v_rd_base(lane);
#define KV_TICKET(gv) do { int t_ = 0; if (lane == 0) t_ = __hip_atomic_fetch_add(&cnt[1], 1, __ATOMIC_RELAXED, __HIP_MEMORY_SCOPE_WORKGROUP); gv = __builtin_amdgcn_readfirstlane(t_); } while (0)
#define KV_META(gv, own_, wq_, e_, ntl_) do { own_ = (gv) >= ngath; wq_ = 7 - ((gv) - ngath);     \
        if (own_) { e_ = (unsigned)(256 * j + 32 * wq_ + r32) | 0x8000u; ntl_ = (wq_ >> 1) + 1; }          \
        else { const int idx_ = (gv) * 32 + r32; const bool v_ = idx_ < n; e_ = (unsigned)list[v_ ? idx_ : n - 1] | (v_ ? 0x8000u : 0u); ntl_ = 4; } } while (0)
#define KV_QOFF(e_) ((unsigned)((int)((e_) & 4095u) * LDX + hi * 8) * 2u)
#define KV_LOADQ(e_, q_) do { const char* Qc_ = (const char*)Qh; const unsigned qoff_ = KV_QOFF(e_); \
        _Pragma("unroll") for (int d0 = 0; d0 < 8; ++d0) q_[d0] = *reinterpret_cast<const bf16x8*>(Qc_ + qoff_ + d0 * 32); } while (0)
    int g; KV_TICKET(g);
    bool own = false; int wq = 0, ntl = 0; unsigned ecur = 0; bf16x8 qr[8];
    if (g < ng) { KV_META(g, own, wq, ecur, ntl); KV_LOADQ(ecur, qr); }
    while (g < ng) {
        int gn; KV_TICKET(gn);
        bool ownn = false; int wqn = 0, ntln = 0; unsigned enext = 0;
        const bool hasn = gn < ng;
        if (hasn) { KV_META(gn, ownn, wqn, enext, ntln); }
        float m_reg = -1e30f, l_reg = 0; f32x16 o[4];
        if (!own) flash4(o, m_reg, l_reg, K_lds, vbase, qr, r32, hi, hasn, (const char*)Qh, enext);
        else {
#pragma unroll
            for (int d = 0; d < 4; ++d) o[d] = f32x16{};
#pragma unroll 1
            for (int t = 0; t < ntl - 1; ++t)
                tile_step(o, m_reg, l_reg, K_lds + t * 16384, vbase + t * 16384, qr, r32, hi, al_l, false, 0, false, nullptr, 0u);
            { const int t = ntl - 1;
              tile_step(o, m_reg, l_reg, K_lds + t * 16384, vbase + t * 16384, qr, r32, hi, al_l, true, 32 * wq + r32 - 64 * t - 4 * hi, hasn, (const char*)Qh, enext); }
        }
        const float rl = __builtin_amdgcn_rcpf(l_reg);
        const int qs = (int)(ecur & 4095u), slot = (int)((ecur >> 12) & 3u); const bool valid = (ecur & 0x8000u) != 0u;
        char* rowp;
        if (own) { rowp = (char*)Oown + (size_t)qs * LDX; if (hi == 0) { float* mp = mlown + (size_t)qs * 2; mp[0] = m_reg; mp[1] = l_reg; } }
        else { const int i = qs >> 8; const int ns = nsl_of(i); const int prow = rowoff_of(i) + (qs & 255) * ns + slot; rowp = (char*)P + (size_t)prow * HD;
               if (hi == 0 && valid) { float* mp = mlp + (size_t)prow * 2; mp[0] = m_reg; mp[1] = l_reg; } }
        if (valid) { const float rs = rl * P8S;
#pragma unroll
            for (int d0 = 0; d0 < 4; ++d0)
#pragma unroll
                for (int kp = 0; kp < 2; ++kp) {
                    const unsigned a = pk4_fp8(o[d0][8 * kp + 0] * rs, o[d0][8 * kp + 1] * rs, o[d0][8 * kp + 2] * rs, o[d0][8 * kp + 3] * rs);
                    const unsigned b = pk4_fp8(o[d0][8 * kp + 4] * rs, o[d0][8 * kp + 5] * rs, o[d0][8 * kp + 6] * rs, o[d0][8 * kp + 7] * rs);
                    auto r = __builtin_amdgcn_permlane32_swap(a, b, false, false);
                    const u32x2 w = {r[0], r[1]};
                    *(u32x2*)(rowp + d0 * 32 + kp * 16 + hi * 8) = w; }
        }
        g = gn; own = ownn; wq = wqn; ecur = enext; ntl = ntln;
    }
#undef KV_TICKET
#undef KV_META
#undef KV_QOFF
#undef KV_LOADQ
    __syncthreads();
}
}

#define XB_TMO      128
#define XB_XCNT(j)  (256  + 64 * (j))
#define XB_XSUB(j)  (1280 + 64 * (j))
#define XB_XGEN(j)  (2304 + 64 * (j))
#define XB_TOP      3328
#define XB_TOPGEN   3392
#define XCD_BAR_WORDS 3456
#define XB_SPIN_CAP (1u << 18)
__device__ __forceinline__ unsigned xb_ld(unsigned* p)              { return __hip_atomic_load(p, __ATOMIC_RELAXED, __HIP_MEMORY_SCOPE_AGENT); }
__device__ __forceinline__ unsigned xb_add(unsigned* p, unsigned v) { return __hip_atomic_fetch_add(p, v, __ATOMIC_RELAXED, __HIP_MEMORY_SCOPE_AGENT); }
__device__ __forceinline__ unsigned xb_xcc_id() { return (unsigned)__builtin_amdgcn_s_getreg((3 << 11) | 20) & 0xFu; }
#define XB_SPIN(cond, bar) do { unsigned _sp = 0; while (cond) { __builtin_amdgcn_s_sleep(1); \
    if ((++_sp & 255u) == 0u) { if (xb_ld(&(bar)[XB_TMO])) break; if (_sp > XB_SPIN_CAP) { atomicAdd(&(bar)[XB_TMO], 1u); break; } } } } while (0)
struct XcdBarrier { unsigned* bar; unsigned x; volatile LAS unsigned* st; };
__device__ __forceinline__ XcdBarrier xcd_barrier_post(unsigned* bar, volatile LAS unsigned* st) {
    XcdBarrier b; b.bar = bar; b.x = xb_xcc_id(); b.st = st;
    if (threadIdx.x == 0) (void)xb_add(&bar[XB_XCNT(b.x)], 1u);
    return b;
}
__device__ __forceinline__ void xcd_barrier_complete(unsigned* bar, unsigned x, unsigned& nloc, unsigned& nx) {
    const unsigned G = gridDim.x * gridDim.y * gridDim.z;
    unsigned sum, cnt, mine, sp = 0u;
    for (;;) {
        sum = 0u; cnt = 0u; mine = 0u;
#pragma unroll
        for (unsigned j = 0; j < 16; ++j) { const unsigned c = xb_ld(&bar[XB_XCNT(j)]); sum += c; cnt += (c > 0u) ? 1u : 0u; mine = (j == x) ? c : mine; }
        if (sum == G) break;
        __builtin_amdgcn_s_sleep(1);
        if ((++sp & 255u) == 0u) { if (xb_ld(&bar[XB_TMO])) break; if (sp > XB_SPIN_CAP) { atomicAdd(&bar[XB_TMO], 1u); break; } }
    }
    nloc = mine > 0u ? mine : 1u; nx = cnt > 0u ? cnt : 1u;
}
__device__ __forceinline__ void xcd_barrier(const XcdBarrier& b) {
    asm volatile("s_waitcnt vmcnt(0)" ::: "memory");
    __syncthreads();
    if (threadIdx.x == 0) {
        unsigned* bar = b.bar;
        __builtin_amdgcn_s_waitcnt(0);
        unsigned nloc = b.st[0], nx = b.st[1];
        if (nloc == 0u) { xcd_barrier_complete(bar, b.x, nloc, nx); b.st[0] = nloc; b.st[1] = nx; }
        const unsigned old = xb_add(&bar[XB_XSUB(b.x)], 1u);
        const unsigned gen = old / nloc;
        if (old + 1u == (gen + 1u) * nloc) {
            __builtin_amdgcn_fence(__ATOMIC_RELEASE, "agent");
            asm volatile("s_waitcnt vmcnt(0)" ::: "memory");
            const unsigned og = xb_add(&bar[XB_TOP], 1u);
            const unsigned tg = og / nx;
            if (og + 1u == (tg + 1u) * nx) xb_add(&bar[XB_TOPGEN], 1u);
            else XB_SPIN(xb_ld(&bar[XB_TOPGEN]) == tg, bar);
            __builtin_amdgcn_fence(__ATOMIC_ACQUIRE, "agent");
            xb_add(&bar[XB_XGEN(b.x)], 1u);
            asm volatile("s_waitcnt vmcnt(0)" ::: "memory");
        } else {
            XB_SPIN(xb_ld(&bar[XB_XGEN(b.x)]) == gen, bar);
            __builtin_amdgcn_fence(__ATOMIC_ACQUIRE, "agent");
            asm volatile("s_waitcnt vmcnt(0)" ::: "memory");
        }
    }
    __syncthreads();
}

__constant__ double ROPE_C1[16] = {
    0.5403023058681398, 0.9045954518793624, 0.9812558362840286, 0.996355883049411, 0.9992929765482185, 0.9998628790459692, 0.9999734086383661, 0.9999948433117433,
    0.9999990000001666, 0.9999998060772615, 0.9999999623939693, 0.9999999927073353, 0.9999999985857865, 0.9999999997257518, 0.999999999946817, 0.9999999999896866};
__constant__ double ROPE_S1[16] = {
    0.8414709848078965, 0.4262711208130009, 0.19270958398204202, 0.08529334272279625, 0.0375971677311151, 0.01655968314629382, 0.007292600096474083, 0.0032114404746087437,
    0.0014142130909686214, 0.0006227723816580176, 0.00027424817223841217, 0.00012076973711788731, 5.31829589443792e-05, 2.3419998959268378e-05, 1.0313385377029628e-05, 4.541670480592256e-06};

__device__ __forceinline__ int sig32(int p) { return (p & 4) ? 16 + 4 * (p >> 3) + (p & 3) : 4 * (p >> 3) + (p & 3); }
__device__ __forceinline__ void tr_item(const float* src, int ldw, int k0, bf16* out, int K, const float* gk, const float* gn, bool sigma, LAS float* scr, int lane) {
    const int lr = lane >> 3, lc = (lane & 7) * 4;
#pragma unroll
    for (int i = 0; i < 8; ++i) { const int kk = 8 * i + lr; f32x4 v = *(const f32x4*)(src + (size_t)(k0 + kk) * ldw + lc); if (gk) v *= gk[k0 + kk];
        LAS float* d = scr + kk * 33 + lc; d[0] = v[0]; d[1] = v[1]; d[2] = v[2]; d[3] = v[3]; }
    LDS_WAIT(); asm volatile("" ::: "memory");
    const int c = lane & 7;
#pragma unroll
    for (int j = 0; j < 4; ++j) { const int n = (lane >> 3) + 8 * j; const int ns = sigma ? sig32(n) : n; const LAS float* s = scr + (8 * c) * 33 + ns; const float sc = gn ? gn[n] : 1.0f;
        u32x4 o; o.x = pk2(s[0 * 33] * sc, s[1 * 33] * sc); o.y = pk2(s[2 * 33] * sc, s[3 * 33] * sc); o.z = pk2(s[4 * 33] * sc, s[5 * 33] * sc); o.w = pk2(s[6 * 33] * sc, s[7 * 33] * sc);
        *(GAS u32x4*)(out + (size_t)n * K + k0 + 8 * c) = o; }
    LDS_WAIT(); asm volatile("" ::: "memory");
}

__device__ __forceinline__ void tr_load(const float* src, int ldw, int k0, int lane, f32x4 (&v)[8]) {
    const int lr = lane >> 3, lc = (lane & 7) * 4;
#pragma unroll
    for (int i = 0; i < 8; ++i) v[i] = __builtin_nontemporal_load((const GAS f32x4*)(src + (size_t)(k0 + 8 * i + lr) * ldw + lc));
}
__device__ __forceinline__ void tr_finish(const f32x4 (&v)[8], int k0, bf16* out, int K, const LAS float* gk, LAS float* scr, int lane) {
    const int lr = lane >> 3, lc = (lane & 7) * 4;
#pragma unroll
    for (int i = 0; i < 8; ++i) { LAS float* d = scr + (8 * i + lr) * 33 + lc; d[0] = v[i][0]; d[1] = v[i][1]; d[2] = v[i][2]; d[3] = v[i][3]; }
    LDS_WAIT(); asm volatile("" ::: "memory");
    const int c = lane & 7;
    f32x4 g0 = (f32x4){1.f, 1.f, 1.f, 1.f}, g1 = g0;
    if (gk) { g0 = *(const LAS f32x4*)(gk + k0 + 8 * c); g1 = *(const LAS f32x4*)(gk + k0 + 8 * c + 4); }
    float tv[4][8];
#pragma unroll
    for (int j = 0; j < 4; ++j) { const LAS float* s = scr + (8 * c) * 33 + (lane >> 3) + 8 * j;
#pragma unroll
        for (int e = 0; e < 8; ++e) tv[j][e] = s[e * 33]; }
    LDS_WAIT(); asm volatile("" ::: "memory");
#pragma unroll
    for (int j = 0; j < 4; ++j) { const int n = (lane >> 3) + 8 * j;
        u32x4 o; o.x = cvt_pk_bf16(tv[j][0] * g0[0], tv[j][1] * g0[1]); o.y = cvt_pk_bf16(tv[j][2] * g0[2], tv[j][3] * g0[3]); o.z = cvt_pk_bf16(tv[j][4] * g1[0], tv[j][5] * g1[1]); o.w = cvt_pk_bf16(tv[j][6] * g1[2], tv[j][7] * g1[3]);
        *(GAS u32x4*)(out + (size_t)n * K + k0 + 8 * c) = o; }
}

__device__ __forceinline__ void tr_finish8(const f32x4 (&v)[8], int k0, unsigned char* out, int Kb, const LAS float* gk, float sc, LAS float* scr, int lane, bool sigma = false) {
    const int lr = lane >> 3, lc = (lane & 7) * 4;
#pragma unroll
    for (int i = 0; i < 8; ++i) { LAS float* d = scr + (8 * i + lr) * 33 + lc; d[0] = v[i][0]; d[1] = v[i][1]; d[2] = v[i][2]; d[3] = v[i][3]; }
    LDS_WAIT(); asm volatile("" ::: "memory");
    const int c = lane & 7;
    f32x4 g0 = (f32x4){1.f, 1.f, 1.f, 1.f}, g1 = g0;
    if (gk) { g0 = *(const LAS f32x4*)(gk + k0 + 8 * c); g1 = *(const LAS f32x4*)(gk + k0 + 8 * c + 4); }
    g0 *= sc; g1 *= sc;
    float tv[4][8];
#pragma unroll
    for (int j = 0; j < 4; ++j) { const int n_ = (lane >> 3) + 8 * j; const LAS float* s = scr + (8 * c) * 33 + (sigma ? sig32(n_) : n_);
#pragma unroll
        for (int e = 0; e < 8; ++e) tv[j][e] = s[e * 33]; }
    LDS_WAIT(); asm volatile("" ::: "memory");
#pragma unroll
    for (int j = 0; j < 4; ++j) { const int n = (lane >> 3) + 8 * j;
        u32x2 o; o.x = pk4_fp8(tv[j][0] * g0[0], tv[j][1] * g0[1], tv[j][2] * g0[2], tv[j][3] * g0[3]); o.y = pk4_fp8(tv[j][4] * g1[0], tv[j][5] * g1[1], tv[j][6] * g1[2], tv[j][7] * g1[3]);
        *(GAS u32x2*)(out + (size_t)n * Kb + k0 + 8 * c) = o; }
}

#define rope_c ((float*)(unsigned char*)(wsp + WS_ROPE_C))
#define rope_s ((float*)(unsigned char*)(wsp + WS_ROPE_S))
#define kmean ((float*)(unsigned char*)(wsp + WS_KMEAN))
#define ss1 ((float*)(unsigned char*)(wsp + WS_SS1))
#define ss2 ((float*)(unsigned char*)(wsp + WS_SS2))
#define ss3 ((float*)(unsigned char*)(wsp + WS_SS3))
#define rstd3 ((float*)(unsigned char*)(wsp + WS_RSTD3))
#define gatew ((float*)(unsigned char*)(wsp + WS_GATEW))
#define ent ((unsigned*)(unsigned char*)(wsp + WS_ENT))
#define bcnt ((int*)(unsigned char*)(wsp + WS_BCNT))
#define soff ((unsigned*)(unsigned char*)(wsp + WS_SOFF))
#define srstd ((float*)(unsigned char*)(wsp + WS_SRSTD))
#define sdst ((int*)(unsigned char*)(wsp + WS_SDST))
#define sgw ((float*)(unsigned char*)(wsp + WS_SGW))
#define texp ((int*)(unsigned char*)(wsp + WS_TEXP))
#define w_pool ((bf16*)(unsigned char*)(wsp + WS_W_POOL))
#define w_qkv ((bf16*)(unsigned char*)(wsp + WS_W_QKV))
#define w_wo ((bf16*)(unsigned char*)(wsp + WS_W_WO))
#define w_fgu ((bf16*)(unsigned char*)(wsp + WS_W_FGU))
#define w_fd ((bf16*)(unsigned char*)(wsp + WS_W_FD))
#define w_mgu ((bf16*)(unsigned char*)(wsp + WS_W_MGU))
#define w_md ((bf16*)(unsigned char*)(wsp + WS_W_MD))
#define w_mgu8 ((unsigned char*)(wsp + WS_W_MGU))
#define w_md8 ((unsigned char*)(wsp + WS_W_MD))
#define h8buf ((unsigned char*)(wsp + WS_H8))
#define o8buf ((unsigned char*)(wsp + WS_Q))
#define h8abuf ((unsigned char*)(wsp + WS_PART))
#define hbuf ((bf16*)(unsigned char*)(wsp + WS_H))
#define pooled ((bf16*)(unsigned char*)(wsp + WS_POOLED))
#define fact ((bf16*)(unsigned char*)(wsp + WS_FACT))
#define qbuf ((bf16*)(unsigned char*)(wsp + WS_Q))
#define kbuf ((bf16*)(unsigned char*)(wsp + WS_K))
#define vbuf ((bf16*)(unsigned char*)(wsp + WS_V))
struct Args { const float* in[18]; float* out; unsigned char* ws; int ph_lo, ph_hi; };
constexpr int PH_P0 = 0, PH_POOL = 1, PH_FFN1 = 2, PH_FFN2 = 3, PH_QKV = 4, PH_SEL = 5, PH_KV = 6, PH_COMB = 7, PH_WO = 8, PH_ROUTE = 9, PH_LIST = 10, PH_MOE0 = 11, PH_FINAL = PH_MOE0 + MOE_STEPS, PH_COUNT = PH_FINAL + 1;

__global__ void __launch_bounds__(NWAVES * 64, 2) yoco_fwd(Args args) {
    extern __shared__ __attribute__((aligned(16))) unsigned char lds_raw[];
    LAS unsigned char* lds = (LAS unsigned char*)lds_raw;
    volatile LAS unsigned* MISC = (volatile LAS unsigned*)(lds + MISC_OFF);
    const int tid = threadIdx.x, lane = tid & 63, wave = __builtin_amdgcn_readfirstlane(tid >> 6);
    const int G = gridDim.x; const int bx = blockIdx.x; const int vcu = (G % 8 == 0) ? (bx % 8) * (G / 8) + bx / 8 : bx;
    unsigned char* ws = args.ws;
    unsigned* ctl = (unsigned*)(ws + WS_CTL);
    typedef const __attribute__((address_space(4))) Args* KArgs;
    KArgs kap = (KArgs)__builtin_amdgcn_kernarg_segment_ptr();
#define PIN_ARGS() asm volatile("" : "+s"(kap))
    GAS unsigned char* wsp = (GAS unsigned char*)ws;
#define obuf ((unsigned char*)kap->out)
#define y8buf ((unsigned char*)(wsp + WS_Y8))
    for (int u = tid; u < (LDS_BYTES - LDSCTL_OFF) / 4; u += NWAVES * 64) ((LAS unsigned*)(lds + LDSCTL_OFF))[u] = 0u;
    __syncthreads();
    const bool one_launch = (args.ph_hi - args.ph_lo) > 1;
    XcdBarrier bar; bar.bar = ctl + CW_BAR; bar.x = 0; bar.st = nullptr;
    if (one_launch) bar = xcd_barrier_post(ctl + CW_BAR, MISC + 8);
    const int lo = args.ph_lo, hi = args.ph_hi;
#ifndef PHMASK
#define PHMASK 0xffffffffu
#endif
#define IN(k) (((PHMASK >> ((k) < 31 ? (k) : 31)) & 1u) && lo <= (k) && (k) < hi)
#define SEAM(k) do { if (IN(k) && IN((k) + 1)) xcd_barrier(bar); } while (0)
    const int gw = vcu * NWAVES + wave, NGW = G * NWAVES;

#ifndef REP_P0
#define REP_P0 1
#endif
    for (int rep = 0; rep < REP_P0; ++rep) { if (rep) xcd_barrier(bar);
    if (IN(PH_P0)) {
        wsp = (GAS unsigned char*)ws; asm volatile("" : "+s"(wsp)); PIN_ARGS(); const float* x = kap->in[0]; const float* attn_norm = kap->in[1]; const float* ffn_norm = kap->in[2]; const float* pool_w = kap->in[3]; const float* pool_scale = kap->in[4]; const float* wq = kap->in[5]; const float* wo = kap->in[6]; const float* kv_norm = kap->in[7]; const float* wk = kap->in[8]; const float* wv = kap->in[9]; const float* fwg = kap->in[10]; const float* fwu = kap->in[11]; const float* fwd = kap->in[12];
        for (int i = bx * 512 + tid; i < SEQ * 16; i += G * 512) { const int s = i >> 4, d = i & 15; double c = 1.0, sn = 0.0, bc = ROPE_C1[d], bs = ROPE_S1[d];
            for (int b = 0; b < 12; ++b) { if ((s >> b) & 1) { const double nc = c * bc - sn * bs, ns = sn * bc + c * bs; c = nc; sn = ns; } const double nbc = bc * bc - bs * bs, nbs = 2.0 * bc * bs; bc = nbc; bs = nbs; }
            rope_c[i] = (float)c; rope_s[i] = (float)sn; }
        for (int i = bx * 512 + tid; i < NBATCH * NH * NBLK * HD; i += G * 512) kmean[i] = 0.f;
        {
            LAS float* rsl = (LAS float*)(lds + XTRA_OFF);
            for (int chunk = vcu; chunk < T / 128; chunk += G) {
                const int t0 = chunk * 128, p0 = t0 & (SEQ - 1);
                for (int r0 = wave; r0 < 143; r0 += 6 * NWAVES) {
                    float s6[6];
#pragma unroll
                    for (int q = 0; q < 6; ++q) { const int rr = r0 + q * NWAVES; const int t = t0 - 15 + rr; float s = 0.f;
                        if (rr < 143 && p0 + rr - 15 >= 0) { const GAS f32x4* xr = (const GAS f32x4*)(x + (size_t)t * D) + lane;
#pragma unroll
                            for (int j = 0; j < 4; ++j) { const f32x4 v = xr[64 * j]; s += (v[0] * v[0] + v[1] * v[1]) + (v[2] * v[2] + v[3] * v[3]); } }
                        s6[q] = s; }
#pragma unroll
                    for (int q = 0; q < 6; ++q) { const int rr = r0 + q * NWAVES; const float s = wave_sum(s6[q]); if (lane == 0 && rr < 143) rsl[rr] = 1.0f / sqrtf(s * (1.0f / D) + EPS); }
                }
                __syncthreads();
                const int tb = t0 + wave * 16;
                const int pb = tb & (SEQ - 1);
#pragma unroll
                for (int jh = 0; jh < 8; ++jh) {
                    const int j = jh >> 1, hh = jh & 1; const int w = 2 << j; const int tq = tb + 8 * hh, pq = pb + 8 * hh;
                    const f32x4 g = *(const f32x4*)(attn_norm + 256 * j + 4 * lane);
                    f32x4 v[23];
                    const char* xb = (const char*)x + ((size_t)(tq - 15) * D + 256 * j) * 4; const unsigned lo = (unsigned)lane * 16u;
#pragma unroll
                    for (int r = 0; r < 23; ++r) { const bool need = (r >= 16 - w) && (pq - 15 + r >= 0);
                        if (need) { const float rs = __builtin_bit_cast(float, __builtin_amdgcn_readfirstlane(__builtin_bit_cast(int, rsl[wave * 16 + 8 * hh + r]))); v[r] = *(const f32x4*)(xb + (size_t)r * (D * 4) + lo) * (rs * g); }
                        else v[r] = (f32x4){0.f, 0.f, 0.f, 0.f}; }
#pragma unroll
                    for (int i = 0; i < 8; ++i) { const int pos = pq + i; f32x4 S = v[15 + i];
#pragma unroll
                        for (int d = 1; d < w; ++d) S += v[15 + i - d];
                        const float inv = 1.0f / (float)(pos + 1 < w ? pos + 1 : w); const f32x4 o = S * inv - v[15 + i];
                        u32x2 pk; pk.x = pk2(o[0], o[1]); pk.y = pk2(o[2], o[3]); *(u32x2*)(pooled + (size_t)(tq + i) * D + 256 * j + 4 * lane) = pk; }
                    asm volatile("" ::: "memory");
                }
                __syncthreads();
            }
        }
#if QKV_FP8 && WO_FP8 && !FFN1_FP8 && FFN2_FP8
        {
            LAS float* scr = (LAS float*)(lds + RING_OFF + wave * 16384);
            LAS float* gk0 = (LAS float*)(lds + XTRA_OFF + 8192); LAS float* gq = (LAS float*)(lds + XTRA_OFF + 12288); LAS float* gkv = gq + D;
            for (int i = tid; i < D; i += NWAVES * 64) { gk0[i] = ffn_norm[i]; gq[i] = attn_norm[D + i]; gkv[i] = kv_norm[i]; }
            __syncthreads();
            constexpr int I_QKV = 128, I_WO = I_QKV + 1536, I_FGU = I_WO + 512, I_FD = I_FGU + 16 * 176, I_END = I_FD + 44 * 32;
#define P0_DEC(itg_, S_, L_, K0_, O_, KB_, G_, SC_, SG_, T8_) do { const int g_ = (itg_); \
        if (g_ < I_WO) { const int it_ = g_ - I_QKV, which_ = it_ >> 9, r_ = it_ & 511, kb_ = r_ >> 5, nb_ = r_ & 31; S_ = (which_ == 0 ? wq : (which_ == 1 ? wk : wv)) + nb_ * 32; L_ = D; K0_ = kb_ * 64; \
            O_ = (unsigned char*)w_qkv + (size_t)(which_ * 1024 + nb_ * 32) * D; KB_ = D; G_ = which_ == 0 ? gq : gkv; SC_ = W8S_GU; SG_ = which_ < 2 && (nb_ & 3) == 0; T8_ = true; } \
        else if (g_ < I_FGU) { const int it_ = g_ - I_WO, kb_ = it_ >> 5, nb_ = it_ & 31; S_ = wo + nb_ * 32; L_ = D; K0_ = kb_ * 64; O_ = (unsigned char*)w_wo + (size_t)(nb_ * 32) * D; KB_ = D; G_ = nullptr; SC_ = W8S_GU; SG_ = false; T8_ = true; } \
        else if (g_ < I_FD) { const int it_ = g_ - I_FGU, kb_ = it_ / 176, nb_ = it_ % 176, n0_ = nb_ * 32, pn_ = n0_ >> 8, r_ = n0_ & 255; S_ = (r_ < 128 ? fwg : fwu) + pn_ * 128 + (r_ & 127); L_ = FF; K0_ = kb_ * 64; \
            O_ = (unsigned char*)(w_fgu + (size_t)n0_ * D); KB_ = D; G_ = gk0; SC_ = 1.0f; SG_ = false; T8_ = false; } \
        else { const int it_ = g_ - I_FD, kb_ = it_ >> 5, nb_ = it_ & 31; S_ = fwd + nb_ * 32; L_ = D; K0_ = kb_ * 64; O_ = (unsigned char*)w_fd + (size_t)(nb_ * 32) * FF; KB_ = FF; G_ = nullptr; SC_ = W8S_DN; SG_ = false; T8_ = true; } } while (0)
#define P0_FIN(B_, K0_, O_, KB_, G_, SC_, SG_, T8_) do { if (T8_) tr_finish8(B_, K0_, O_, KB_, G_, SC_, scr, lane, SG_); else tr_finish(B_, K0_, (bf16*)(O_), KB_, G_, scr, lane); } while (0)
            int it0 = gw;
            if (it0 < I_QKV) { const int g = it0 >> 5, r = it0 & 31, kb = r >> 3, nb = r & 7;
                tr_item(pool_w + (size_t)g * 65536 + nb * 32, 256, kb * 64, w_pool + (size_t)(g * 256 + nb * 32) * 256, 256, nullptr, pool_scale + g * 256 + nb * 32, false, scr, lane); it0 += NGW; }
            const int it1 = it0 + NGW, it2 = it1 + NGW, it3 = it2 + NGW;
            f32x4 bA[8], bB[8]; const float* sA; const float* sB; int lA, lB, kA, kB, KA, KB; unsigned char* oA; unsigned char* oB; const LAS float* gA; const LAS float* gB; float cA, cB; bool zA, zB, tA, tB;
            if (it0 < I_END) { P0_DEC(it0, sA, lA, kA, oA, KA, gA, cA, zA, tA); tr_load(sA, lA, kA, lane, bA); }
            if (it1 < I_END) { P0_DEC(it1, sB, lB, kB, oB, KB, gB, cB, zB, tB); tr_load(sB, lB, kB, lane, bB); }
            if (it0 < I_END) P0_FIN(bA, kA, oA, KA, gA, cA, zA, tA);
            if (it2 < I_END) { P0_DEC(it2, sA, lA, kA, oA, KA, gA, cA, zA, tA); tr_load(sA, lA, kA, lane, bA); }
            if (it1 < I_END) P0_FIN(bB, kB, oB, KB, gB, cB, zB, tB);
            if (it3 < I_END) { P0_DEC(it3, sB, lB, kB, oB, KB, gB, cB, zB, tB); tr_load(sB, lB, kB, lane, bB); }
            if (it2 < I_END) P0_FIN(bA, kA, oA, KA, gA, cA, zA, tA);
            if (it3 < I_END) P0_FIN(bB, kB, oB, KB, gB, cB, zB, tB);
#undef P0_DEC
#undef P0_FIN
        }
#else
        {
            LAS float* scr = (LAS float*)(lds + RING_OFF + wave * 16384);
            for (int it = gw; it < 128; it += NGW) { const int g = it >> 5, r = it & 31, kb = r >> 3, nb = r & 7;
                tr_item(pool_w + (size_t)g * 65536 + nb * 32, 256, kb * 64, w_pool + (size_t)(g * 256 + nb * 32) * 256, 256, nullptr, pool_scale + g * 256 + nb * 32, false, scr, lane); }
#if QKV_FP8
            LAS float* gq = (LAS float*)(lds + XTRA_OFF + 12288); LAS float* gkv = gq + D;
            for (int i = tid; i < D; i += NWAVES * 64) { gq[i] = attn_norm[D + i]; gkv[i] = kv_norm[i]; }
            __syncthreads();
#endif
            for (int it = gw; it < 1536; it += NGW) { const int which = it >> 9, r = it & 511, kb = r >> 5, nb = r & 31;
                const float* W = which == 0 ? wq : (which == 1 ? wk : wv);
#if QKV_FP8
                f32x4 b8[8]; tr_load(W + nb * 32, D, kb * 64, lane, b8); tr_finish8(b8, kb * 64, (unsigned char*)w_qkv + (size_t)(which * 1024 + nb * 32) * D, D, which == 0 ? gq : gkv, W8S_GU, scr, lane, which < 2 && (nb & 3) == 0); LDS_WAIT();
#else
                const float* gk = which == 0 ? attn_norm + D : kv_norm;
                tr_item(W + nb * 32, D, kb * 64, w_qkv + (size_t)(which * 1024 + nb * 32) * D, D, gk, nullptr, which < 2 && (nb & 3) == 0, scr, lane);
#endif
            }
            for (int it = gw; it < 512; it += NGW) { const int kb = it >> 5, nb = it & 31;
#if WO_FP8
                f32x4 b8[8]; tr_load(wo + nb * 32, D, kb * 64, lane, b8); tr_finish8(b8, kb * 64, (unsigned char*)w_wo + (size_t)(nb * 32) * D, D, nullptr, W8S_GU, scr, lane); LDS_WAIT();
#else
                tr_item(wo + nb * 32, D, kb * 64, w_wo + (size_t)(nb * 32) * D, D, nullptr, nullptr, false, scr, lane);
#endif
            }
#if FFN1_FP8
            LAS float* gk0 = (LAS float*)(lds + XTRA_OFF + 8192);
            for (int i = tid; i < D; i += NWAVES * 64) gk0[i] = ffn_norm[i];
            __syncthreads();
#endif
            for (int it = gw; it < 16 * 176; it += NGW) { const int kb = it / 176, nb = it % 176, n0 = nb * 32, pn = n0 >> 8, r = n0 & 255;
                const float* W = (r < 128 ? fwg : fwu) + pn * 128 + (r & 127);
#if FFN1_FP8
                f32x4 b8[8]; tr_load(W, FF, kb * 64, lane, b8); tr_finish8(b8, kb * 64, (unsigned char*)w_fgu + (size_t)n0 * D, D, gk0, W8S_GU, scr, lane); LDS_WAIT();
#else
                tr_item(W, FF, kb * 64, w_fgu + (size_t)n0 * D, D, ffn_norm, nullptr, false, scr, lane);
#endif
            }
            for (int it = gw; it < 44 * 32; it += NGW) { const int kb = it >> 5, nb = it & 31;
#if FFN2_FP8
                f32x4 b8[8]; tr_load(fwd + nb * 32, D, kb * 64, lane, b8); tr_finish8(b8, kb * 64, (unsigned char*)w_fd + (size_t)(nb * 32) * FF, FF, nullptr, W8S_DN, scr, lane); LDS_WAIT();
#else
                tr_item(fwd + nb * 32, D, kb * 64, w_fd + (size_t)(nb * 32) * FF, FF, nullptr, nullptr, false, scr, lane);
#endif
            }
        }
#endif
    }
    }
    SEAM(PH_P0);

    if (IN(PH_POOL)) {
        wsp = (GAS unsigned char*)ws; asm volatile("" : "+s"(wsp)); PIN_ARGS(); const float* x = kap->in[0];
        ProbDense pr{(const char*)pooled, (const char*)w_pool, 256, D, 512};
        pg8::StaticOrder S; S.init(T / 256, 4, G, bx);
        EpiRes<true> E{x, hbuf, ss1, FFN1_FP8 ? h8abuf : nullptr, 1.0f};
        pg8::gemm_phase(lds + RING_OFF, pr, S, E);
    }
    SEAM(PH_POOL);

#ifndef REP_FFN1
#define REP_FFN1 1
#endif
    for (int rep = 0; rep < REP_FFN1; ++rep) { if (rep) xcd_barrier(bar);
    if (IN(PH_FFN1)) {
        wsp = (GAS unsigned char*)ws; asm volatile("" : "+s"(wsp)); PIN_ARGS();
        ProbDenseT<FFN1_FP8 != 0> pr{FFN1_FP8 ? (const char*)h8abuf : (const char*)hbuf, (const char*)w_fgu, FFN1_FP8 ? D / 2 : D, FFN1_FP8 ? D / 2 : D, 0};
        pg8::StaticOrder S; S.init(T / 256, 2 * FF / 256, G, bx);
        EpiSwiGLU<false, FF, FFN2_FP8 != 0, FFN1_FP8 != 0> E{fact, RstdTable{ss1, -1, 0}, nullptr, 0, 1 << 30, nullptr};
        pg8::gemm_phase(lds + RING_OFF, pr, S, E);
    }
    }
    SEAM(PH_FFN1);

    if (IN(PH_FFN2)) {
        wsp = (GAS unsigned char*)ws; asm volatile("" : "+s"(wsp)); PIN_ARGS();
        ProbDenseT<FFN2_FP8 != 0> pr{(const char*)fact, (const char*)w_fd, FFN2_FP8 ? FF / 2 : FF, FFN2_FP8 ? FF / 2 : FF, 0};
        pg8::StaticOrder S; S.init(T / 256, 4, G, bx);
        EpiRes<false> E{nullptr, hbuf, ss2, QKV_FP8 ? h8abuf : nullptr, FFN2_FP8 ? 1.0f / (W8S_DN * ACT8S) : 1.0f};
        pg8::gemm_phase(lds + RING_OFF, pr, S, E);
    }
    SEAM(PH_FFN2);

    if (IN(PH_QKV)) {
        wsp = (GAS unsigned char*)ws; asm volatile("" : "+s"(wsp)); PIN_ARGS();
        ProbDenseT<QKV_FP8 != 0> pr{QKV_FP8 ? (const char*)h8abuf : (const char*)hbuf, (const char*)w_qkv, QKV_FP8 ? D / 2 : D, QKV_FP8 ? D / 2 : D, 0};
        pg8::StaticOrder S; S.init(T / 256, 12, G, bx);
        EpiQKV E{qbuf, RstdTable{ss2, -1, 0}, rope_c, rope_s, kmean};
        pg8::gemm_phase(lds + RING_OFF, pr, S, E);
    }
    SEAM(PH_QKV);

#ifndef REP_SEL
#define REP_SEL 1
#endif
    for (int rep = 0; rep < REP_SEL; ++rep) { if (rep) xcd_barrier(bar);
    if (IN(PH_SEL)) {
        wsp = (GAS unsigned char*)ws; asm volatile("" : "+s"(wsp)); PIN_ARGS();
        unsigned short* selbuf = (unsigned short*)((unsigned char*)(wsp + WS_SEL));
        char* kmL = (char*)lds_raw + XTRA_OFF + 4096;
#define SEL_BLK(s4_, k_) ((k_) == 0 ? (s4_) : ((k_) == 1 ? 7 - (s4_) : ((k_) == 2 ? 8 + (s4_) : 15 - (s4_))))
        for (int v2 = vcu; v2 < 256; v2 += G) {
            const int bh = v2 >> 2, s4 = v2 & 3, b = bh >> 3, h = bh & 7;
            bf16x8 q4[4][8];
#pragma unroll
            for (int k = 0; k < 4; ++k) att::sel_load(qbuf + ((size_t)(b * SEQ + SEL_BLK(s4, k) * 256)) * D + h * HD, q4[k]);
            att::sel_tile_fill(kmL, kmean + (size_t)bh * NBLK * HD);
            __syncthreads();
#pragma unroll
            for (int k = 0; k < 4; ++k) att::sel_unit(q4[k], kmL, selbuf + (size_t)bh * SEQ + SEL_BLK(s4, k) * 256, SEL_BLK(s4, k));
            __syncthreads();
        }
    }
    }
    SEAM(PH_SEL);

#ifndef REP_KV
#define REP_KV 1
#endif
    for (int rep = 0; rep < REP_KV; ++rep) { if (rep) xcd_barrier(bar);
    if (IN(PH_KV)) {
        wsp = (GAS unsigned char*)ws; asm volatile("" : "+s"(wsp)); PIN_ARGS();
        const bool convfirst = (G == 256) && bx >= G - CONV_WGS;
        auto conv_pass = [&]() {
            wsp = (GAS unsigned char*)ws; asm volatile("" : "+s"(wsp)); PIN_ARGS();
            int tid_c = threadIdx.x; asm volatile("" : "+v"(tid_c)); const int tid = tid_c;
            const float* ffn_norm = kap->in[2]; const float* mwg = kap->in[14]; const float* mwu = kap->in[15]; const float* mwd = kap->in[16];
            constexpr int N_GU = NE * 16 * 224, N_DN = NE * 56 * 32, TK_ITEMS = 64;
            LAS float* scr = (LAS float*)(lds + RING_OFF + wave * 16384); int lane_c = threadIdx.x; asm volatile("" : "+v"(lane_c)); lane_c &= 63;
            LAS float* gkL = (LAS float*)(lds + XTRA_OFF + 16384);
            LAS int* tkL = (LAS int*)(lds + XTRA_OFF + 20480);
            for (int i = tid; i < D; i += NWAVES * 64) gkL[i] = ffn_norm[D + i];
#define MOE_ITEM(it_, S_, L_, K0_, O_, KK_, G_) do { if ((it_) < N_GU) { const int e_ = (it_) / (16 * 224), r2_ = (it_) % (16 * 224), kb_ = r2_ / 224, nb_ = r2_ % 224, n0_ = nb_ * 32, pn_ = n0_ >> 8, r_ = n0_ & 255; \
        S_ = (r_ < 128 ? mwg : mwu) + (size_t)e_ * D * FE + pn_ * 128 + (r_ & 127); L_ = FE; K0_ = kb_ * 64; O_ = w_mgu8 + ((size_t)e_ * 2 * FE + n0_) * D; KK_ = D; G_ = gkL; } \
    else { const int i2_ = (it_) - N_GU; const int e_ = i2_ / (56 * 32), r2_ = i2_ % (56 * 32), kb_ = r2_ >> 5, nb_ = r2_ & 31; \
        S_ = mwd + (size_t)e_ * FE * D + nb_ * 32; L_ = D; K0_ = kb_ * 64; O_ = w_md8 + ((size_t)e_ * D + nb_ * 32) * FE; KK_ = FE; G_ = nullptr; } } while (0)
            __syncthreads();
            if (tid == 0) tkL[0] = (int)__hip_atomic_fetch_add(ctl + CW_CONVQ, 1u, RLX_AGENT);
            for (;;) {
                __syncthreads();
                const int tk = tkL[0];
                if (tk * TK_ITEMS >= N_GU + N_DN) break;
                int tnx = 0; if (tid == 0) tnx = (int)__hip_atomic_fetch_add(ctl + CW_CONVQ, 1u, RLX_AGENT);
                const int i0 = tk * TK_ITEMS + wave * 8;
                const float sc = (tk * TK_ITEMS < N_GU) ? W8S_GU : W8S_DN;
                f32x4 bA[8], bB[8], bC[8], bD[8]; const float* sA; const float* sB; const float* sC; const float* sD; int lA, lB, lC, lD, kA, kB, kC, kD, KA, KB, KC, KD;
                unsigned char* oA; unsigned char* oB; unsigned char* oC; unsigned char* oD; const LAS float* gA; const LAS float* gB; const LAS float* gC; const LAS float* gD;
                MOE_ITEM(i0, sA, lA, kA, oA, KA, gA); tr_load(sA, lA, kA, lane_c, bA);
                MOE_ITEM(i0 + 1, sB, lB, kB, oB, KB, gB); tr_load(sB, lB, kB, lane_c, bB);
                MOE_ITEM(i0 + 2, sC, lC, kC, oC, KC, gC); tr_load(sC, lC, kC, lane_c, bC);
                MOE_ITEM(i0 + 3, sD, lD, kD, oD, KD, gD); tr_load(sD, lD, kD, lane_c, bD);
                tr_finish8(bA, kA, oA, KA, gA, sc, scr, lane_c); MOE_ITEM(i0 + 4, sA, lA, kA, oA, KA, gA); tr_load(sA, lA, kA, lane_c, bA);
                tr_finish8(bB, kB, oB, KB, gB, sc, scr, lane_c); MOE_ITEM(i0 + 5, sB, lB, kB, oB, KB, gB); tr_load(sB, lB, kB, lane_c, bB);
                tr_finish8(bC, kC, oC, KC, gC, sc, scr, lane_c); MOE_ITEM(i0 + 6, sC, lC, kC, oC, KC, gC); tr_load(sC, lC, kC, lane_c, bC);
                tr_finish8(bD, kD, oD, KD, gD, sc, scr, lane_c); MOE_ITEM(i0 + 7, sD, lD, kD, oD, KD, gD); tr_load(sD, lD, kD, lane_c, bD);
                tr_finish8(bA, kA, oA, KA, gA, sc, scr, lane_c);
                tr_finish8(bB, kB, oB, KB, gB, sc, scr, lane_c);
                tr_finish8(bC, kC, oC, KC, gC, sc, scr, lane_c);
                tr_finish8(bD, kD, oD, KD, gD, sc, scr, lane_c);
                __syncthreads();
                if (tid == 0) tkL[0] = tnx;
            }
#undef MOE_ITEM
            __syncthreads();
        };
        if (convfirst) conv_pass();
        {
            wsp = (GAS unsigned char*)ws; asm volatile("" : "+s"(wsp)); PIN_ARGS();
            const unsigned short* selbuf = (const unsigned short*)((unsigned char*)(wsp + WS_SEL));
            unsigned char* part = (unsigned char*)(wsp + WS_PART); float* mlp = (float*)((unsigned char*)(wsp + WS_MLP)); float* mlown = (float*)((unsigned char*)(wsp + WS_MLOWN));
            const int xq = bx & 7; unsigned* kvq = ctl + CW_KVQ + (rep * 8 + xq) * 64;
            LAS int* tkq = (LAS int*)(lds + XTRA_OFF + 3088);
            if (tid == 0) tkq[0] = (int)__hip_atomic_fetch_add(kvq, 1u, RLX_AGENT);
            for (;;) {
                __syncthreads();
                const int tk = tkq[0];
                if (tk >= 128) break;
                int tnx = 0; if (tid == 0) tnx = (int)__hip_atomic_fetch_add(kvq, 1u, RLX_AGENT);
                const int jb = tk >> 3, bh = 8 * xq + (tk & 7), b = bh >> 3, h = bh & 7;
                const size_t hb = (size_t)b * SEQ * D + h * HD;
                att::kv_unit(qbuf + hb, kbuf + hb, vbuf + hb, selbuf + (size_t)bh * SEQ, obuf + hb, mlown + (size_t)bh * SEQ * 2, part + (size_t)bh * att::PROWS * HD, mlp + (size_t)bh * att::PROWS * 2, jb,
                             (char*)lds_raw + RING_OFF, lds + RING_OFF);
                if (tid == 0) tkq[0] = tnx;
            }
            __syncthreads();
        }
        if (!convfirst) conv_pass();
    }
    }
    SEAM(PH_KV);

    if (IN(PH_COMB)) {
        wsp = (GAS unsigned char*)ws; asm volatile("" : "+s"(wsp)); PIN_ARGS();
        const unsigned char* part = (const unsigned char*)(wsp + WS_PART); const float* mlp = (const float*)((unsigned char*)(wsp + WS_MLP)); const float* mlown = (const float*)((unsigned char*)(wsp + WS_MLOWN));
        constexpr float C = att::SCALE * 1.4426950408889634f;
        constexpr int NIT = T * NH * 16;
        const int stride = G * 512;
#pragma unroll 1
        for (int base = vcu * 512 + tid; base < NIT; base += 4 * stride) {
            u32x2 ow[4]; u32x2 pw[4][3]; float m0[4], l0[4], mk[4][3], lk[4][3]; int nsv[4]; size_t opv[4];
#pragma unroll
            for (int u = 0; u < 4; ++u) {
                const int idx = base + u * stride; const int c8 = idx & 15; const int qh = idx >> 4; const int h = qh & 7, tq = qh >> 3, b = tq >> 12, s = tq & (SEQ - 1), i = s >> 8, ns = att::nsl_of(i), bh = b * NH + h;
                opv[u] = (size_t)tq * D + h * HD + c8 * 8; nsv[u] = ns;
                ow[u] = *(const u32x2*)(obuf + opv[u]);
                const f32x2 ml0 = *(const f32x2*)(mlown + ((size_t)bh * SEQ + s) * 2); m0[u] = ml0[0]; l0[u] = ml0[1];
                const size_t prow = (size_t)bh * att::PROWS + att::rowoff_of(i) + (s & 255) * ns;
#pragma unroll
                for (int k = 0; k < 3; ++k) { const size_t pr = prow + (k < ns ? k : 0);
                    const f32x2 mlk = *(const f32x2*)(mlp + pr * 2); mk[u][k] = mlk[0]; lk[u][k] = mlk[1]; pw[u][k] = *(const u32x2*)(part + pr * HD + c8 * 8); }
            }
#pragma unroll
            for (int u = 0; u < 4; ++u) {
                float M = m0[u];
#pragma unroll
                for (int k = 0; k < 3; ++k) if (k < nsv[u]) M = fmaxf(M, mk[u][k]);
                const float w0 = l0[u] * __builtin_amdgcn_exp2f((m0[u] - M) * C); float W = w0;
                float acc[8]; { float f0[4], f1[4]; up4_fp8(ow[u].x, f0); up4_fp8(ow[u].y, f1); const float ws0 = w0 * (1.0f / P8S);
                    acc[0] = f0[0] * ws0; acc[1] = f0[1] * ws0; acc[2] = f0[2] * ws0; acc[3] = f0[3] * ws0; acc[4] = f1[0] * ws0; acc[5] = f1[1] * ws0; acc[6] = f1[2] * ws0; acc[7] = f1[3] * ws0; }
#pragma unroll
                for (int k = 0; k < 3; ++k) { const float wk = (k < nsv[u]) ? lk[u][k] * __builtin_amdgcn_exp2f((mk[u][k] - M) * C) : 0.f; W += wk; const u32x2 p = pw[u][k];
                    float f0[4], f1[4]; up4_fp8(p.x, f0); up4_fp8(p.y, f1); const float ws = wk * (1.0f / P8S);
                    acc[0] += f0[0] * ws; acc[1] += f0[1] * ws; acc[2] += f0[2] * ws; acc[3] += f0[3] * ws; acc[4] += f1[0] * ws; acc[5] += f1[1] * ws; acc[6] += f1[2] * ws; acc[7] += f1[3] * ws; }
                const float iw = (WO_FP8 ? O8S : 1.0f) / W;
                u32x4 o; o.x = cvt_pk_bf16(acc[0] * iw, acc[1] * iw); o.y = cvt_pk_bf16(acc[2] * iw, acc[3] * iw); o.z = cvt_pk_bf16(acc[4] * iw, acc[5] * iw); o.w = cvt_pk_bf16(acc[6] * iw, acc[7] * iw);
#if WO_FP8
                { u32x2 o8; o8.x = pk4_fp8(acc[0] * iw, acc[1] * iw, acc[2] * iw, acc[3] * iw); o8.y = pk4_fp8(acc[4] * iw, acc[5] * iw, acc[6] * iw, acc[7] * iw); *(u32x2*)(o8buf + opv[u]) = o8; }
#else
                *(u32x4*)opv[u] = o;
#endif
            }
        }
    }
    SEAM(PH_COMB);

    if (IN(PH_WO)) {
        wsp = (GAS unsigned char*)ws; asm volatile("" : "+s"(wsp)); PIN_ARGS();
        ProbDenseT<WO_FP8 != 0> pr{WO_FP8 ? (const char*)o8buf : (const char*)obuf, (const char*)w_wo, WO_FP8 ? D / 2 : D, WO_FP8 ? D / 2 : D, 0};
        pg8::StaticOrder S; S.init(T / 256, 4, G, bx);
        EpiRes<false> E{nullptr, hbuf, ss3, h8buf, WO_FP8 ? 1.0f / (W8S_GU * O8S) : 1.0f};
        pg8::gemm_phase(lds + RING_OFF, pr, S, E);
    }
    SEAM(PH_WO);

    if (IN(PH_ROUTE)) {
        wsp = (GAS unsigned char*)ws; asm volatile("" : "+s"(wsp)); PIN_ARGS(); const float* ffn_norm = kap->in[2]; const float* router_w = kap->in[13];
        LAS unsigned* entL = (LAS unsigned*)(lds + XTRA_OFF);
        LAS unsigned* rankL = entL + 256;
        int lane_r = threadIdx.x; asm volatile("" : "+v"(lane_r) :: "memory"); lane_r &= 63;
        float wr_[16][8];
#pragma unroll
        for (int j = 0; j < 16; ++j) { const int k = (j < 8) ? 8 * lane_r + j : 512 + 8 * lane_r + (j - 8); const float gk = ffn_norm[D + k];
            const f32x4 a = *(const f32x4*)(router_w + (size_t)k * 8), b2 = *(const f32x4*)(router_w + (size_t)k * 8 + 4);
            wr_[j][0] = a[0] * gk; wr_[j][1] = a[1] * gk; wr_[j][2] = a[2] * gk; wr_[j][3] = a[3] * gk; wr_[j][4] = b2[0] * gk; wr_[j][5] = b2[1] * gk; wr_[j][6] = b2[2] * gk; wr_[j][7] = b2[3] * gk; }
        for (int chunk = vcu; chunk < T / 128; chunk += G) {
            const int t0 = chunk * 128;
            for (int i0 = 0; i0 < 16; i0 += 4) {
                float lg[4][8], sq4[4];
#pragma unroll
                for (int q = 0; q < 4; ++q) { const int t = t0 + wave * 16 + i0 + q;
                    const u32x4 h0 = *(const u32x4*)(hbuf + (size_t)t * D + 8 * lane_r), h1 = *(const u32x4*)(hbuf + (size_t)t * D + 512 + 8 * lane_r);
                    const float hv[16] = {bflo(h0.x), bfhi(h0.x), bflo(h0.y), bfhi(h0.y), bflo(h0.z), bfhi(h0.z), bflo(h0.w), bfhi(h0.w), bflo(h1.x), bfhi(h1.x), bflo(h1.y), bfhi(h1.y), bflo(h1.z), bfhi(h1.z), bflo(h1.w), bfhi(h1.w)};
#pragma unroll
                    for (int e = 0; e < 8; ++e) { float s = 0.f;
#pragma unroll
                        for (int j = 0; j < 16; ++j) s += hv[j] * wr_[j][e];
                        lg[q][e] = s; }
                    sq4[q] = (lane_r < 16) ? ss3[(size_t)t * 16 + lane_r] : 0.f; }
                { const bool b5 = (lane_r & 32) != 0, b4 = (lane_r & 16) != 0, b3 = (lane_r & 8) != 0;
#pragma unroll
                for (int q = 0; q < 4; ++q) {
                    float a4[4], a2[2];
#pragma unroll
                    for (int i = 0; i < 4; ++i) { const float keep = b5 ? lg[q][4 + i] : lg[q][i], send = b5 ? lg[q][i] : lg[q][4 + i]; a4[i] = keep + __shfl_xor(send, 32); }
#pragma unroll
                    for (int i = 0; i < 2; ++i) { const float keep = b4 ? a4[2 + i] : a4[i], send = b4 ? a4[i] : a4[2 + i]; a2[i] = keep + __shfl_xor(send, 16); }
                    float a1; { const float keep = b3 ? a2[1] : a2[0], send = b3 ? a2[0] : a2[1]; a1 = keep + __shfl_xor(send, 8); }
                    a1 += __shfl_xor(a1, 4); a1 += __shfl_xor(a1, 2); a1 += __shfl_xor(a1, 1);
#pragma unroll
                    for (int e = 0; e < 8; ++e) lg[q][e] = __builtin_bit_cast(float, __builtin_amdgcn_readlane(__builtin_bit_cast(int, a1), 8 * e));
                    float sq = sq4[q]; sq += __shfl_xor(sq, 8); sq += __shfl_xor(sq, 4); sq += __shfl_xor(sq, 2); sq += __shfl_xor(sq, 1);
                    sq4[q] = __builtin_bit_cast(float, __builtin_amdgcn_readlane(__builtin_bit_cast(int, sq), 0)); } }
#pragma unroll
                for (int q = 0; q < 4; ++q) { const int tl = wave * 16 + i0 + q, t = t0 + tl;
                    const float rstd = 1.0f / sqrtf(sq4[q] * (1.0f / D) + EPS);
                    int i1 = 0; float v1 = lg[q][0];
#pragma unroll
                    for (int e = 1; e < 8; ++e) if (lg[q][e] > v1) { v1 = lg[q][e]; i1 = e; }
                    int i2 = -1; float v2 = -__builtin_inff();
#pragma unroll
                    for (int e = 0; e < 8; ++e) if (e != i1 && lg[q][e] > v2) { v2 = lg[q][e]; i2 = e; }
                    const float w1 = 1.0f / (1.0f + __expf((v2 - v1) * rstd));
                    if (lane_r == 0) { entL[tl * 2] = (unsigned)i1; entL[tl * 2 + 1] = (unsigned)i2; gatew[(size_t)t * 2] = w1; gatew[(size_t)t * 2 + 1] = 1.0f - w1; rstd3[t] = rstd; } }
            }
            __syncthreads();
            LAS unsigned* wcntL = rankL + 256;
            unsigned e_r = 0, myrank = 0;
            if (tid < 256) { e_r = entL[tid];
#pragma unroll
                for (unsigned q = 0; q < 8; ++q) { const unsigned long long mq = __ballot(e_r == q); if (e_r == q) myrank = (unsigned)__builtin_popcountll(mq & ((1ull << lane_r) - 1ull));
                    if (lane_r == 0) wcntL[wave * 8 + q] = (unsigned)__builtin_popcountll(mq); } }
            __syncthreads();
            if (tid < 256) { unsigned off = 0;
#pragma unroll
                for (int w = 0; w < 3; ++w) if (w < wave) off += wcntL[w * 8 + e_r];
                ent[(size_t)t0 * 2 + tid] = e_r | ((off + myrank) << 8); }
            if (tid < 8) bcnt[chunk * 8 + tid] = (int)(wcntL[tid] + wcntL[8 + tid] + wcntL[16 + tid] + wcntL[24 + tid]);
            __syncthreads();
        }
    }
    SEAM(PH_ROUTE);

    if (IN(PH_LIST)) {
        wsp = (GAS unsigned char*)ws; asm volatile("" : "+s"(wsp)); PIN_ARGS();
        LAS int* cntL = (LAS int*)(lds + XTRA_OFF);
        LAS int* baseL = cntL + 2048;
        for (int chunk = vcu; chunk < T / 128; chunk += G) {
            unsigned en_l = 0; float rs_l = 0.f, gw_l = 0.f;
            if (tid < 256) { en_l = ent[(size_t)chunk * 256 + tid]; rs_l = rstd3[chunk * 128 + (tid >> 1)]; gw_l = gatew[(size_t)(chunk * 128 + (tid >> 1)) * 2 + (tid & 1)]; }
            for (int i = tid; i < 2048; i += 512) cntL[i] = bcnt[i];
            __syncthreads();
            {
                int tl_ = threadIdx.x; asm volatile("" : "+v"(tl_)); const int ln = tl_ & 63, e = wave;
                const int c0 = cntL[(4 * ln + 0) * 8 + e], c1 = cntL[(4 * ln + 1) * 8 + e], c2 = cntL[(4 * ln + 2) * 8 + e], c3 = cntL[(4 * ln + 3) * 8 + e];
                const int s4 = (c0 + c1) + (c2 + c3); int incl = s4;
#pragma unroll
                for (int o = 1; o < 64; o <<= 1) { const int t_ = __shfl_up(incl, o); if (ln >= o) incl += t_; }
                if (ln == (chunk >> 2)) { int pre = incl - s4; const int k = chunk & 3; if (k > 0) pre += c0; if (k > 1) pre += c1; if (k > 2) pre += c2; baseL[e] = pre; }
                if (ln == 63) baseL[16 + e] = incl; }
            __syncthreads();
            if (tid == 0) { int seg = 0; for (int e = 0; e < 8; ++e) { baseL[8 + e] = seg; seg += (baseL[16 + e] + 255) & ~255; } baseL[24] = seg; }
            __syncthreads();
            if (tid < 256) { const unsigned en = en_l; const int e = en & 255, rk = en >> 8; const int t = chunk * 128 + (tid >> 1);
                const int pos = baseL[8 + e] + baseL[e] + rk;
                soff[pos] = (unsigned)t * D; srstd[pos] = rs_l; sdst[pos] = t * 2 + (tid & 1); sgw[pos] = gw_l; }
            if (chunk < 8) { const int e = chunk; const int tot = baseL[16 + e], seg = baseL[8 + e]; for (int p = tot + tid; p < ((tot + 255) & ~255); p += 512) { soff[seg + p] = 0u; srstd[seg + p] = 0.f; sdst[seg + p] = -1; sgw[seg + p] = 0.f; } }
            if (chunk == 0) { const int ntl = baseL[24] >> 8; for (int mt = tid; mt < ntl; mt += 512) { int e = 0; for (int q = 1; q < 8; ++q) if (mt * 256 >= baseL[8 + q]) e = q; texp[mt] = e; } if (tid == 0) ctl[CW_NTILES] = (unsigned)ntl; }
            __syncthreads();
        }
    }
    SEAM(PH_LIST);

#ifndef REP_G1
#define REP_G1 1
#endif
#ifndef REP_G2
#define REP_G2 1
#endif
#ifndef REP_MOE
#define REP_MOE 1
#endif
    for (int rep = 0; rep < REP_MOE; ++rep) { if (rep) xcd_barrier(bar);
    int ntiles_c = 0;
#pragma unroll 1
    for (int st = 0; st < MOE_STEPS; ++st) {
        if (IN(PH_MOE0 + st)) {
            wsp = (GAS unsigned char*)ws; asm volatile("" : "+s"(wsp)); PIN_ARGS(); const float* mwd = kap->in[16];
            LAS int* texpL = (LAS int*)(lds + XTRA_OFF + 16384);
            if (st == 0 || lo == PH_MOE0 + st) {
                ntiles_c = (int)__hip_atomic_load(ctl + CW_NTILES, RLX_AGENT);
                { int tm_ = threadIdx.x; asm volatile("" : "+v"(tm_)); for (int i = tm_; i < MOE_TILES_MAX; i += NWAVES * 64) texpL[i] = texp[i]; }
                __syncthreads(); }
            const int ntiles = ntiles_c;
            const int nrem = ntiles > 256 ? ntiles - 256 : 0;
            bf16* act2 = (bf16*)(unsigned char*)(wsp + WS_ACT2);
#ifndef MOE_NO_G2
            if (st >= 1) { const int c = st - 1; const int nM = CHUNK_TILES + (c == 0 ? nrem : 0);
                ProbMoeG2 pr{(const char*)(unsigned char*)(wsp + ((c & 1) ? WS_ACT1 : WS_ACT0)), (const char*)act2, (const char*)w_md8, FE / 2, FE / 2, texpL, c * CHUNK_TILES, CHUNK_TILES};
                pg8::StaticOrder S; S.init(nM, 4, G, bx);
                EpiMoeOut E{y8buf, sdst, sgw, c * CHUNK_TILES, CHUNK_TILES};
                for (int r2 = 0; r2 < REP_G2; ++r2) pg8::gemm_phase(lds + RING_OFF, pr, S, E); }
#endif
#ifndef MOE_NO_G1
            if (st < MOE_STEPS - 1) { const int c = st; const int nM = CHUNK_TILES + (c == 0 ? nrem : 0);
                ProbMoeG1 pr{(const char*)h8buf, (const char*)w_mgu8, D / 2, D / 2, soff, texpL, c * CHUNK_TILES, CHUNK_TILES};
                EpiSwiGLU<true, FE> E{(bf16*)(unsigned char*)(wsp + ((c & 1) ? WS_ACT1 : WS_ACT0)), RstdTable{nullptr, -1, 0}, srstd, c * CHUNK_TILES, CHUNK_TILES, act2};
                if (st == 1 && nrem > 0 && G == 256) { SkewOrder S; S.init(nM, 2 * FE / 256, G, bx); S.e = 4 * nrem; pg8::gemm_phase(lds + RING_OFF, pr, S, E); }
                else { pg8::StaticOrder S; S.init(nM, 2 * FE / 256, G, bx); for (int r1 = 0; r1 < REP_G1; ++r1) pg8::gemm_phase(lds + RING_OFF, pr, S, E); } }
#endif
        }
        SEAM(PH_MOE0 + st);
    }
    }

    if (IN(PH_FINAL)) {
        wsp = (GAS unsigned char*)ws; asm volatile("" : "+s"(wsp)); PIN_ARGS(); const float* final_norm = kap->in[17]; float* out_f = kap->out;
        int tf_ = threadIdx.x; asm volatile("" : "+v"(tf_)); const int lane_f = tf_ & 63;
        const unsigned tmo = __hip_atomic_load(ctl + CW_BAR + XB_TMO, RLX_AGENT);
        f32x4 gn[4];
#pragma unroll
        for (int j = 0; j < 4; ++j) gn[j] = *(const f32x4*)(final_norm + 16 * lane_f + 4 * j);
        for (int t0 = gw; t0 < T; t0 += 2 * NGW) {
            f32x4 v[2][4]; float s2[2];
#pragma unroll
            for (int q = 0; q < 2; ++q) { const int t = t0 + q * NGW;
                const u32x4 a0 = *(const u32x4*)(hbuf + (size_t)t * D + 16 * lane_f), a1 = *(const u32x4*)(hbuf + (size_t)t * D + 16 * lane_f + 8);
                const u32x4 y = *(const u32x4*)(y8buf + (size_t)t * 2 * D + 16 * lane_f), z = *(const u32x4*)(y8buf + (size_t)t * 2 * D + D + 16 * lane_f);
                float yf[4][4], zf[4][4]; up4_fp8(y.x, yf[0]); up4_fp8(y.y, yf[1]); up4_fp8(y.z, yf[2]); up4_fp8(y.w, yf[3]); up4_fp8(z.x, zf[0]); up4_fp8(z.y, zf[1]); up4_fp8(z.z, zf[2]); up4_fp8(z.w, zf[3]);
                constexpr float YI = 1.0f / Y8S;
                v[q][0] = (f32x4){bflo(a0.x) + (yf[0][0] + zf[0][0]) * YI, bfhi(a0.x) + (yf[0][1] + zf[0][1]) * YI, bflo(a0.y) + (yf[0][2] + zf[0][2]) * YI, bfhi(a0.y) + (yf[0][3] + zf[0][3]) * YI};
                v[q][1] = (f32x4){bflo(a0.z) + (yf[1][0] + zf[1][0]) * YI, bfhi(a0.z) + (yf[1][1] + zf[1][1]) * YI, bflo(a0.w) + (yf[1][2] + zf[1][2]) * YI, bfhi(a0.w) + (yf[1][3] + zf[1][3]) * YI};
                v[q][2] = (f32x4){bflo(a1.x) + (yf[2][0] + zf[2][0]) * YI, bfhi(a1.x) + (yf[2][1] + zf[2][1]) * YI, bflo(a1.y) + (yf[2][2] + zf[2][2]) * YI, bfhi(a1.y) + (yf[2][3] + zf[2][3]) * YI};
                v[q][3] = (f32x4){bflo(a1.z) + (yf[3][0] + zf[3][0]) * YI, bfhi(a1.z) + (yf[3][1] + zf[3][1]) * YI, bflo(a1.w) + (yf[3][2] + zf[3][2]) * YI, bfhi(a1.w) + (yf[3][3] + zf[3][3]) * YI};
                float s = 0.f;
#pragma unroll
                for (int j = 0; j < 4; ++j) s += (v[q][j][0] * v[q][j][0] + v[q][j][1] * v[q][j][1]) + (v[q][j][2] * v[q][j][2] + v[q][j][3] * v[q][j][3]);
                s2[q] = s; }
            s2[0] = wave_sum(s2[0]); s2[1] = wave_sum(s2[1]);
            asm volatile("s_waitcnt vmcnt(0)" ::: "memory");
#pragma unroll
            for (int q = 0; q < 2; ++q) { const int t = t0 + q * NGW;
                float rstd = 1.0f / sqrtf(s2[q] * (1.0f / D) + EPS);
                if (tmo) rstd = __builtin_nanf("");
#pragma unroll
                for (int j = 0; j < 4; ++j) *(f32x4*)(out_f + (size_t)t * D + 16 * lane_f + 4 * j) = v[q][j] * rstd * gn[j]; }
        }
    }
#undef IN
#undef SEAM
}

#ifndef MK_ONE_LAUNCH
#define MK_ONE_LAUNCH 1
#endif
extern "C" void kernel_launch(void* const* d_in, const int* in_sizes, int n_in, void* d_out, int out_size, void* d_ws, size_t ws_size, hipStream_t stream) {
    static int grid = 0;
    if (grid == 0) {
        if (n_in != 18 || in_sizes[0] != T * D || out_size != T * D || ws_size < WS_END) { fprintf(stderr, "kernel_launch: shape mismatch n_in %d in0 %d out %d ws %zu (need %zu)\n", n_in, n_in > 0 ? in_sizes[0] : -1, out_size, ws_size, (size_t)WS_END); grid = -1; return; }
        int dev = 0, cus = 0, per_cu = 0;
        if (hipGetDevice(&dev) != hipSuccess || hipDeviceGetAttribute(&cus, hipDeviceAttributeMultiprocessorCount, dev) != hipSuccess) { grid = -1; return; }
        if (hipFuncSetAttribute((const void*)yoco_fwd, hipFuncAttributeMaxDynamicSharedMemorySize, LDS_BYTES) != hipSuccess) { fprintf(stderr, "kernel_launch: hipFuncSetAttribute failed\n"); grid = -1; return; }
        if (hipOccupancyMaxActiveBlocksPerMultiprocessor(&per_cu, (const void*)yoco_fwd, NWAVES * 64, LDS_BYTES) != hipSuccess || per_cu < 1) fprintf(stderr, "kernel_launch: occupancy query says %d\n", per_cu);
        (void)hipGetLastError();
        grid = cus;
    }
    if (grid < 0) return;
    (void)hipMemsetAsync((char*)d_ws + WS_CTL, 0, CTL_ZERO_BYTES, stream);
    Args a{};
    for (int i = 0; i < 18; ++i) a.in[i] = (const float*)d_in[i];
    a.out = (float*)d_out; a.ws = (unsigned char*)d_ws;
#if MK_ONE_LAUNCH
    a.ph_lo = 0; a.ph_hi = PH_COUNT;
    hipLaunchKernelGGL(yoco_fwd, dim3(grid), dim3(NWAVES * 64), LDS_BYTES, stream, a);
#else
    for (int p = 0; p < PH_COUNT; ++p) { a.ph_lo = p; a.ph_hi = p + 1; hipLaunchKernelGGL(yoco_fwd, dim3(grid), dim3(NWAVES * 64), LDS_BYTES, stream, a); }
#endif
}
```
